# Optimizing an MI355X kernel written in HIP

```python
import jax, jax.numpy as jnp
from jax import lax
import numpy as np

D_MODEL = 4096
BATCH = 8
SEQ = 2048
DEPTH = 1
DEC_BATCH = 16
DEC_SEQ = 32
PAST_LEN = 1024

CHUNK = 64
Q_BLOCK = 128
HEAD_DIM = 128
N_HEADS = D_MODEL // HEAD_DIM
H_FOX = N_HEADS // 2
H_SB = N_HEADS - H_FOX
W_FOX = H_FOX * HEAD_DIM
W_SB = H_SB * HEAD_DIM
D_MIX = W_FOX + W_SB
D_IN = 3 * W_FOX + H_FOX + 3 * W_SB
D_FF = ((8 * D_MODEL // 3 + 255) // 256) * 256
EPS = 1e-6
NEG_INF = -1e30
FORGET_BIAS_INIT = 2.0

kernel_name = "fox_stickbreak_hybrid_stream_step"


def _rmsnorm(x, g):
    x32 = x.astype(jnp.float32)
    y = x32 * lax.rsqrt(jnp.mean(x32 * x32, axis=-1, keepdims=True) + EPS)
    return (y * g.astype(jnp.float32)).astype(x.dtype)


def _project(h, w_in, b_forget):
    b, t = h.shape[:2]
    z = h @ w_in
    cuts = np.cumsum([W_FOX, W_FOX, W_FOX, H_FOX, W_SB, W_SB]).tolist()
    qf, kf, vf, fl, qs, ks, vs = jnp.split(z, cuts, axis=-1)
    r_fox = lambda a: a.reshape(b, t, H_FOX, HEAD_DIM)
    r_sb = lambda a: a.reshape(b, t, H_SB, HEAD_DIM)
    logf = jax.nn.log_sigmoid(fl.astype(jnp.float32) + b_forget.astype(jnp.float32))
    return r_fox(qf), r_fox(kf), r_fox(vf), logf, r_sb(qs), r_sb(ks), r_sb(vs)


def _fox_attend(q, k, v, cq, ck, qpos, kpos):
    s = jnp.einsum('bqhd,bkhd->bhqk', q, k).astype(jnp.float32) * (HEAD_DIM ** -0.5)
    cq32 = jnp.transpose(cq.astype(jnp.float32), (0, 2, 1))
    ck32 = jnp.transpose(ck.astype(jnp.float32), (0, 2, 1))
    s = s + (cq32[..., :, None] - ck32[..., None, :])
    mask = kpos[None, :] <= qpos[:, None]
    s = jnp.where(mask, s, NEG_INF)
    p = jax.nn.softmax(s, axis=-1)
    return jnp.einsum('bhqk,bkhd->bqhd', p.astype(v.dtype), v)


def _sb_attend(q, k, v, qpos, kpos):
    z = jnp.einsum('bqhd,bkhd->bhqk', q, k).astype(jnp.float32) * (HEAD_DIM ** -0.5)
    mask = kpos[None, :] < qpos[:, None]
    log_1mb = jnp.where(mask, jax.nn.log_sigmoid(-z), 0.0)
    between = lax.cumsum(log_1mb, axis=3, reverse=True) - log_1mb
    a = jnp.where(mask, jnp.exp(jax.nn.log_sigmoid(z) + between), 0.0)
    return jnp.einsum('bhqk,bkhd->bqhd', a.astype(v.dtype), v)


def _to_blocks(a):
    b, t = a.shape[:2]
    a = a.reshape((b, t // Q_BLOCK, Q_BLOCK) + a.shape[2:])
    return jnp.moveaxis(a, 1, 0)


def _from_blocks(a):
    a = jnp.moveaxis(a, 0, 1)
    return a.reshape((a.shape[0], a.shape[1] * a.shape[2]) + a.shape[3:])


def _merge_groups(o_fox, o_sb, g_fox, g_sb, w_out):
    b, t = o_fox.shape[:2]
    a = _rmsnorm(o_fox.reshape(b, t, W_FOX), g_fox)
    s = _rmsnorm(o_sb.reshape(b, t, W_SB), g_sb)
    return jnp.concatenate([a, s], axis=-1) @ w_out


def _swiglu(h, w_gate, w_up, w_down):
    return (jax.nn.silu(h @ w_gate) * (h @ w_up)) @ w_down


def setup_inputs(seed: int = 0) -> dict:
    key = jax.random.key(seed)
    ks = jax.random.split(key, 20)
    f32 = jnp.float32
    nrm = lambda k, shape, scale: jax.random.normal(k, shape, f32) * scale
    cache_kv_fox = (DEPTH, DEC_BATCH, PAST_LEN, H_FOX, HEAD_DIM)
    cache_kv_sb = (DEPTH, DEC_BATCH, PAST_LEN, H_SB, HEAD_DIM)
    return {
        "x_prompt": nrm(ks[0], (BATCH, SEQ, D_MODEL), 1.0),
        "x_sample": nrm(ks[1], (DEC_BATCH, DEC_SEQ, D_MODEL), 1.0),
        "cache_fox_k": nrm(ks[2], cache_kv_fox, 1.0),
        "cache_fox_v": nrm(ks[3], cache_kv_fox, 1.0),
        "cache_fox_logf": jax.nn.log_sigmoid(FORGET_BIAS_INIT + nrm(ks[4], (DEPTH, DEC_BATCH, PAST_LEN, H_FOX), 1.0)),
        "cache_sb_k": nrm(ks[5], cache_kv_sb, 1.0),
        "cache_sb_v": nrm(ks[6], cache_kv_sb, 1.0),
        "attn_norm": 1.0 + nrm(ks[7], (DEPTH, D_MODEL), 0.01),
        "w_in": nrm(ks[8], (DEPTH, D_MODEL, D_IN), D_MODEL ** -0.5),
        "b_forget": FORGET_BIAS_INIT + nrm(ks[9], (DEPTH, H_FOX), 0.1),
        "out_norm_fox": 1.0 + nrm(ks[10], (DEPTH, W_FOX), 0.01),
        "out_norm_sb": 1.0 + nrm(ks[11], (DEPTH, W_SB), 0.01),
        "w_out": nrm(ks[12], (DEPTH, D_MIX, D_MODEL), D_MIX ** -0.5),
        "ffn_norm": 1.0 + nrm(ks[13], (DEPTH, D_MODEL), 0.01),
        "w_gate": nrm(ks[14], (DEPTH, D_MODEL, D_FF), D_MODEL ** -0.5),
        "w_up": nrm(ks[15], (DEPTH, D_MODEL, D_FF), D_MODEL ** -0.5),
        "w_down": nrm(ks[16], (DEPTH, D_FF, D_MODEL), D_FF ** -0.5),
        "final_norm": 1.0 + nrm(ks[17], (D_MODEL,), 0.01),
    }


def reference(x_prompt, x_sample, cache_fox_k, cache_fox_v, cache_fox_logf, cache_sb_k, cache_sb_v,
              attn_norm, w_in, b_forget, out_norm_fox, out_norm_sb, w_out,
              ffn_norm, w_gate, w_up, w_down, final_norm):
    xp, xs = x_prompt, x_sample
    t_p = xp.shape[1]
    t_s = xs.shape[1]
    past = cache_fox_k.shape[2]
    pos_p = jnp.arange(t_p, dtype=jnp.int32)
    pos_all = jnp.arange(past + t_s, dtype=jnp.int32)
    pos_q_s = past + jnp.arange(t_s, dtype=jnp.int32)

    p_fk, p_fv, p_fl, p_sk, p_sv = [], [], [], [], []
    s_fk, s_fv, s_fl, s_sk, s_sv = [], [], [], [], []
    for l in range(DEPTH):
        hp = _rmsnorm(xp, attn_norm[l])
        qf, kf, vf, lf, qsb, ksb, vsb = _project(hp, w_in[l], b_forget[l])
        cf = jnp.cumsum(lf, axis=1)
        o_fox = _from_blocks(lax.map(
            lambda blk: _fox_attend(blk[0], kf, vf, blk[1], cf, blk[2], pos_p),
            (_to_blocks(qf), _to_blocks(cf), pos_p.reshape(-1, Q_BLOCK))))
        o_sb = _from_blocks(lax.map(
            lambda blk: _sb_attend(blk[0], ksb, vsb, blk[1], pos_p),
            (_to_blocks(qsb), pos_p.reshape(-1, Q_BLOCK))))
        xp = xp + _merge_groups(o_fox, o_sb, out_norm_fox[l], out_norm_sb[l], w_out[l])
        xp = xp + _swiglu(_rmsnorm(xp, ffn_norm[l]), w_gate[l], w_up[l], w_down[l])
        p_fk.append(kf); p_fv.append(vf); p_fl.append(lf); p_sk.append(ksb); p_sv.append(vsb)

        hs = _rmsnorm(xs, attn_norm[l])
        qf2, kf2, vf2, lf2, qsb2, ksb2, vsb2 = _project(hs, w_in[l], b_forget[l])
        kf_all = jnp.concatenate([cache_fox_k[l], kf2], axis=1)
        vf_all = jnp.concatenate([cache_fox_v[l], vf2], axis=1)
        cf_all = jnp.cumsum(jnp.concatenate([cache_fox_logf[l].astype(jnp.float32), lf2], axis=1), axis=1)
        ksb_all = jnp.concatenate([cache_sb_k[l], ksb2], axis=1)
        vsb_all = jnp.concatenate([cache_sb_v[l], vsb2], axis=1)
        o_fox2 = _fox_attend(qf2, kf_all, vf_all, cf_all[:, past:], cf_all, pos_q_s, pos_all)
        o_sb2 = _sb_attend(qsb2, ksb_all, vsb_all, pos_q_s, pos_all)
        xs = xs + _merge_groups(o_fox2, o_sb2, out_norm_fox[l], out_norm_sb[l], w_out[l])
        xs = xs + _swiglu(_rmsnorm(xs, ffn_norm[l]), w_gate[l], w_up[l], w_down[l])
        s_fk.append(kf2); s_fv.append(vf2); s_fl.append(lf2); s_sk.append(ksb2); s_sv.append(vsb2)

    y_prompt = _rmsnorm(xp, final_norm)
    y_sample = _rmsnorm(xs, final_norm)
    return (y_prompt, y_sample,
            jnp.stack(p_fk), jnp.stack(p_fv), jnp.stack(p_fl), jnp.stack(p_sk), jnp.stack(p_sv),
            jnp.stack(s_fk), jnp.stack(s_fv), jnp.stack(s_fl), jnp.stack(s_sk), jnp.stack(s_sv))
```

```cpp
#include <hip/hip_runtime.h>
#include <cstdio>
#include <cstdint>

#ifndef MK_N_LAUNCHES
#define MK_N_LAUNCHES 1
#endif

#define GAS __attribute__((address_space(1)))
#define LAS __attribute__((address_space(3)))
typedef unsigned short bf16;
typedef unsigned v4u __attribute__((ext_vector_type(4)));
typedef unsigned v2u __attribute__((ext_vector_type(2)));
typedef float f32x4 __attribute__((ext_vector_type(4)));
typedef float f32x16 __attribute__((ext_vector_type(16)));
typedef short bf16x8 __attribute__((ext_vector_type(8)));
typedef short s16x4 __attribute__((ext_vector_type(4)));
typedef GAS unsigned gu32;

constexpr int DM = 4096, NB = 8, SEQ = 2048, DB = 16, DS = 32, PAST = 1024, HD = 128, NHG = 16;
constexpr int WG = NHG * HD;
constexpr int DFF = 11008;
constexpr int MP = NB * SEQ, MS = DB * DS, MT = MP + MS;
constexpr int DIN = 3 * WG + NHG + 3 * WG;
constexpr int NIN = 6 * WG + 256;
constexpr int TKS = PAST + DS;
constexpr int KVROWS = MP + DB * TKS;
constexpr float EPS = 1e-6f;
constexpr float LOG2E = 1.4426950408889634f;
constexpr float QSCALE = 0.08838834764831845f * LOG2E;

constexpr size_t O_YP = 0, O_YS = O_YP + (size_t)MP * DM;
constexpr size_t O_PFK = O_YS + (size_t)MS * DM, O_PFV = O_PFK + (size_t)MP * WG, O_PFL = O_PFV + (size_t)MP * WG;
constexpr size_t O_PSK = O_PFL + (size_t)MP * NHG, O_PSV = O_PSK + (size_t)MP * WG;
constexpr size_t O_SFK = O_PSV + (size_t)MP * WG, O_SFV = O_SFK + (size_t)MS * WG, O_SFL = O_SFV + (size_t)MS * WG;
constexpr size_t O_SSK = O_SFL + (size_t)MS * NHG, O_SSV = O_SSK + (size_t)MS * WG, O_END = O_SSV + (size_t)MS * WG;

constexpr size_t MiB = 1u << 20;
constexpr size_t WS_CTL = 0, CTL_ZERO_BYTES = 1 * MiB;
constexpr size_t WS_WIN = 2 * MiB;
constexpr size_t WS_WOUT = 100 * MiB;
constexpr size_t WS_WGU = 132 * MiB;
constexpr size_t WS_WDN = 304 * MiB;
constexpr size_t WS_XN = 390 * MiB;
constexpr size_t WS_QO = 522 * MiB;
constexpr size_t WS_KV = 654 * MiB, KV_STRIDE = 130 * MiB;
constexpr size_t WS_ACT = 654 * MiB;
constexpr size_t WS_END = 1174 * MiB;
static_assert((size_t)NIN * DM * 2 == 98 * MiB && (size_t)2 * DFF * DM * 2 == 172 * MiB && (size_t)DM * DFF * 2 == 86 * MiB && (size_t)MT * DM * 2 == 132 * MiB && (size_t)KVROWS * WG * 2 == KV_STRIDE, "ws map");
static_assert(WS_ACT + (size_t)MT * DFF * 2 <= WS_END && WS_KV + 4 * KV_STRIDE == WS_END, "ws map");
constexpr int CW_TMO = 0, CW_CODE = 1, CW_BAR = 4096;

constexpr int NWAVES = 8;
constexpr int RING_OFF = 0, RING_BYTES = 131072;
constexpr int LDSCTL_OFF = RING_BYTES, MISC_OFF = LDSCTL_OFF + 320;
constexpr int LDS_BYTES = 147456;

#define RLX_AGENT __ATOMIC_RELAXED, __HIP_MEMORY_SCOPE_AGENT
#define LDS_WAIT() asm volatile("s_waitcnt lgkmcnt(0)" ::: "memory")
#define VM_WAIT() asm volatile("s_waitcnt vmcnt(0)" ::: "memory")

__device__ __forceinline__ unsigned cvt_pk_bf16(float lo, float hi) { unsigned r; asm volatile("v_cvt_pk_bf16_f32 %0, %1, %2" : "=v"(r) : "v"(lo), "v"(hi)); return r; }

namespace pg8 {
#define PG8_LAS __attribute__((address_space(3)))
typedef unsigned short bf16_t;
constexpr int BM = 256, BK = 64, HALF = 128, HTB = HALF * BK * 2, STAGE_BYTES = 8 * HTB, NXCD = 8, WGM = 8;
__host__ __device__ __forceinline__ int lds_byte(int r, int c) { const int st = (r >> 4) * 2 + (c >> 5), rr = r & 15, cc = c & 31, ob = rr * 64 + cc * 2; return st * 1024 + (ob ^ (((ob >> 9) & 1) << 5)); }
__host__ __device__ __forceinline__ void stage_rc(int b, int& R, int& C) { const int st = b / 1024, sb = b % 1024, swz = sb ^ (((sb >> 9) & 1) << 5); R = (st >> 1) * 16 + swz / 64; C = (st & 1) * 32 + (swz % 64) / 2; }
__host__ __device__ __forceinline__ int perm32(int rho) { const int n = rho >> 4, i = rho & 15; return 8 * (i >> 2) + 4 * n + (i & 3); }
struct Unit { int pm, pn; };
struct Gemm { const bf16_t* A; const bf16_t* Bt; int M, N, K; };
struct StaticOrder {
    int nM, nN, nwg, G, c;
    __host__ __device__ void init(int M, int N, int G_, int c_) { nM = M / BM; nN = N / BM; nwg = nM * nN; G = G_; c = c_; }
    __host__ __device__ bool next(int i, Unit& u) const {
        const long L = (long)i * G + c; if (L >= nwg) return false;
        int wgid = (int)L; { const int q = nwg / NXCD, r = nwg % NXCD, xcd = wgid % NXCD, off = wgid / NXCD; wgid = (xcd < r ? xcd * (q + 1) : r * (q + 1) + (xcd - r) * q) + off; }
        const int nig = WGM * nN, gid = wgid / nig, fm = gid * WGM, gsz = (nM - fm) < WGM ? (nM - fm) : WGM;
        u.pm = fm + ((wgid % nig) % gsz); u.pn = (wgid % nig) / gsz; return true;
    }
    __device__ __forceinline__ void a_ready(const Unit&) const {}
    __device__ __forceinline__ void done(const Unit&) const {}
};
template <class Epi, class Sched, bool ALIGN_EPI = false, bool SP2 = false>
__device__ __forceinline__ void gemm_phase(PG8_LAS unsigned char* lds, const Gemm g, const Sched& S, const Epi& E) {
    const int tid = threadIdx.x, wid = __builtin_amdgcn_readfirstlane(tid >> 6), lane = tid & 63, wr = wid >> 2, wc = wid & 3, fr = lane & 15, fq = lane >> 4;
    const int K = g.K, nt = K / BK;
    unsigned voffA[2], voffB[2];
#pragma unroll
    for (int i = 0; i < 2; ++i) { int R, C; stage_rc(tid * 16 + i * 8192, R, C); const int Rb = Epi::PERM ? ((R & ~31) + perm32(R & 31)) : R;
        voffA[i] = (unsigned)(R * K + C) * 2u; voffB[i] = (unsigned)(Rb * K + C) * 2u; }
    const size_t kstep = (size_t)(BK * 2);
    const size_t hstep = (size_t)HALF * K * 2;
    const size_t tstep = 2 * hstep;
    const unsigned ldsw = (unsigned)wid * 1024u;
    const int aoff = lds_byte(wr * 64 + fr, fq * 8), boff = lds_byte(wc * 32 + fr, fq * 8);
#define PG8_SA(b, h) (((b) * 2 + (h)) * HTB)
#define PG8_SB(b, h) ((4 + (b) * 2 + (h)) * HTB)
#define PG8_STAGE(bufoff, gbase, voff) do { _Pragma("unroll") for (int _i = 0; _i < 2; ++_i) \
        __builtin_amdgcn_global_load_lds((const unsigned*)((const char*)(gbase) + (voff)[_i]), (PG8_LAS unsigned*)(lds + (bufoff) + ldsw + _i * 8192), 16, 0, 0); } while (0)
#define PG8_LDA(dst, b, h) do { _Pragma("unroll") for (int m = 0; m < 4; ++m) _Pragma("unroll") for (int k = 0; k < 2; ++k) dst[m][k] = *(const PG8_LAS bf16x8*)(lds + PG8_SA(b, h) + aoff + m * 2048 + k * 1024); } while (0)
#define PG8_LDB(dst, b, h) do { _Pragma("unroll") for (int n = 0; n < 2; ++n) _Pragma("unroll") for (int k = 0; k < 2; ++k) dst[n][k] = *(const PG8_LAS bf16x8*)(lds + PG8_SB(b, h) + boff + n * 2048 + k * 1024); } while (0)
#define PG8_MMA(ai, bj, At, Bt) do { __builtin_amdgcn_s_setprio(1); _Pragma("unroll") for (int m = 0; m < 4; ++m) _Pragma("unroll") for (int n = 0; n < 2; ++n) _Pragma("unroll") for (int k = 0; k < 2; ++k) \
        acc[ai][bj][m][n] = __builtin_amdgcn_mfma_f32_16x16x32_bf16(Bt[n][k], At[m][k], acc[ai][bj][m][n], 0, 0, 0); __builtin_amdgcn_s_setprio(0); } while (0)
#define PG8_WAIT_V(n) asm volatile("s_waitcnt vmcnt(" #n ")" ::: "memory")
#define PG8_WAIT_L(n) asm volatile("s_waitcnt lgkmcnt(" #n ")" ::: "memory")
#define PG8_BAR __builtin_amdgcn_s_barrier()
#define PG8_SCHED __builtin_amdgcn_sched_barrier(0)
    Unit cur, nxt; int ui = 0;
    if (!S.next(0, cur)) return;
    f32x4 acc[2][2][4][2];
#pragma unroll
    for (int a = 0; a < 2; ++a)
#pragma unroll
        for (int b = 0; b < 2; ++b)
#pragma unroll
            for (int m = 0; m < 4; ++m)
#pragma unroll
                for (int n = 0; n < 2; ++n) acc[a][b][m][n] = (f32x4){0.f, 0.f, 0.f, 0.f};
    bf16x8 At[4][2], B0[2][2], B1[2][2];
    const char* cA = (const char*)g.A + (size_t)cur.pm * tstep; const char* cB = (const char*)g.Bt + (size_t)cur.pn * tstep;
    S.a_ready(cur);
    if constexpr (SP2) {
        PG8_STAGE(PG8_SB(0, 0), cB, voffB); PG8_STAGE(PG8_SB(0, 1), cB + hstep, voffB); PG8_STAGE(PG8_SA(0, 0), cA, voffA); PG8_STAGE(PG8_SA(0, 1), cA + hstep, voffA);
        if (wr == 1) PG8_BAR;
        PG8_WAIT_V(2); PG8_BAR;
        PG8_STAGE(PG8_SB(1, 0), cB + kstep, voffB); PG8_STAGE(PG8_SA(1, 0), cA + kstep, voffA); PG8_STAGE(PG8_SB(1, 1), cB + hstep + kstep, voffB);
        PG8_WAIT_V(6); PG8_BAR;
    } else {
        PG8_STAGE(PG8_SB(0, 0), cB, voffB); PG8_STAGE(PG8_SA(0, 0), cA, voffA); PG8_STAGE(PG8_SB(0, 1), cB + hstep, voffB); PG8_STAGE(PG8_SA(0, 1), cA + hstep, voffA);
        if (wr == 1) PG8_BAR;
        PG8_WAIT_V(4); PG8_BAR;
        PG8_STAGE(PG8_SB(1, 0), cB + kstep, voffB); PG8_STAGE(PG8_SA(1, 0), cA + kstep, voffA); PG8_STAGE(PG8_SB(1, 1), cB + hstep + kstep, voffB);
        PG8_WAIT_V(6); PG8_BAR;
    }
    for (;;) {
        const bool has_next = S.next(ui + 1, nxt);
        const char* nA = has_next ? (const char*)g.A + (size_t)nxt.pm * tstep : cA; const char* nB = has_next ? (const char*)g.Bt + (size_t)nxt.pn * tstep : cB;
        for (int t = 0; t < nt; t += 2) {
            const bool last = (t == nt - 2);
            const char* a1 = cA + (size_t)(t + 1) * kstep;
            const char* a2 = last ? nA : cA + (size_t)(t + 2) * kstep; const char* b2 = last ? nB : cB + (size_t)(t + 2) * kstep;
            const char* a3 = a2 + kstep; const char* b3 = b2 + kstep;
            if (last && has_next) S.a_ready(nxt);
            if constexpr (SP2) {
            PG8_LDB(B0, 0, 0); PG8_LDB(B1, 0, 1); PG8_SCHED; PG8_LDA(At, 0, 0); PG8_STAGE(PG8_SA(1, 1), a1 + hstep, voffA);
            PG8_WAIT_V(8); PG8_WAIT_L(0); PG8_BAR; PG8_MMA(0, 0, At, B0); PG8_MMA(0, 1, At, B1); PG8_BAR; PG8_SCHED;
            PG8_LDA(At, 0, 1); PG8_STAGE(PG8_SB(0, 0), b2, voffB); PG8_STAGE(PG8_SB(0, 1), b2 + hstep, voffB); PG8_STAGE(PG8_SA(0, 0), a2, voffA);
            PG8_WAIT_V(8); PG8_WAIT_L(0); PG8_BAR; PG8_MMA(1, 0, At, B0); PG8_MMA(1, 1, At, B1); PG8_BAR; PG8_SCHED;
            PG8_LDB(B0, 1, 0); PG8_LDB(B1, 1, 1); PG8_SCHED; PG8_LDA(At, 1, 0); PG8_STAGE(PG8_SA(0, 1), a2 + hstep, voffA);
            PG8_WAIT_V(8); PG8_WAIT_L(0); PG8_BAR; PG8_MMA(0, 0, At, B0); PG8_MMA(0, 1, At, B1); PG8_BAR; PG8_SCHED;
            PG8_LDA(At, 1, 1); PG8_STAGE(PG8_SB(1, 0), b3, voffB); PG8_STAGE(PG8_SB(1, 1), b3 + hstep, voffB); PG8_STAGE(PG8_SA(1, 0), a3, voffA);
            PG8_WAIT_V(8); PG8_WAIT_L(0); PG8_BAR; PG8_MMA(1, 0, At, B0); PG8_MMA(1, 1, At, B1); PG8_BAR; PG8_SCHED;
            } else {
            PG8_LDB(B0, 0, 0); PG8_SCHED; PG8_LDA(At, 0, 0); PG8_STAGE(PG8_SA(1, 1), a1 + hstep, voffA);
            PG8_WAIT_L(8); PG8_BAR; PG8_WAIT_L(0); PG8_MMA(0, 0, At, B0); PG8_BAR; PG8_SCHED;
            PG8_LDB(B1, 0, 1); PG8_STAGE(PG8_SB(0, 0), b2, voffB);
            PG8_BAR; PG8_WAIT_L(0); PG8_MMA(0, 1, At, B1); PG8_BAR;
            PG8_LDA(At, 0, 1); PG8_STAGE(PG8_SA(0, 0), a2, voffA);
            PG8_BAR; PG8_WAIT_L(0); PG8_MMA(1, 0, At, B0); PG8_BAR; PG8_SCHED;
            PG8_STAGE(PG8_SB(0, 1), b2 + hstep, voffB);
            PG8_WAIT_V(6); PG8_BAR; PG8_MMA(1, 1, At, B1); PG8_BAR;
            PG8_LDB(B0, 1, 0); PG8_SCHED; PG8_LDA(At, 1, 0); PG8_STAGE(PG8_SA(0, 1), a2 + hstep, voffA);
            PG8_WAIT_L(8); PG8_BAR; PG8_WAIT_L(0); PG8_MMA(0, 0, At, B0); PG8_BAR; PG8_SCHED;
            PG8_LDB(B1, 1, 1); PG8_STAGE(PG8_SB(1, 0), b3, voffB);
            PG8_BAR; PG8_WAIT_L(0); PG8_MMA(0, 1, At, B1); PG8_BAR;
            PG8_LDA(At, 1, 1); PG8_STAGE(PG8_SA(1, 0), a3, voffA);
            PG8_BAR; PG8_WAIT_L(0); PG8_MMA(1, 0, At, B0); PG8_BAR; PG8_SCHED;
            PG8_STAGE(PG8_SB(1, 1), b3 + hstep, voffB);
            PG8_WAIT_V(6); PG8_BAR; PG8_MMA(1, 1, At, B1); PG8_BAR;
            }
        }
        if constexpr (ALIGN_EPI) { if (wr == 0) PG8_BAR; }
        E(acc, cur, wr, wc, fr, fq); S.done(cur);
        if (!has_next) break;
#pragma unroll
        for (int a = 0; a < 2; ++a)
#pragma unroll
            for (int b = 0; b < 2; ++b)
#pragma unroll
                for (int m = 0; m < 4; ++m)
#pragma unroll
                    for (int n = 0; n < 2; ++n) acc[a][b][m][n] = (f32x4){0.f, 0.f, 0.f, 0.f};
        cur = nxt; cA = nA; cB = nB; ++ui;
        if constexpr (ALIGN_EPI) { if (wr == 1) PG8_BAR; }
    }
    PG8_WAIT_V(0);
    if constexpr (!ALIGN_EPI) { if (wr == 0) PG8_BAR; }
    PG8_BAR;
#undef PG8_SA
#undef PG8_SB
#undef PG8_STAGE
#undef PG8_LDA
#undef PG8_LDB
#undef PG8_MMA
#undef PG8_WAIT_V
#undef PG8_WAIT_L
#undef PG8_BAR
#undef PG8_SCHED
}

__device__ __forceinline__ float log_sigmoid_f(float x) { return -(fmaxf(-x, 0.f) + log1pf(expf(-fabsf(x)))); }
struct EpiIn {
    static constexpr bool PERM = true;
    bf16_t* QO; bf16_t* KV; float* out; const float* bfg;
    __device__ __forceinline__ void operator()(const f32x4 (&acc)[2][2][4][2], const Unit& u, int wr, int wc, int fr, int fq) const {
        const int seg = u.pn >> 3;
        const int row0 = u.pm * BM + wr * 64 + fr;
        const int cseg = (u.pn & 7) * BM + wc * 32 + 8 * fq;
        const bool prompt = u.pm < (MP / BM);
        if (seg == 6) {
            if (wc == 0 && fq < 2) {
                const f32x4 b0 = *(const f32x4*)(bfg + 8 * fq), b1 = *(const f32x4*)(bfg + 8 * fq + 4);
#pragma unroll
                for (int ai = 0; ai < 2; ++ai)
#pragma unroll
                    for (int m = 0; m < 4; ++m) { const int row = row0 + ai * HALF + m * 16;
                        float* dst = prompt ? out + O_PFL + (size_t)row * NHG + 8 * fq : out + O_SFL + (size_t)(row - MP) * NHG + 8 * fq;
                        const f32x4 v0 = acc[ai][0][m][0] + b0, v1 = acc[ai][0][m][1] + b1; f32x4 r0, r1;
#pragma unroll
                        for (int j = 0; j < 4; ++j) { r0[j] = log_sigmoid_f(v0[j]); r1[j] = log_sigmoid_f(v1[j]); }
                        *(f32x4*)dst = r0; *(f32x4*)(dst + 4) = r1; }
            }
        } else if (seg == 0 || seg == 3) {
            bf16_t* base = QO + (seg == 3 ? WG : 0) + cseg;
#pragma unroll
            for (int ai = 0; ai < 2; ++ai)
#pragma unroll
                for (int m = 0; m < 4; ++m) { bf16_t* rowp = base + (size_t)(row0 + ai * HALF + m * 16) * DM;
#pragma unroll
                    for (int bj = 0; bj < 2; ++bj) { const f32x4 v0 = acc[ai][bj][m][0] * QSCALE, v1 = acc[ai][bj][m][1] * QSCALE;
                        v4u w; w.x = cvt_pk_bf16(v0[0], v0[1]); w.y = cvt_pk_bf16(v0[2], v0[3]); w.z = cvt_pk_bf16(v1[0], v1[1]); w.w = cvt_pk_bf16(v1[2], v1[3]);
                        *(v4u*)(rowp + bj * HALF) = w; } }
        } else {
            const int kvi = (seg == 1) ? 0 : (seg == 2) ? 1 : (seg == 4) ? 2 : 3;
            bf16_t* kvb = KV + (size_t)kvi * (KV_STRIDE / 2) + cseg;
            float* ob = out + (prompt ? O_PFK + (size_t)kvi * ((size_t)MP * WG) + (kvi >= 2 ? (size_t)MP * NHG : 0)
                                      : O_SFK + (size_t)kvi * ((size_t)MS * WG) + (kvi >= 2 ? (size_t)MS * NHG : 0)) + cseg;
#pragma unroll
            for (int ai = 0; ai < 2; ++ai)
#pragma unroll
                for (int m = 0; m < 4; ++m) { const int row = row0 + ai * HALF + m * 16; const int rs = row - MP;
                    const int kvrow = prompt ? row : MP + (rs >> 5) * TKS + PAST + (rs & 31);
                    const int orow = prompt ? row : rs;
                    bf16_t* rowp = kvb + (size_t)kvrow * WG; float* op = ob + (size_t)orow * WG;
#pragma unroll
                    for (int bj = 0; bj < 2; ++bj) { const f32x4 v0 = acc[ai][bj][m][0], v1 = acc[ai][bj][m][1];
                        v4u w; w.x = cvt_pk_bf16(v0[0], v0[1]); w.y = cvt_pk_bf16(v0[2], v0[3]); w.z = cvt_pk_bf16(v1[0], v1[1]); w.w = cvt_pk_bf16(v1[2], v1[3]);
                        *(v4u*)(rowp + bj * HALF) = w; *(f32x4*)(op + bj * HALF) = v0; *(f32x4*)(op + bj * HALF + 4) = v1; } }
        }
    }
};
struct EpiRes {
    static constexpr bool PERM = false;
    const float* rp; const float* rs; float* out;
    __device__ __forceinline__ void operator()(const f32x4 (&acc)[2][2][4][2], const Unit& u, int wr, int wc, int fr, int fq) const {
        const int row0 = u.pm * BM + wr * 64 + fr, col0 = u.pn * BM + wc * 32 + 4 * fq;
        const bool prompt = u.pm < (MP / BM);
#pragma unroll
        for (int ai = 0; ai < 2; ++ai)
#pragma unroll
            for (int m = 0; m < 4; ++m) { const int row = row0 + ai * HALF + m * 16;
                const float* rr = (prompt ? rp + (size_t)row * DM : rs + (size_t)(row - MP) * DM) + col0; float* op = out + (size_t)row * DM + col0;
                f32x4 rv[2][2];
#pragma unroll
                for (int bj = 0; bj < 2; ++bj)
#pragma unroll
                    for (int n = 0; n < 2; ++n) rv[bj][n] = *(const f32x4*)(rr + bj * HALF + n * 16);
#pragma unroll
                for (int bj = 0; bj < 2; ++bj)
#pragma unroll
                    for (int n = 0; n < 2; ++n) *(f32x4*)(op + bj * HALF + n * 16) = acc[ai][bj][m][n] + rv[bj][n]; }
    }
};
struct EpiGlu {
    static constexpr bool PERM = true;
    bf16_t* ACT;
    __device__ __forceinline__ void operator()(const f32x4 (&acc)[2][2][4][2], const Unit& u, int wr, int wc, int fr, int fq) const {
        const int row0 = u.pm * BM + wr * 64 + fr, col0 = u.pn * HALF + wc * 32 + 8 * fq;
#pragma unroll
        for (int ai = 0; ai < 2; ++ai)
#pragma unroll
            for (int m = 0; m < 4; ++m) { bf16_t* rowp = ACT + (size_t)(row0 + ai * HALF + m * 16) * DFF + col0; float r[8];
#pragma unroll
                for (int n = 0; n < 2; ++n)
#pragma unroll
                    for (int j = 0; j < 4; ++j) { const float g = acc[ai][0][m][n][j], up = acc[ai][1][m][n][j];
                        r[n * 4 + j] = g * __builtin_amdgcn_rcpf(1.0f + __builtin_amdgcn_exp2f(-g * LOG2E)) * up; }
                v4u w; w.x = cvt_pk_bf16(r[0], r[1]); w.y = cvt_pk_bf16(r[2], r[3]); w.z = cvt_pk_bf16(r[4], r[5]); w.w = cvt_pk_bf16(r[6], r[7]);
                *(v4u*)rowp = w; }
    }
};
}

namespace att {
constexpr int SHM_V = 16384, SHM_K = 16384;
constexpr int OFF_V = 0, OFF_K = 2 * SHM_V, OFF_WS = 4 * 16384, OFF_U = OFF_WS + NWAVES * 256, OFF_SCAN = OFF_U + (2048 + 64) * 4, ATT_LDS = OFF_SCAN + 64;
static_assert(ATT_LDS <= RING_BYTES, "attention LDS");
#define KSWZ(row, colB) ((row) * 256 + ((colB) ^ (((row) & 7) << 4)))
#define SBAR() __builtin_amdgcn_sched_barrier(0)
__device__ __forceinline__ int slot32(int k) { return (k & 3) | (((k >> 2) & 3) << 3) | (((k >> 4) & 1) << 2); }
__device__ __forceinline__ int v_st(int k, int c) { const int kk = (k & ~0xC) | ((k & 4) << 1) | ((k & 8) >> 1); return ((kk >> 3) * 4 + (c >> 5)) * 512 + ((kk & 7) * 32 + (c & 31)) * 2; }
__device__ __forceinline__ int v_rd_base(int lane) { return ((lane & 3) << 3) | (((lane >> 2) & 3) << 6) | (((lane >> 4) & 1) << 5) | (((lane >> 5) & 1) << 8); }
constexpr int v_rd_off(int d0, int ks, int half) { return d0 * 512 + ks * 4096 + half * 2048; }
__device__ __forceinline__ int crow(int r, int hi) { return (r & 3) + 8 * (r >> 2) + 4 * hi; }
__device__ __forceinline__ float partner(float x, int hi) { auto rr = __builtin_amdgcn_permlane32_swap(__float_as_uint(x), __float_as_uint(x), false, false); return __uint_as_float(hi ? rr[0] : rr[1]); }

__device__ __forceinline__ void qkt(f32x16& p0, f32x16& p1, LAS const unsigned char* Kt, int r32, int hi, const bf16x8* qr) {
    p0 = f32x16{}; p1 = f32x16{};
    LAS const unsigned char* kb[4];
#pragma unroll
    for (int dd = 0; dd < 4; ++dd) kb[dd] = Kt + KSWZ(r32, (dd * 16 + hi * 8) * 2);
#pragma unroll
    for (int d0 = 0; d0 < 8; ++d0) { LAS const unsigned char* a = kb[d0 & 3] + (d0 >> 2) * 128;
        const bf16x8 b0 = *(LAS const bf16x8*)a;
        const bf16x8 b1 = *(LAS const bf16x8*)(a + 32 * 256);
        p0 = __builtin_amdgcn_mfma_f32_32x32x16_bf16(b0, qr[d0], p0, 0, 0, 0);
        p1 = __builtin_amdgcn_mfma_f32_32x32x16_bf16(b1, qr[d0], p1, 0, 0, 0); }
}
__device__ __forceinline__ void pv_tile(f32x16* o, int vb0, bf16x8 pa0, bf16x8 pa1, bf16x8 pa2, bf16x8 pa3) {
#define TRRD(dst, off) asm volatile("ds_read_b64_tr_b16 %0, %1 offset:%2" : "=&v"(dst) : "v"(vb0), "i"(off) : "memory")
#define PV_D0(d0) do { s16x4 l0, l1, l2, l3, h0, h1, h2, h3; constexpr int b_ = v_rd_off(d0, 0, 0); \
        TRRD(l0, b_); TRRD(h0, b_ + 2048); TRRD(l1, b_ + 4096); TRRD(h1, b_ + 6144); TRRD(l2, b_ + 8192); TRRD(h2, b_ + 10240); TRRD(l3, b_ + 12288); TRRD(h3, b_ + 14336); \
        asm volatile("s_waitcnt lgkmcnt(0)" ::: "memory"); SBAR(); \
        o[d0] = __builtin_amdgcn_mfma_f32_32x32x16_bf16(pa0, (bf16x8){l0[0], l0[1], l0[2], l0[3], h0[0], h0[1], h0[2], h0[3]}, o[d0], 0, 0, 0); \
        o[d0] = __builtin_amdgcn_mfma_f32_32x32x16_bf16(pa1, (bf16x8){l1[0], l1[1], l1[2], l1[3], h1[0], h1[1], h1[2], h1[3]}, o[d0], 0, 0, 0); \
        o[d0] = __builtin_amdgcn_mfma_f32_32x32x16_bf16(pa2, (bf16x8){l2[0], l2[1], l2[2], l2[3], h2[0], h2[1], h2[2], h2[3]}, o[d0], 0, 0, 0); \
        o[d0] = __builtin_amdgcn_mfma_f32_32x32x16_bf16(pa3, (bf16x8){l3[0], l3[1], l3[2], l3[3], h3[0], h3[1], h3[2], h3[3]}, o[d0], 0, 0, 0); } while (0)
    PV_D0(0); PV_D0(1); PV_D0(2); PV_D0(3);
#undef PV_D0
#undef TRRD
}
#define PK4(P, B_, OUT) do { unsigned a0 = cvt_pk_bf16(P[B_+0], P[B_+1]), a1 = cvt_pk_bf16(P[B_+2], P[B_+3]); \
        unsigned b0 = cvt_pk_bf16(P[B_+4], P[B_+5]), b1 = cvt_pk_bf16(P[B_+6], P[B_+7]); \
        auto r0 = __builtin_amdgcn_permlane32_swap(a0, b0, false, false); auto r1 = __builtin_amdgcn_permlane32_swap(a1, b1, false, false); \
        v4u w = {r0[0], r1[0], r0[1], r1[1]}; OUT = __builtin_bit_cast(bf16x8, w); } while (0)

template <class F> __device__ __forceinline__ void scan_u(LAS float* U, LAS float* scan, int n, F lf) {
    const int tid = threadIdx.x, lane = tid & 63, wid = tid >> 6, t0 = 4 * tid;
    float v0 = t0 < n ? lf(t0) : 0.f, v1 = t0 + 1 < n ? lf(t0 + 1) : 0.f, v2 = t0 + 2 < n ? lf(t0 + 2) : 0.f, v3 = t0 + 3 < n ? lf(t0 + 3) : 0.f;
    v1 += v0; v2 += v1; v3 += v2;
    float x = v3;
#pragma unroll
    for (int o = 1; o < 64; o <<= 1) { const float y = __shfl_up(x, o); if (lane >= o) x += y; }
    if (lane == 63) scan[wid] = x;
    __syncthreads();
    float pre = x - v3;
    for (int w = 0; w < wid; ++w) pre += scan[w];
    f32x4 r = {-(v0 + pre) * LOG2E, -(v1 + pre) * LOG2E, -(v2 + pre) * LOG2E, -(v3 + pre) * LOG2E};
    *(LAS f32x4*)(U + t0) = r;
    __syncthreads();
}

__device__ __forceinline__ int islot(int rho) { return (rho & 0x23) | (((rho >> 3) & 3) << 2) | (((rho >> 2) & 1) << 4); }
template <int MODE>
__device__ __forceinline__ void attn_unit(LAS unsigned char* lds, const bf16* Q, const bf16* K, const bf16* V, bf16* O, int P0, int Tk, int nact) {
    const int tid = threadIdx.x, wid = __builtin_amdgcn_readfirstlane(tid >> 6), lane = tid & 63, r32 = lane & 31, hi = lane >> 5;
    const bool active = wid < nact;
    const int nrows = 32 * nact;
    const int NT = (P0 + nrows + 63) >> 6;
    LAS unsigned char* V_lds = lds + OFF_V; LAS unsigned char* K_lds = lds + OFF_K;
    LAS float* wsf = (LAS float*)(lds + OFF_WS) + wid * 64; LAS float* li_l = wsf; LAS float* al_l = wsf + 32;
    LAS const float* U = (LAS const float*)(lds + OFF_U);
    int kkey[2], kcol[2], vkey[2], vcol[2];
#pragma unroll
    for (int i = 0; i < 2; ++i) {
        const int q = wid * 2 + i;
        { const int rho = q * 4 + (lane >> 4), cpos = lane & 15; kkey[i] = islot(rho); kcol[i] = (cpos ^ (rho & 7)) * 8; }
        { const int sub = q * 2 + (lane >> 5), kk = (sub >> 2) * 8 + ((lane & 31) >> 2), ks = (kk & ~0xC) | ((kk & 4) << 1) | ((kk & 8) >> 1); vkey[i] = islot(ks); vcol[i] = (sub & 3) * 32 + (lane & 3) * 8; }
    }
    const int vb0 = (int)(size_t)V_lds + v_rd_base(lane);
    const int qlo = P0 + wid * 32, tq = qlo + r32;
    bf16x8 qr[8];
    if (active) {
#pragma unroll
        for (int d0 = 0; d0 < 8; ++d0) qr[d0] = *(const bf16x8*)(Q + (size_t)(wid * 32 + r32) * DM + d0 * 16 + hi * 8);
    } else {
#pragma unroll
        for (int d0 = 0; d0 < 8; ++d0) qr[d0] = bf16x8{};
    }
#define TILE_OF(t) (MODE == 0 ? (t) : NT - 1 - (t))
#define STAGE(j, bf) do { _Pragma("unroll") for (int _i = 0; _i < 2; ++_i) { \
        int kk_ = (j) * 64 + kkey[_i]; kk_ = kk_ < Tk ? kk_ : Tk - 1; int vk_ = (j) * 64 + vkey[_i]; vk_ = vk_ < Tk ? vk_ : Tk - 1; \
        __builtin_amdgcn_global_load_lds((const unsigned*)(K + (size_t)kk_ * WG + kcol[_i]), (LAS unsigned*)(K_lds + (bf) * SHM_K + (wid * 2 + _i) * 1024), 16, 0, 0); \
        __builtin_amdgcn_global_load_lds((const unsigned*)(V + (size_t)vk_ * WG + vcol[_i]), (LAS unsigned*)(V_lds + (bf) * SHM_V + (wid * 2 + _i) * 1024), 16, 0, 0); } } while (0)
    STAGE(TILE_OF(0), 0); VM_WAIT();
    __syncthreads();
    float m_reg = -1e30f, l_reg = 0.f, carry = 0.f;
    f32x16 o[4] = {};
    for (int t = 0; t < NT; ++t) {
        const int j = TILE_OF(t), kb = j * 64, bufo = (t & 1) * SHM_K;
        if (t + 1 < NT) STAGE(TILE_OF(t + 1), (t + 1) & 1);
        if (active && kb <= qlo + 31) {
            f32x16 p0, p1;
            qkt(p0, p1, K_lds + bufo, r32, hi, qr);
            bf16x8 pa0, pa1, pa2, pa3;
            const int dq = tq - kb - 16 * hi;
            const bool need_mask = kb + 63 >= qlo;
            if (MODE == 0) {
                LAS const f32x4* up0 = (LAS const f32x4*)(U + kb + 16 * hi); LAS const f32x4* up1 = (LAS const f32x4*)(U + kb + 32 + 16 * hi);
#pragma unroll
                for (int g = 0; g < 4; ++g) { const f32x4 a = up0[g], b = up1[g];
#pragma unroll
                    for (int jj = 0; jj < 4; ++jj) { p0[4 * g + jj] += a[jj]; p1[4 * g + jj] += b[jj]; } }
                if (need_mask) { const float NEG = -__builtin_inff();
#pragma unroll
                    for (int r = 0; r < 16; ++r) { if (r > dq) p0[r] = NEG; if (r + 32 > dq) p1[r] = NEG; } }
                float pmax = p0[0];
#pragma unroll
                for (int r = 1; r < 16; ++r) pmax = fmaxf(pmax, p0[r]);
#pragma unroll
                for (int r = 0; r < 16; ++r) pmax = fmaxf(pmax, p1[r]);
                pmax = fmaxf(pmax, partner(pmax, hi));
                const float mn = fmaxf(m_reg, pmax);
                const float alpha = __builtin_amdgcn_exp2f(m_reg - mn);
                m_reg = mn;
                float ps = 0.f;
#pragma unroll
                for (int r = 0; r < 16; ++r) { p0[r] = __builtin_amdgcn_exp2f(p0[r] - mn); p1[r] = __builtin_amdgcn_exp2f(p1[r] - mn); ps += p0[r] + p1[r]; }
                ps += partner(ps, hi);
                l_reg = l_reg * alpha + ps;
                if (hi == 0) al_l[r32] = alpha;
                LDS_WAIT();
#pragma unroll
                for (int g = 0; g < 4; ++g) { const f32x4 a = *(LAS const f32x4*)(al_l + 8 * g + 4 * hi);
#pragma unroll
                    for (int jj = 0; jj < 4; ++jj)
#pragma unroll
                        for (int d_ = 0; d_ < 4; ++d_) o[d_][4 * g + jj] *= a[jj]; }
            } else {
                f32x16 l1;
#pragma unroll
                for (int r = 0; r < 16; ++r) l1[r] = -(fmaxf(p1[r], 0.f) + __builtin_amdgcn_logf(1.0f + __builtin_amdgcn_exp2f(-fabsf(p1[r]))));
                if (need_mask) {
#pragma unroll
                    for (int r = 0; r < 16; ++r) if (r + 32 >= dq) l1[r] = 0.f; }
#pragma unroll
                for (int r = 14; r >= 0; --r) l1[r] += l1[r + 1];
                const float T1 = l1[0], oT1 = partner(T1, hi);
                const float off1 = carry + (hi ? 0.f : oT1);
#pragma unroll
                for (int r = 0; r < 16; ++r) p1[r] = __builtin_amdgcn_exp2f(p1[r] + l1[r] + off1);
                if (need_mask) {
#pragma unroll
                    for (int r = 0; r < 16; ++r) if (r + 32 >= dq) p1[r] = 0.f; }
                f32x16 l0;
#pragma unroll
                for (int r = 0; r < 16; ++r) l0[r] = -(fmaxf(p0[r], 0.f) + __builtin_amdgcn_logf(1.0f + __builtin_amdgcn_exp2f(-fabsf(p0[r]))));
                if (need_mask) {
#pragma unroll
                    for (int r = 0; r < 16; ++r) if (r >= dq) l0[r] = 0.f; }
#pragma unroll
                for (int r = 14; r >= 0; --r) l0[r] += l0[r + 1];
                const float T0 = l0[0], oT0 = partner(T0, hi);
                const float off0 = carry + T1 + oT1 + (hi ? 0.f : oT0);
                carry += (T0 + oT0) + (T1 + oT1);
#pragma unroll
                for (int r = 0; r < 16; ++r) p0[r] = __builtin_amdgcn_exp2f(p0[r] + l0[r] + off0);
                if (need_mask) {
#pragma unroll
                    for (int r = 0; r < 16; ++r) if (r >= dq) p0[r] = 0.f; }
            }
            PK4(p0, 0, pa0); PK4(p0, 8, pa1); PK4(p1, 0, pa2); PK4(p1, 8, pa3);
            pv_tile(o, vb0 + bufo, pa0, pa1, pa2, pa3);
        }
        VM_WAIT();
        __syncthreads();
    }
    if (active) {
        if (MODE == 0) {
            if (hi == 0) li_l[r32] = 1.0f / l_reg;
            LDS_WAIT();
#pragma unroll
            for (int g = 0; g < 4; ++g) { const f32x4 a = *(LAS const f32x4*)(li_l + 8 * g + 4 * hi);
#pragma unroll
                for (int jj = 0; jj < 4; ++jj)
#pragma unroll
                    for (int d_ = 0; d_ < 4; ++d_) o[d_][4 * g + jj] *= a[jj]; }
        }
        bf16* Ow = O + (size_t)(wid * 32) * DM;
#pragma unroll
        for (int r = 0; r < 16; ++r) { const int orow = crow(r, hi);
#pragma unroll
            for (int d0 = 0; d0 < 4; ++d0) { const float v = o[d0][r]; const float vn = __shfl_xor(v, 1);
                if ((r32 & 1) == 0) *(unsigned*)(Ow + (size_t)orow * DM + d0 * 32 + r32) = cvt_pk_bf16(v, vn); } }
    }
    __syncthreads();
#undef TILE_OF
#undef STAGE
}
#undef PK4
}

#define XB_TMO      128
#define XB_XCNT(j)  (256  + 64 * (j))
#define XB_XSUB(j)  (1280 + 64 * (j))
#define XB_XGEN(j)  (2304 + 64 * (j))
#define XB_TOP      3328
#define XB_TOPGEN   3392
#define XCD_BAR_WORDS 3456
#define XB_SPIN_CAP (1u << 18)
__device__ __forceinline__ unsigned xb_ld(unsigned* p)              { return __hip_atomic_load(p, __ATOMIC_RELAXED, __HIP_MEMORY_SCOPE_AGENT); }
__device__ __forceinline__ unsigned xb_add(unsigned* p, unsigned v) { return __hip_atomic_fetch_add(p, v, __ATOMIC_RELAXED, __HIP_MEMORY_SCOPE_AGENT); }
__device__ __forceinline__ unsigned xb_xcc_id() { return (unsigned)__builtin_amdgcn_s_getreg((3 << 11) | 20) & 0xFu; }
#define XB_SPIN(cond, bar) do { unsigned _sp = 0; while (cond) { __builtin_amdgcn_s_sleep(1); \
    if ((++_sp & 255u) == 0u) { if (xb_ld(&(bar)[XB_TMO])) break; if (_sp > XB_SPIN_CAP) { atomicAdd(&(bar)[XB_TMO], 1u); break; } } } } while (0)
struct XcdBarrier { unsigned* bar; unsigned x; volatile LAS unsigned* st; };
__device__ __forceinline__ XcdBarrier xcd_barrier_post(unsigned* bar, volatile LAS unsigned* st) {
    XcdBarrier b; b.bar = bar; b.x = xb_xcc_id(); b.st = st;
    if (threadIdx.x == 0) (void)xb_add(&bar[XB_XCNT(b.x)], 1u);
    return b;
}
__device__ __forceinline__ void xcd_barrier_complete(unsigned* bar, unsigned x, unsigned& nloc, unsigned& nx) {
    const unsigned G = gridDim.x * gridDim.y * gridDim.z;
    unsigned sum, cnt, mine, sp = 0u;
    for (;;) {
        sum = 0u; cnt = 0u; mine = 0u;
#pragma unroll
        for (unsigned j = 0; j < 16; ++j) { const unsigned c = xb_ld(&bar[XB_XCNT(j)]); sum += c; cnt += (c > 0u) ? 1u : 0u; mine = (j == x) ? c : mine; }
        if (sum == G) break;
        __builtin_amdgcn_s_sleep(1);
        if ((++sp & 255u) == 0u) { if (xb_ld(&bar[XB_TMO])) break; if (sp > XB_SPIN_CAP) { atomicAdd(&bar[XB_TMO], 1u); break; } }
    }
    nloc = mine > 0u ? mine : 1u; nx = cnt > 0u ? cnt : 1u;
}
__device__ __forceinline__ void xcd_barrier(const XcdBarrier& b) {
    asm volatile("s_waitcnt vmcnt(0)" ::: "memory");
    __syncthreads();
    if (threadIdx.x == 0) {
        unsigned* bar = b.bar;
        __builtin_amdgcn_s_waitcnt(0);
        unsigned nloc = b.st[0], nx = b.st[1];
        if (nloc == 0u) { xcd_barrier_complete(bar, b.x, nloc, nx); b.st[0] = nloc; b.st[1] = nx; }
        const unsigned old = xb_add(&bar[XB_XSUB(b.x)], 1u);
        const unsigned gen = old / nloc;
        if (old + 1u == (gen + 1u) * nloc) {
            __builtin_amdgcn_fence(__ATOMIC_RELEASE, "agent");
            asm volatile("s_waitcnt vmcnt(0)" ::: "memory");
            const unsigned og = xb_add(&bar[XB_TOP], 1u);
            const unsigned tg = og / nx;
            if (og + 1u == (tg + 1u) * nx) xb_add(&bar[XB_TOPGEN], 1u);
            else XB_SPIN(xb_ld(&bar[XB_TOPGEN]) == tg, bar);
            __builtin_amdgcn_fence(__ATOMIC_ACQUIRE, "agent");
            xb_add(&bar[XB_XGEN(b.x)], 1u);
            asm volatile("s_waitcnt vmcnt(0)" ::: "memory");
        } else {
            XB_SPIN(xb_ld(&bar[XB_XGEN(b.x)]) == gen, bar);
            __builtin_amdgcn_fence(__ATOMIC_ACQUIRE, "agent");
            asm volatile("s_waitcnt vmcnt(0)" ::: "memory");
        }
    }
    __syncthreads();
}

struct Args { const float* in[18]; float* out; unsigned char* ws; int ph_lo, ph_hi; };

__device__ __forceinline__ float wave_sum(float v) {
#pragma unroll
    for (int o = 1; o < 64; o <<= 1) v += __shfl_xor(v, o);
    return v;
}
__device__ __forceinline__ void tr_item(const float* W, int ldw, int K, int k0, int nsrc0, int ncols, bf16* WT, int drow0, LAS float* scr, int lane) {
    const int c = lane & 31;
#pragma unroll 8
    for (int i = 0; i < 32; ++i) { const int kk = 2 * i + (lane >> 5); scr[kk * 33 + c] = (c < ncols) ? W[(size_t)(k0 + kk) * ldw + nsrc0 + c] : 0.f; }
    LDS_WAIT(); asm volatile("" ::: "memory");
    const int c8 = lane & 7;
#pragma unroll
    for (int j = 0; j < 4; ++j) { const int n = (lane >> 3) + 8 * j; const LAS float* s = scr + (8 * c8) * 33 + n;
        v4u o; o.x = cvt_pk_bf16(s[0 * 33], s[1 * 33]); o.y = cvt_pk_bf16(s[2 * 33], s[3 * 33]); o.z = cvt_pk_bf16(s[4 * 33], s[5 * 33]); o.w = cvt_pk_bf16(s[6 * 33], s[7 * 33]);
        if (n < ncols) *(GAS v4u*)(WT + (size_t)(drow0 + n) * K + k0 + 8 * c8) = o; }
    LDS_WAIT(); asm volatile("" ::: "memory");
}
__device__ __forceinline__ void rms_row_bf16(const float* xrow, const float* g, bf16* orow, int lane) {
    const f32x4* xr = (const f32x4*)xrow + lane; const f32x4* gr = (const f32x4*)g + lane;
    f32x4 v[16]; float s = 0.f;
#pragma unroll
    for (int j = 0; j < 16; ++j) { v[j] = xr[64 * j]; s += (v[j].x * v[j].x + v[j].y * v[j].y) + (v[j].z * v[j].z + v[j].w * v[j].w); }
    const float rstd = rsqrtf(wave_sum(s) * (1.f / DM) + EPS);
    v2u* o8 = (v2u*)orow + lane;
#pragma unroll
    for (int j = 0; j < 16; ++j) { const f32x4 gg = gr[64 * j]; v2u w; w.x = cvt_pk_bf16(v[j].x * rstd * gg.x, v[j].y * rstd * gg.y); w.y = cvt_pk_bf16(v[j].z * rstd * gg.z, v[j].w * rstd * gg.w); o8[64 * j] = w; }
}
__device__ __forceinline__ float bf_lo(unsigned w) { return __uint_as_float(w << 16); }
__device__ __forceinline__ float bf_hi(unsigned w) { return __uint_as_float(w & 0xffff0000u); }

__global__ void __launch_bounds__(NWAVES * 64, 2) fwd_kernel(Args args) {
    extern __shared__ __attribute__((aligned(16))) unsigned char lds_raw[];
    LAS unsigned char* lds = (LAS unsigned char*)lds_raw;
    volatile LAS unsigned* MISC = (volatile LAS unsigned*)(lds + MISC_OFF);
    const int tid = threadIdx.x, lane = tid & 63, wave = __builtin_amdgcn_readfirstlane(tid >> 6);
    const int G = gridDim.x; const int bx = blockIdx.x; const int vcu = (G % 8 == 0) ? (bx % 8) * (G / 8) + bx / 8 : bx;
    unsigned char* ws = args.ws; float* out = args.out;
    gu32* ctl = (gu32*)(ws + WS_CTL);
    const float* x_prompt = args.in[0]; const float* x_sample = args.in[1];
    const float* cache_fk = args.in[2]; const float* cache_fv = args.in[3]; const float* cache_fl = args.in[4]; const float* cache_sk = args.in[5]; const float* cache_sv = args.in[6];
    const float* g_attn = args.in[7]; const float* w_in = args.in[8]; const float* b_forget = args.in[9]; const float* g_of = args.in[10]; const float* g_os = args.in[11];
    const float* w_out = args.in[12]; const float* g_ffn = args.in[13]; const float* w_gate = args.in[14]; const float* w_up = args.in[15]; const float* w_down = args.in[16]; const float* g_final = args.in[17];
    bf16* Win_t = (bf16*)(ws + WS_WIN); bf16* Wout_t = (bf16*)(ws + WS_WOUT); bf16* Wgu_t = (bf16*)(ws + WS_WGU); bf16* Wdn_t = (bf16*)(ws + WS_WDN);
    bf16* XN = (bf16*)(ws + WS_XN); bf16* QO = (bf16*)(ws + WS_QO); bf16* KVB = (bf16*)(ws + WS_KV); bf16* ACT = (bf16*)(ws + WS_ACT);

    for (int u = tid; u < (LDS_BYTES - LDSCTL_OFF) / 4; u += NWAVES * 64) ((LAS unsigned*)(lds + LDSCTL_OFF))[u] = 0u;
    __syncthreads();
    XcdBarrier bar; bar.bar = (unsigned*)(ctl + CW_BAR); bar.x = 0; bar.st = nullptr;
    if (MK_N_LAUNCHES == 1) bar = xcd_barrier_post((unsigned*)(ctl + CW_BAR), MISC + 8);
    const int lo = args.ph_lo, hi_ph = args.ph_hi;
#ifndef PH_MASK
#define PH_MASK 0x1ff
#endif
#define IN(k) (((PH_MASK >> (k)) & 1) && lo <= (k) && (k) < hi_ph)
#define BOTH(k) (IN(k) && IN((k) + 1))
#define GRID_BAR() do { if (MK_N_LAUNCHES == 1) xcd_barrier(bar); } while (0)
    const int gw = vcu * NWAVES + wave, NGW = G * NWAVES;

    if (IN(0)) {
        LAS float* scr = (LAS float*)(lds + RING_OFF + wave * 16384);
        constexpr int KB4 = DM / 64;
        constexpr int I_INA = KB4 * (3 * WG / 32), I_INB = I_INA, I_FL = KB4, I_OUT = KB4 * (DM / 32), I_G = KB4 * (DFF / 32), I_U = I_G, I_D = (DFF / 64) * (DM / 32);
        constexpr int NITEMS = I_INA + I_INB + I_FL + I_OUT + I_G + I_U + I_D;
        for (int it = gw; it < NITEMS; it += NGW) {
            int r = it;
            if (r < I_INA) { const int kb = r / 192, nb = r % 192; tr_item(w_in, DIN, DM, 64 * kb, 32 * nb, 32, Win_t, 32 * nb, scr, lane); continue; } r -= I_INA;
            if (r < I_INB) { const int kb = r / 192, nb = r % 192; tr_item(w_in, DIN, DM, 64 * kb, 3 * WG + NHG + 32 * nb, 32, Win_t, 3 * WG + 32 * nb, scr, lane); continue; } r -= I_INB;
            if (r < I_FL) { tr_item(w_in, DIN, DM, 64 * r, 3 * WG, 16, Win_t, 6 * WG, scr, lane); continue; } r -= I_FL;
            if (r < I_OUT) { const int kb = r / 128, nb = r % 128; tr_item(w_out, DM, DM, 64 * kb, 32 * nb, 32, Wout_t, 32 * nb, scr, lane); continue; } r -= I_OUT;
            if (r < I_G) { const int kb = r / 344, nb = r % 344; const int n0 = 32 * nb; tr_item(w_gate, DFF, DM, 64 * kb, n0, 32, Wgu_t, (n0 >> 7) * 256 + (n0 & 127), scr, lane); continue; } r -= I_G;
            if (r < I_U) { const int kb = r / 344, nb = r % 344; const int n0 = 32 * nb; tr_item(w_up, DFF, DM, 64 * kb, n0, 32, Wgu_t, (n0 >> 7) * 256 + 128 + (n0 & 127), scr, lane); continue; } r -= I_U;
            { const int kb = r / 128, nb = r % 128; tr_item(w_down, DM, DFF, 64 * kb, 32 * nb, 32, Wdn_t, 32 * nb, scr, lane); }
        }
        for (int i = gw * 64 + lane; i < 240 * DM / 8; i += NGW * 64) *(v4u*)(Win_t + (size_t)(6 * WG + 16) * DM + (size_t)i * 8) = (v4u){0u, 0u, 0u, 0u};
        for (int m = gw; m < MT; m += NGW) rms_row_bf16(m < MP ? x_prompt + (size_t)m * DM : x_sample + (size_t)(m - MP) * DM, g_attn, XN + (size_t)m * DM, lane);
        for (int it = gw; it < 4 * DB * PAST; it += NGW) { const int kvi = it / (DB * PAST), rr = it % (DB * PAST), b = rr / PAST, t = rr % PAST;
            const float* src = (kvi == 0 ? cache_fk : kvi == 1 ? cache_fv : kvi == 2 ? cache_sk : cache_sv) + (size_t)rr * WG;
            bf16* dst = KVB + (size_t)kvi * (KV_STRIDE / 2) + (size_t)(MP + b * TKS + t) * WG;
#pragma unroll
            for (int j = 0; j < 8; ++j) { const f32x4 v = ((const f32x4*)src)[lane + 64 * j]; v2u w; w.x = cvt_pk_bf16(v.x, v.y); w.y = cvt_pk_bf16(v.z, v.w); ((v2u*)dst)[lane + 64 * j] = w; } }
        if (BOTH(0)) GRID_BAR();
    }

    if (IN(1)) {
        pg8::Gemm g{XN, Win_t, MT, NIN, DM}; pg8::StaticOrder S; S.init(MT, NIN, G, bx);
        pg8::EpiIn E{QO, KVB, out, b_forget};
        pg8::gemm_phase<pg8::EpiIn, pg8::StaticOrder, true, true>(lds + RING_OFF, g, S, E);
        if (BOTH(1)) GRID_BAR();
    }

    if (IN(2)) {
        LAS float* U = (LAS float*)(lds + att::OFF_U); LAS float* scn = (LAS float*)(lds + att::OFF_SCAN);
        constexpr int N_ITEMS = 512 + 512 + 256 + 256;
        for (int it = vcu; it < N_ITEMS; it += G) {
            if (it < 1024) {
                const int mode = it >> 9, r = it & 511, bh = r >> 2, pi = r & 3, b = bh >> 4, h = bh & 15;
                const bf16* Kp = KVB + (size_t)(mode * 2) * (KV_STRIDE / 2) + (size_t)(b * SEQ) * WG + h * HD;
                const bf16* Vp = Kp + (KV_STRIDE / 2);
                bf16* Qp = QO + (size_t)(b * SEQ) * DM + mode * WG + h * HD;
                if (mode == 0) {
                    const float* lf = out + O_PFL + (size_t)(b * SEQ) * NHG + h;
                    att::scan_u(U, scn, SEQ, [&](int t) { return lf[(size_t)t * NHG]; });
                }
#pragma unroll 1
                for (int pass = 0; pass < 2; ++pass) { const int qb = pass ? 7 - pi : pi; bf16* Qb = Qp + (size_t)(qb * 256) * DM;
#ifndef NO_FOX
                    if (mode == 0) att::attn_unit<0>(lds + RING_OFF, Qb, Kp, Vp, Qb, qb * 256, SEQ, 8);
#endif
#ifndef NO_SB
                    if (mode == 1) att::attn_unit<1>(lds + RING_OFF, Qb, Kp, Vp, Qb, qb * 256, SEQ, 8);
#endif
 }
            } else {
                const int r = it - 1024, mode = r >> 8, bh = r & 255, b = bh >> 4, h = bh & 15;
                const bf16* Kp = KVB + (size_t)(mode * 2) * (KV_STRIDE / 2) + (size_t)(MP + b * TKS) * WG + h * HD;
                const bf16* Vp = Kp + (KV_STRIDE / 2);
                bf16* Qb = QO + (size_t)(MP + b * DS) * DM + mode * WG + h * HD;
                if (mode == 0) {
                    const float* lfc = cache_fl + (size_t)(b * PAST) * NHG + h; const float* lfn = out + O_SFL + (size_t)(b * DS) * NHG + h;
                    att::scan_u(U, scn, TKS, [&](int t) { return t < PAST ? lfc[(size_t)t * NHG] : lfn[(size_t)(t - PAST) * NHG]; });
#ifndef NO_FOX
                    att::attn_unit<0>(lds + RING_OFF, Qb, Kp, Vp, Qb, PAST, TKS, 1);
#endif
                } else {
#ifndef NO_SB
                    att::attn_unit<1>(lds + RING_OFF, Qb, Kp, Vp, Qb, PAST, TKS, 1);
#endif
                }
            }
        }
        if (BOTH(2)) GRID_BAR();
    }

    if (IN(3)) {
        for (int m = gw; m < MT; m += NGW) { v4u* row = (v4u*)(QO + (size_t)m * DM) + lane;
            v4u v[8]; float sf = 0.f, ss = 0.f;
#pragma unroll
            for (int j = 0; j < 8; ++j) { v[j] = row[64 * j]; float s = 0.f;
#pragma unroll
                for (int e = 0; e < 4; ++e) { const float a = bf_lo(v[j][e]), b = bf_hi(v[j][e]); s += a * a + b * b; }
                if (j < 4) sf += s; else ss += s; }
            const float rf = rsqrtf(wave_sum(sf) * (1.f / WG) + EPS), rs = rsqrtf(wave_sum(ss) * (1.f / WG) + EPS);
#pragma unroll
            for (int j = 0; j < 8; ++j) { const float rr = j < 4 ? rf : rs; const float* gp = (j < 4 ? g_of : g_os) + (lane + 64 * (j & 3)) * 8;
                const f32x4 g0 = *(const f32x4*)gp, g1 = *(const f32x4*)(gp + 4); v4u w;
                w.x = cvt_pk_bf16(bf_lo(v[j].x) * rr * g0.x, bf_hi(v[j].x) * rr * g0.y); w.y = cvt_pk_bf16(bf_lo(v[j].y) * rr * g0.z, bf_hi(v[j].y) * rr * g0.w);
                w.z = cvt_pk_bf16(bf_lo(v[j].z) * rr * g1.x, bf_hi(v[j].z) * rr * g1.y); w.w = cvt_pk_bf16(bf_lo(v[j].w) * rr * g1.z, bf_hi(v[j].w) * rr * g1.w);
                row[64 * j] = w; } }
        if (BOTH(3)) GRID_BAR();
    }

    if (IN(4)) {
        pg8::Gemm g{QO, Wout_t, MT, DM, DM}; pg8::StaticOrder S; S.init(MT, DM, G, bx);
        pg8::EpiRes E{x_prompt, x_sample, out};
        pg8::gemm_phase<pg8::EpiRes, pg8::StaticOrder, true, true>(lds + RING_OFF, g, S, E);
        if (BOTH(4)) GRID_BAR();
    }

    if (IN(5)) {
        for (int m = gw; m < MT; m += NGW) rms_row_bf16(out + (size_t)m * DM, g_ffn, XN + (size_t)m * DM, lane);
        if (BOTH(5)) GRID_BAR();
    }

    if (IN(6)) {
        pg8::Gemm g{XN, Wgu_t, MT, 2 * DFF, DM}; pg8::StaticOrder S; S.init(MT, 2 * DFF, G, bx);
        pg8::EpiGlu E{ACT};
        pg8::gemm_phase<pg8::EpiGlu, pg8::StaticOrder, true, true>(lds + RING_OFF, g, S, E);
        if (BOTH(6)) GRID_BAR();
    }

    if (IN(7)) {
        pg8::Gemm g{ACT, Wdn_t, MT, DM, DFF}; pg8::StaticOrder S; S.init(MT, DM, G, bx);
        pg8::EpiRes E{out, out + (size_t)MP * DM, out};
        pg8::gemm_phase<pg8::EpiRes, pg8::StaticOrder, true, true>(lds + RING_OFF, g, S, E);
        if (BOTH(7)) GRID_BAR();
    }

    if (IN(8)) {
        for (int m = gw; m < MT; m += NGW) { f32x4* xr = (f32x4*)(out + (size_t)m * DM) + lane; const f32x4* gr = (const f32x4*)g_final + lane;
            f32x4 v[16]; float s = 0.f;
#pragma unroll
            for (int j = 0; j < 16; ++j) { v[j] = xr[64 * j]; s += (v[j].x * v[j].x + v[j].y * v[j].y) + (v[j].z * v[j].z + v[j].w * v[j].w); }
            const float rstd = rsqrtf(wave_sum(s) * (1.f / DM) + EPS);
#pragma unroll
            for (int j = 0; j < 16; ++j) { const f32x4 gg = gr[64 * j]; xr[64 * j] = v[j] * rstd * gg; } }
    }
#undef IN
#undef BOTH
#undef GRID_BAR
}

extern "C" void kernel_launch(void* const* d_in, const int* in_sizes, int n_in, void* d_out, int out_size, void* d_ws, size_t ws_size, hipStream_t stream) {
    static int grid = 0;
    if (grid == 0) {
        if (n_in != 18 || (size_t)out_size != O_END || ws_size < WS_END) { fprintf(stderr, "kernel_launch: unexpected shapes (n_in %d, out %d, ws %zu)\n", n_in, out_size, ws_size); grid = -1; return; }
        int dev = 0, cus = 0;
        if (hipGetDevice(&dev) != hipSuccess || hipDeviceGetAttribute(&cus, hipDeviceAttributeMultiprocessorCount, dev) != hipSuccess) { grid = -1; return; }
        if (hipFuncSetAttribute((const void*)fwd_kernel, hipFuncAttributeMaxDynamicSharedMemorySize, LDS_BYTES) != hipSuccess) { fprintf(stderr, "kernel_launch: hipFuncSetAttribute failed\n"); grid = -1; return; }
        int per_cu = 0;
        if (hipOccupancyMaxActiveBlocksPerMultiprocessor(&per_cu, (const void*)fwd_kernel, NWAVES * 64, LDS_BYTES) != hipSuccess || per_cu < 1) fprintf(stderr, "kernel_launch: occupancy query says %d\n", per_cu);
        (void)hipGetLastError();
        grid = cus;
    }
    if (grid < 0) return;
    (void)hipMemsetAsync((char*)d_ws + WS_CTL, 0, CTL_ZERO_BYTES, stream);
    Args a{};
    for (int i = 0; i < 18; ++i) a.in[i] = (const float*)d_in[i];
    a.out = (float*)d_out; a.ws = (unsigned char*)d_ws;
#if MK_N_LAUNCHES == 1
    a.ph_lo = 0; a.ph_hi = 9;
    hipLaunchKernelGGL(fwd_kernel, dim3(grid), dim3(NWAVES * 64), LDS_BYTES, stream, a);
#else
    for (int p = 0; p < 9; ++p) { a.ph_lo = p; a.ph_hi = p + 1; hipLaunchKernelGGL(fwd_kernel, dim3(grid), dim3(NWAVES * 64), LDS_BYTES, stream, a); }
#endif
}
```

```cpp
#include <hip/hip_runtime.h>
#include <cstdio>
#include <cstdint>

#ifndef MK_N_LAUNCHES
#define MK_N_LAUNCHES 1
#endif

#define GAS __attribute__((address_space(1)))
#define LAS __attribute__((address_space(3)))
typedef unsigned short bf16;
typedef unsigned v4u __attribute__((ext_vector_type(4)));
typedef unsigned v2u __attribute__((ext_vector_type(2)));
typedef float f32x4 __attribute__((ext_vector_type(4)));
typedef float f32x16 __attribute__((ext_vector_type(16)));
typedef short bf16x8 __attribute__((ext_vector_type(8)));
typedef short s16x4 __attribute__((ext_vector_type(4)));
typedef GAS unsigned gu32;

constexpr int DM = 4096, NB = 8, SEQ = 2048, DB = 16, DS = 32, PAST = 1024, HD = 128, NHG = 16;
constexpr int WG = NHG * HD;
constexpr int DFF = 11008;
constexpr int MP = NB * SEQ, MS = DB * DS, MT = MP + MS;
constexpr int DIN = 3 * WG + NHG + 3 * WG;
constexpr int NIN = 6 * WG + 256;
constexpr int TKS = PAST + DS;
constexpr int KVROWS = MP + DB * TKS;
constexpr float EPS = 1e-6f;
constexpr float LOG2E = 1.4426950408889634f;
constexpr float QSCALE = 0.08838834764831845f * LOG2E;

constexpr size_t O_YP = 0, O_YS = O_YP + (size_t)MP * DM;
constexpr size_t O_PFK = O_YS + (size_t)MS * DM, O_PFV = O_PFK + (size_t)MP * WG, O_PFL = O_PFV + (size_t)MP * WG;
constexpr size_t O_PSK = O_PFL + (size_t)MP * NHG, O_PSV = O_PSK + (size_t)MP * WG;
constexpr size_t O_SFK = O_PSV + (size_t)MP * WG, O_SFV = O_SFK + (size_t)MS * WG, O_SFL = O_SFV + (size_t)MS * WG;
constexpr size_t O_SSK = O_SFL + (size_t)MS * NHG, O_SSV = O_SSK + (size_t)MS * WG, O_END = O_SSV + (size_t)MS * WG;

constexpr size_t MiB = 1u << 20;
constexpr size_t WS_CTL = 0, CTL_ZERO_BYTES = 1 * MiB;
constexpr size_t WS_WIN = 2 * MiB;
constexpr size_t WS_WOUT = 100 * MiB;
constexpr size_t WS_WGU = 132 * MiB;
constexpr size_t WS_WDN = 304 * MiB;
constexpr size_t WS_XN = 390 * MiB;
constexpr size_t WS_QO = 522 * MiB;
constexpr size_t WS_KV = 654 * MiB, KV_STRIDE = 130 * MiB;
constexpr size_t WS_ACT = 654 * MiB;
constexpr size_t WS_END = 1174 * MiB;
static_assert((size_t)NIN * DM * 2 == 98 * MiB && (size_t)2 * DFF * DM * 2 == 172 * MiB && (size_t)DM * DFF * 2 == 86 * MiB && (size_t)MT * DM * 2 == 132 * MiB && (size_t)KVROWS * WG * 2 == KV_STRIDE, "ws map");
static_assert(WS_ACT + (size_t)MT * DFF * 2 <= WS_END && WS_KV + 4 * KV_STRIDE == WS_END, "ws map");
constexpr int CW_TMO = 0, CW_CODE = 1, CW_BAR = 4096, CW_SSQ = 16384;
static_assert((CW_SSQ + MT) * 4 <= (int)CTL_ZERO_BYTES, "ctl");

constexpr int NWAVES = 8;
constexpr int RING_OFF = 0, RING_BYTES = 131072;
constexpr int LDSCTL_OFF = RING_BYTES, MISC_OFF = LDSCTL_OFF + 320;
constexpr int LDS_BYTES = 147456;

#define RLX_AGENT __ATOMIC_RELAXED, __HIP_MEMORY_SCOPE_AGENT
#define LDS_WAIT() asm volatile("s_waitcnt lgkmcnt(0)" ::: "memory")
#define VM_WAIT() asm volatile("s_waitcnt vmcnt(0)" ::: "memory")

__device__ __forceinline__ unsigned cvt_pk_bf16(float lo, float hi) { unsigned r; asm volatile("v_cvt_pk_bf16_f32 %0, %1, %2" : "=v"(r) : "v"(lo), "v"(hi)); return r; }

namespace pg8 {
#define PG8_LAS __attribute__((address_space(3)))
typedef unsigned short bf16_t;
constexpr int BM = 256, BK = 64, HALF = 128, HTB = HALF * BK * 2, STAGE_BYTES = 8 * HTB, NXCD = 8, WGM = 8;
__host__ __device__ __forceinline__ int lds_byte(int r, int c) { const int st = (r >> 4) * 2 + (c >> 5), rr = r & 15, cc = c & 31, ob = rr * 64 + cc * 2; return st * 1024 + (ob ^ (((ob >> 9) & 1) << 5)); }
__host__ __device__ __forceinline__ void stage_rc(int b, int& R, int& C) { const int st = b / 1024, sb = b % 1024, swz = sb ^ (((sb >> 9) & 1) << 5); R = (st >> 1) * 16 + swz / 64; C = (st & 1) * 32 + (swz % 64) / 2; }
__host__ __device__ __forceinline__ int perm32(int rho) { const int n = rho >> 4, i = rho & 15; return 8 * (i >> 2) + 4 * n + (i & 3); }
struct Unit { int pm, pn; };
struct Gemm { const bf16_t* A; const bf16_t* Bt; int M, N, K; };
struct StaticOrder {
    int nM, nN, nwg, G, c;
    __host__ __device__ void init(int M, int N, int G_, int c_) { nM = M / BM; nN = N / BM; nwg = nM * nN; G = G_; c = c_; }
    __host__ __device__ bool next(int i, Unit& u) const {
        const long L = (long)i * G + c; if (L >= nwg) return false;
        int wgid = (int)L; { const int q = nwg / NXCD, r = nwg % NXCD, xcd = wgid % NXCD, off = wgid / NXCD; wgid = (xcd < r ? xcd * (q + 1) : r * (q + 1) + (xcd - r) * q) + off; }
        const int nig = WGM * nN, gid = wgid / nig, fm = gid * WGM, gsz = (nM - fm) < WGM ? (nM - fm) : WGM;
        u.pm = fm + ((wgid % nig) % gsz); u.pn = (wgid % nig) / gsz; return true;
    }
    __device__ __forceinline__ void a_ready(const Unit&) const {}
    __device__ __forceinline__ void done(const Unit&) const {}
};
template <class Epi, class Sched, bool ALIGN_EPI = false, bool SP2 = false>
__device__ __forceinline__ void gemm_phase(PG8_LAS unsigned char* lds, const Gemm g, const Sched& S, const Epi& E) {
    const int tid = threadIdx.x, wid = __builtin_amdgcn_readfirstlane(tid >> 6), lane = tid & 63, wr = wid >> 2, wc = wid & 3, fr = lane & 15, fq = lane >> 4;
    const int K = g.K, nt = K / BK;
    unsigned voffA[2], voffB[2];
#pragma unroll
    for (int i = 0; i < 2; ++i) { int R, C; stage_rc(tid * 16 + i * 8192, R, C); const int Rb = Epi::PERM ? ((R & ~31) + perm32(R & 31)) : R;
        voffA[i] = (unsigned)(R * K + C) * 2u; voffB[i] = (unsigned)(Rb * K + C) * 2u; }
    const size_t kstep = (size_t)(BK * 2);
    const size_t hstep = (size_t)HALF * K * 2;
    const size_t tstep = 2 * hstep;
    const unsigned ldsw = (unsigned)wid * 1024u;
    const int aoff = lds_byte(wr * 64 + fr, fq * 8), boff = lds_byte(wc * 32 + fr, fq * 8);
#define PG8_SA(b, h) (((b) * 2 + (h)) * HTB)
#define PG8_SB(b, h) ((4 + (b) * 2 + (h)) * HTB)
#define PG8_STAGE(bufoff, gbase, voff) do { _Pragma("unroll") for (int _i = 0; _i < 2; ++_i) \
        __builtin_amdgcn_global_load_lds((const unsigned*)((const char*)(gbase) + (voff)[_i]), (PG8_LAS unsigned*)(lds + (bufoff) + ldsw + _i * 8192), 16, 0, 0); } while (0)
#define PG8_LDA(dst, b, h) do { _Pragma("unroll") for (int m = 0; m < 4; ++m) _Pragma("unroll") for (int k = 0; k < 2; ++k) dst[m][k] = *(const PG8_LAS bf16x8*)(lds + PG8_SA(b, h) + aoff + m * 2048 + k * 1024); } while (0)
#define PG8_LDB(dst, b, h) do { _Pragma("unroll") for (int n = 0; n < 2; ++n) _Pragma("unroll") for (int k = 0; k < 2; ++k) dst[n][k] = *(const PG8_LAS bf16x8*)(lds + PG8_SB(b, h) + boff + n * 2048 + k * 1024); } while (0)
#define PG8_MMA(ai, bj, At, Bt) do { __builtin_amdgcn_s_setprio(1); _Pragma("unroll") for (int m = 0; m < 4; ++m) _Pragma("unroll") for (int n = 0; n < 2; ++n) _Pragma("unroll") for (int k = 0; k < 2; ++k) \
        acc[ai][bj][m][n] = __builtin_amdgcn_mfma_f32_16x16x32_bf16(Bt[n][k], At[m][k], acc[ai][bj][m][n], 0, 0, 0); __builtin_amdgcn_s_setprio(0); } while (0)
#define PG8_WAIT_V(n) asm volatile("s_waitcnt vmcnt(" #n ")" ::: "memory")
#define PG8_WAIT_L(n) asm volatile("s_waitcnt lgkmcnt(" #n ")" ::: "memory")
#define PG8_BAR __builtin_amdgcn_s_barrier()
#define PG8_SCHED __builtin_amdgcn_sched_barrier(0)
    Unit cur, nxt; int ui = 0;
    if (!S.next(0, cur)) return;
    f32x4 acc[2][2][4][2];
#pragma unroll
    for (int a = 0; a < 2; ++a)
#pragma unroll
        for (int b = 0; b < 2; ++b)
#pragma unroll
            for (int m = 0; m < 4; ++m)
#pragma unroll
                for (int n = 0; n < 2; ++n) acc[a][b][m][n] = (f32x4){0.f, 0.f, 0.f, 0.f};
    bf16x8 At[4][2], B0[2][2], B1[2][2];
    const char* cA = (const char*)g.A + (size_t)cur.pm * tstep; const char* cB = (const char*)g.Bt + (size_t)cur.pn * tstep;
    S.a_ready(cur);
    if constexpr (SP2) {
        PG8_STAGE(PG8_SB(0, 0), cB, voffB); PG8_STAGE(PG8_SB(0, 1), cB + hstep, voffB); PG8_STAGE(PG8_SA(0, 0), cA, voffA); PG8_STAGE(PG8_SA(0, 1), cA + hstep, voffA);
        if (wr == 1) PG8_BAR;
        PG8_WAIT_V(2); PG8_BAR;
        PG8_STAGE(PG8_SB(1, 0), cB + kstep, voffB); PG8_STAGE(PG8_SA(1, 0), cA + kstep, voffA); PG8_STAGE(PG8_SB(1, 1), cB + hstep + kstep, voffB);
        PG8_WAIT_V(6); PG8_BAR;
    } else {
        PG8_STAGE(PG8_SB(0, 0), cB, voffB); PG8_STAGE(PG8_SA(0, 0), cA, voffA); PG8_STAGE(PG8_SB(0, 1), cB + hstep, voffB); PG8_STAGE(PG8_SA(0, 1), cA + hstep, voffA);
        if (wr == 1) PG8_BAR;
        PG8_WAIT_V(4); PG8_BAR;
        PG8_STAGE(PG8_SB(1, 0), cB + kstep, voffB); PG8_STAGE(PG8_SA(1, 0), cA + kstep, voffA); PG8_STAGE(PG8_SB(1, 1), cB + hstep + kstep, voffB);
        PG8_WAIT_V(6); PG8_BAR;
    }
    for (;;) {
        const bool has_next = S.next(ui + 1, nxt);
        const char* nA = has_next ? (const char*)g.A + (size_t)nxt.pm * tstep : cA; const char* nB = has_next ? (const char*)g.Bt + (size_t)nxt.pn * tstep : cB;
        for (int t = 0; t < nt; t += 2) {
            const bool last = (t == nt - 2);
            const char* a1 = cA + (size_t)(t + 1) * kstep;
            const char* a2 = last ? nA : cA + (size_t)(t + 2) * kstep; const char* b2 = last ? nB : cB + (size_t)(t + 2) * kstep;
            const char* a3 = a2 + kstep; const char* b3 = b2 + kstep;
            if (last && has_next) S.a_ready(nxt);
            if constexpr (SP2) {
            PG8_LDB(B0, 0, 0); PG8_LDB(B1, 0, 1); PG8_SCHED; PG8_LDA(At, 0, 0); PG8_STAGE(PG8_SA(1, 1), a1 + hstep, voffA);
            PG8_WAIT_V(8); PG8_WAIT_L(0); PG8_BAR; PG8_MMA(0, 0, At, B0); PG8_MMA(0, 1, At, B1); PG8_BAR; PG8_SCHED;
            PG8_LDA(At, 0, 1); PG8_STAGE(PG8_SB(0, 0), b2, voffB); PG8_STAGE(PG8_SB(0, 1), b2 + hstep, voffB); PG8_STAGE(PG8_SA(0, 0), a2, voffA);
            PG8_WAIT_V(8); PG8_WAIT_L(0); PG8_BAR; PG8_MMA(1, 0, At, B0); PG8_MMA(1, 1, At, B1); PG8_BAR; PG8_SCHED;
            PG8_LDB(B0, 1, 0); PG8_LDB(B1, 1, 1); PG8_SCHED; PG8_LDA(At, 1, 0); PG8_STAGE(PG8_SA(0, 1), a2 + hstep, voffA);
            PG8_WAIT_V(8); PG8_WAIT_L(0); PG8_BAR; PG8_MMA(0, 0, At, B0); PG8_MMA(0, 1, At, B1); PG8_BAR; PG8_SCHED;
            PG8_LDA(At, 1, 1); PG8_STAGE(PG8_SB(1, 0), b3, voffB); PG8_STAGE(PG8_SB(1, 1), b3 + hstep, voffB); PG8_STAGE(PG8_SA(1, 0), a3, voffA);
            PG8_WAIT_V(8); PG8_WAIT_L(0); PG8_BAR; PG8_MMA(1, 0, At, B0); PG8_MMA(1, 1, At, B1); PG8_BAR; PG8_SCHED;
            } else {
            PG8_LDB(B0, 0, 0); PG8_SCHED; PG8_LDA(At, 0, 0); PG8_STAGE(PG8_SA(1, 1), a1 + hstep, voffA);
            PG8_WAIT_L(8); PG8_BAR; PG8_WAIT_L(0); PG8_MMA(0, 0, At, B0); PG8_BAR; PG8_SCHED;
            PG8_LDB(B1, 0, 1); PG8_STAGE(PG8_SB(0, 0), b2, voffB);
            PG8_BAR; PG8_WAIT_L(0); PG8_MMA(0, 1, At, B1); PG8_BAR;
            PG8_LDA(At, 0, 1); PG8_STAGE(PG8_SA(0, 0), a2, voffA);
            PG8_BAR; PG8_WAIT_L(0); PG8_MMA(1, 0, At, B0); PG8_BAR; PG8_SCHED;
            PG8_STAGE(PG8_SB(0, 1), b2 + hstep, voffB);
            PG8_WAIT_V(6); PG8_BAR; PG8_MMA(1, 1, At, B1); PG8_BAR;
            PG8_LDB(B0, 1, 0); PG8_SCHED; PG8_LDA(At, 1, 0); PG8_STAGE(PG8_SA(0, 1), a2 + hstep, voffA);
            PG8_WAIT_L(8); PG8_BAR; PG8_WAIT_L(0); PG8_MMA(0, 0, At, B0); PG8_BAR; PG8_SCHED;
            PG8_LDB(B1, 1, 1); PG8_STAGE(PG8_SB(1, 0), b3, voffB);
            PG8_BAR; PG8_WAIT_L(0); PG8_MMA(0, 1, At, B1); PG8_BAR;
            PG8_LDA(At, 1, 1); PG8_STAGE(PG8_SA(1, 0), a3, voffA);
            PG8_BAR; PG8_WAIT_L(0); PG8_MMA(1, 0, At, B0); PG8_BAR; PG8_SCHED;
            PG8_STAGE(PG8_SB(1, 1), b3 + hstep, voffB);
            PG8_WAIT_V(6); PG8_BAR; PG8_MMA(1, 1, At, B1); PG8_BAR;
            }
        }
        if constexpr (ALIGN_EPI) { if (wr == 0) PG8_BAR; }
        E(acc, cur, wr, wc, fr, fq); S.done(cur);
        if (!has_next) break;
#pragma unroll
        for (int a = 0; a < 2; ++a)
#pragma unroll
            for (int b = 0; b < 2; ++b)
#pragma unroll
                for (int m = 0; m < 4; ++m)
#pragma unroll
                    for (int n = 0; n < 2; ++n) acc[a][b][m][n] = (f32x4){0.f, 0.f, 0.f, 0.f};
        cur = nxt; cA = nA; cB = nB; ++ui;
        if constexpr (ALIGN_EPI) { if (wr == 1) PG8_BAR; }
    }
    PG8_WAIT_V(0);
    if constexpr (!ALIGN_EPI) { if (wr == 0) PG8_BAR; }
    PG8_BAR;
#undef PG8_SA
#undef PG8_SB
#undef PG8_STAGE
#undef PG8_LDA
#undef PG8_LDB
#undef PG8_MMA
#undef PG8_WAIT_V
#undef PG8_WAIT_L
#undef PG8_BAR
#undef PG8_SCHED
}

__device__ __forceinline__ float log_sigmoid_f(float x) { return -(fmaxf(-x, 0.f) + log1pf(expf(-fabsf(x)))); }
struct EpiIn {
    static constexpr bool PERM = true;
    bf16_t* QO; bf16_t* KV; float* out; const float* bfg;
    __device__ __forceinline__ void operator()(const f32x4 (&acc)[2][2][4][2], const Unit& u, int wr, int wc, int fr, int fq) const {
        const int seg = u.pn >> 3;
        const int row0 = u.pm * BM + wr * 64 + fr;
        const int cseg = (u.pn & 7) * BM + wc * 32 + 8 * fq;
        const bool prompt = u.pm < (MP / BM);
        if (seg == 6) {
            if (wc == 0 && fq < 2) {
                const f32x4 b0 = *(const f32x4*)(bfg + 8 * fq), b1 = *(const f32x4*)(bfg + 8 * fq + 4);
#pragma unroll
                for (int ai = 0; ai < 2; ++ai)
#pragma unroll
                    for (int m = 0; m < 4; ++m) { const int row = row0 + ai * HALF + m * 16;
                        float* dst = prompt ? out + O_PFL + (size_t)row * NHG + 8 * fq : out + O_SFL + (size_t)(row - MP) * NHG + 8 * fq;
                        const f32x4 v0 = acc[ai][0][m][0] + b0, v1 = acc[ai][0][m][1] + b1; f32x4 r0, r1;
#pragma unroll
                        for (int j = 0; j < 4; ++j) { r0[j] = log_sigmoid_f(v0[j]); r1[j] = log_sigmoid_f(v1[j]); }
                        *(f32x4*)dst = r0; *(f32x4*)(dst + 4) = r1; }
            }
        } else if (seg == 0 || seg == 3) {
            bf16_t* base = QO + (seg == 3 ? WG : 0) + cseg;
#pragma unroll
            for (int ai = 0; ai < 2; ++ai)
#pragma unroll
                for (int m = 0; m < 4; ++m) { bf16_t* rowp = base + (size_t)(row0 + ai * HALF + m * 16) * DM;
#pragma unroll
                    for (int bj = 0; bj < 2; ++bj) { const f32x4 v0 = acc[ai][bj][m][0] * QSCALE, v1 = acc[ai][bj][m][1] * QSCALE;
                        v4u w; w.x = cvt_pk_bf16(v0[0], v0[1]); w.y = cvt_pk_bf16(v0[2], v0[3]); w.z = cvt_pk_bf16(v1[0], v1[1]); w.w = cvt_pk_bf16(v1[2], v1[3]);
                        *(v4u*)(rowp + bj * HALF) = w; } }
        } else {
            const int kvi = (seg == 1) ? 0 : (seg == 2) ? 1 : (seg == 4) ? 2 : 3;
            bf16_t* kvb = KV + (size_t)kvi * (KV_STRIDE / 2) + cseg;
            float* ob = out + (prompt ? O_PFK + (size_t)kvi * ((size_t)MP * WG) + (kvi >= 2 ? (size_t)MP * NHG : 0)
                                      : O_SFK + (size_t)kvi * ((size_t)MS * WG) + (kvi >= 2 ? (size_t)MS * NHG : 0)) + cseg;
#pragma unroll
            for (int ai = 0; ai < 2; ++ai)
#pragma unroll
                for (int m = 0; m < 4; ++m) { const int row = row0 + ai * HALF + m * 16; const int rs = row - MP;
                    const int kvrow = prompt ? row : MP + (rs >> 5) * TKS + PAST + (rs & 31);
                    const int orow = prompt ? row : rs;
                    bf16_t* rowp = kvb + (size_t)kvrow * WG; float* op = ob + (size_t)orow * WG;
#pragma unroll
                    for (int bj = 0; bj < 2; ++bj) { const f32x4 v0 = acc[ai][bj][m][0], v1 = acc[ai][bj][m][1];
                        v4u w; w.x = cvt_pk_bf16(v0[0], v0[1]); w.y = cvt_pk_bf16(v0[2], v0[3]); w.z = cvt_pk_bf16(v1[0], v1[1]); w.w = cvt_pk_bf16(v1[2], v1[3]);
                        *(v4u*)(rowp + bj * HALF) = w; if (!prompt) { *(f32x4*)(op + bj * HALF) = v0; *(f32x4*)(op + bj * HALF + 4) = v1; } } }
        }
    }
};
struct EpiX2 {
    static constexpr bool PERM = true;
    const float* rp; const float* rs; bf16_t* X2; float* ssq;
    __device__ __forceinline__ void operator()(const f32x4 (&acc)[2][2][4][2], const Unit& u, int wr, int wc, int fr, int fq) const {
        const int row0 = u.pm * BM + wr * 64 + fr, col0 = u.pn * BM + wc * 32 + 8 * fq;
        const bool prompt = u.pm < (MP / BM);
#pragma unroll
        for (int ai = 0; ai < 2; ++ai)
#pragma unroll
            for (int m = 0; m < 4; ++m) { const int row = row0 + ai * HALF + m * 16;
                const float* rr = (prompt ? rp + (size_t)row * DM : rs + (size_t)(row - MP) * DM) + col0; bf16_t* op = X2 + (size_t)row * DM + col0;
                f32x4 rv[2][2];
#pragma unroll
                for (int bj = 0; bj < 2; ++bj)
#pragma unroll
                    for (int n = 0; n < 2; ++n) rv[bj][n] = *(const f32x4*)(rr + bj * HALF + n * 4);
                float s = 0.f;
#pragma unroll
                for (int bj = 0; bj < 2; ++bj) { const f32x4 v0 = acc[ai][bj][m][0] + rv[bj][0], v1 = acc[ai][bj][m][1] + rv[bj][1];
                    s += (v0[0] * v0[0] + v0[1] * v0[1]) + (v0[2] * v0[2] + v0[3] * v0[3]) + (v1[0] * v1[0] + v1[1] * v1[1]) + (v1[2] * v1[2] + v1[3] * v1[3]);
                    v4u w; w.x = cvt_pk_bf16(v0[0], v0[1]); w.y = cvt_pk_bf16(v0[2], v0[3]); w.z = cvt_pk_bf16(v1[0], v1[1]); w.w = cvt_pk_bf16(v1[2], v1[3]);
                    *(v4u*)(op + bj * HALF) = w; }
                s += __shfl_xor(s, 16); s += __shfl_xor(s, 32);
                if (fq == 0) __hip_atomic_fetch_add(ssq + row, s, __ATOMIC_RELAXED, __HIP_MEMORY_SCOPE_AGENT); }
    }
};
struct EpiDown {
    static constexpr bool PERM = true;
    const bf16_t* X2; float* out;
    __device__ __forceinline__ void operator()(const f32x4 (&acc)[2][2][4][2], const Unit& u, int wr, int wc, int fr, int fq) const {
        const int row0 = u.pm * BM + wr * 64 + fr, col0 = u.pn * BM + wc * 32 + 8 * fq;
#pragma unroll
        for (int ai = 0; ai < 2; ++ai)
#pragma unroll
            for (int m = 0; m < 4; ++m) { const size_t off = (size_t)(row0 + ai * HALF + m * 16) * DM + col0;
                v4u xv[2];
#pragma unroll
                for (int bj = 0; bj < 2; ++bj) xv[bj] = *(const v4u*)(X2 + off + bj * HALF);
#pragma unroll
                for (int bj = 0; bj < 2; ++bj) { const v4u x = xv[bj];
                    const f32x4 r0 = {__uint_as_float(x.x << 16), __uint_as_float(x.x & 0xffff0000u), __uint_as_float(x.y << 16), __uint_as_float(x.y & 0xffff0000u)};
                    const f32x4 r1 = {__uint_as_float(x.z << 16), __uint_as_float(x.z & 0xffff0000u), __uint_as_float(x.w << 16), __uint_as_float(x.w & 0xffff0000u)};
                    *(f32x4*)(out + off + bj * HALF) = acc[ai][bj][m][0] + r0; *(f32x4*)(out + off + bj * HALF + 4) = acc[ai][bj][m][1] + r1; } }
    }
};
struct EpiGlu {
    static constexpr bool PERM = true;
    bf16_t* ACT; const float* ssq;
    __device__ __forceinline__ void operator()(const f32x4 (&acc)[2][2][4][2], const Unit& u, int wr, int wc, int fr, int fq) const {
        const int row0 = u.pm * BM + wr * 64 + fr, col0 = u.pn * HALF + wc * 32 + 8 * fq;
#pragma unroll
        for (int ai = 0; ai < 2; ++ai)
#pragma unroll
            for (int m = 0; m < 4; ++m) { const int row = row0 + ai * HALF + m * 16; bf16_t* rowp = ACT + (size_t)row * DFF + col0; float r[8];
                const float rstd = rsqrtf(ssq[row] * (1.f / DM) + EPS);
#pragma unroll
                for (int n = 0; n < 2; ++n)
#pragma unroll
                    for (int j = 0; j < 4; ++j) { const float g = acc[ai][0][m][n][j] * rstd, up = acc[ai][1][m][n][j] * rstd;
                        r[n * 4 + j] = g * __builtin_amdgcn_rcpf(1.0f + __builtin_amdgcn_exp2f(-g * LOG2E)) * up; }
                v4u w; w.x = cvt_pk_bf16(r[0], r[1]); w.y = cvt_pk_bf16(r[2], r[3]); w.z = cvt_pk_bf16(r[4], r[5]); w.w = cvt_pk_bf16(r[6], r[7]);
                *(v4u*)rowp = w; }
    }
};
}

namespace att {
constexpr int SHM_V = 16384, SHM_K = 16384;
constexpr int OFF_V = 0, OFF_K = 2 * SHM_V, OFF_WS = 4 * 16384, OFF_U = OFF_WS + NWAVES * 256, OFF_SCAN = OFF_U + (2048 + 64) * 4, ATT_LDS = OFF_SCAN + 64;
static_assert(ATT_LDS <= RING_BYTES, "attention LDS");
#define KSWZ(row, colB) ((row) * 256 + ((colB) ^ (((row) & 7) << 4)))
#define SBAR() __builtin_amdgcn_sched_barrier(0)
__device__ __forceinline__ int slot32(int k) { return (k & 3) | (((k >> 2) & 3) << 3) | (((k >> 4) & 1) << 2); }
__device__ __forceinline__ int v_st(int k, int c) { const int kk = (k & ~0xC) | ((k & 4) << 1) | ((k & 8) >> 1); return ((kk >> 3) * 4 + (c >> 5)) * 512 + ((kk & 7) * 32 + (c & 31)) * 2; }
__device__ __forceinline__ int v_rd_base(int lane) { return ((lane & 3) << 3) | (((lane >> 2) & 3) << 6) | (((lane >> 4) & 1) << 5) | (((lane >> 5) & 1) << 8); }
constexpr int v_rd_off(int d0, int ks, int half) { return d0 * 512 + ks * 4096 + half * 2048; }
__device__ __forceinline__ int crow(int r, int hi) { return (r & 3) + 8 * (r >> 2) + 4 * hi; }
__device__ __forceinline__ float partner(float x, int hi) { auto rr = __builtin_amdgcn_permlane32_swap(__float_as_uint(x), __float_as_uint(x), false, false); return __uint_as_float(hi ? rr[0] : rr[1]); }

__device__ __forceinline__ void qkt(f32x16& p0, f32x16& p1, LAS const unsigned char* Kt, int r32, int hi, const bf16x8* qr) {
    p0 = f32x16{}; p1 = f32x16{};
    LAS const unsigned char* kb[4];
#pragma unroll
    for (int dd = 0; dd < 4; ++dd) kb[dd] = Kt + KSWZ(r32, (dd * 16 + hi * 8) * 2);
#pragma unroll
    for (int d0 = 0; d0 < 8; ++d0) { LAS const unsigned char* a = kb[d0 & 3] + (d0 >> 2) * 128;
        const bf16x8 b0 = *(LAS const bf16x8*)a;
        const bf16x8 b1 = *(LAS const bf16x8*)(a + 32 * 256);
        p0 = __builtin_amdgcn_mfma_f32_32x32x16_bf16(b0, qr[d0], p0, 0, 0, 0);
        p1 = __builtin_amdgcn_mfma_f32_32x32x16_bf16(b1, qr[d0], p1, 0, 0, 0); }
}
__device__ __forceinline__ void pv_tile(f32x16* o, int vb0, bf16x8 pa0, bf16x8 pa1, bf16x8 pa2, bf16x8 pa3) {
#define TRRD(dst, off) asm volatile("ds_read_b64_tr_b16 %0, %1 offset:%2" : "=&v"(dst) : "v"(vb0), "i"(off) : "memory")
#define PV_D0(d0) do { s16x4 l0, l1, l2, l3, h0, h1, h2, h3; constexpr int b_ = v_rd_off(d0, 0, 0); \
        TRRD(l0, b_); TRRD(h0, b_ + 2048); TRRD(l1, b_ + 4096); TRRD(h1, b_ + 6144); TRRD(l2, b_ + 8192); TRRD(h2, b_ + 10240); TRRD(l3, b_ + 12288); TRRD(h3, b_ + 14336); \
        asm volatile("s_waitcnt lgkmcnt(0)" ::: "memory"); SBAR(); \
        o[d0] = __builtin_amdgcn_mfma_f32_32x32x16_bf16(pa0, (bf16x8){l0[0], l0[1], l0[2], l0[3], h0[0], h0[1], h0[2], h0[3]}, o[d0], 0, 0, 0); \
        o[d0] = __builtin_amdgcn_mfma_f32_32x32x16_bf16(pa1, (bf16x8){l1[0], l1[1], l1[2], l1[3], h1[0], h1[1], h1[2], h1[3]}, o[d0], 0, 0, 0); \
        o[d0] = __builtin_amdgcn_mfma_f32_32x32x16_bf16(pa2, (bf16x8){l2[0], l2[1], l2[2], l2[3], h2[0], h2[1], h2[2], h2[3]}, o[d0], 0, 0, 0); \
        o[d0] = __builtin_amdgcn_mfma_f32_32x32x16_bf16(pa3, (bf16x8){l3[0], l3[1], l3[2], l3[3], h3[0], h3[1], h3[2], h3[3]}, o[d0], 0, 0, 0); } while (0)
    PV_D0(0); PV_D0(1); PV_D0(2); PV_D0(3);
#undef PV_D0
#undef TRRD
}
#define PK4(P, B_, OUT) do { unsigned a0 = cvt_pk_bf16(P[B_+0], P[B_+1]), a1 = cvt_pk_bf16(P[B_+2], P[B_+3]); \
        unsigned b0 = cvt_pk_bf16(P[B_+4], P[B_+5]), b1 = cvt_pk_bf16(P[B_+6], P[B_+7]); \
        auto r0 = __builtin_amdgcn_permlane32_swap(a0, b0, false, false); auto r1 = __builtin_amdgcn_permlane32_swap(a1, b1, false, false); \
        v4u w = {r0[0], r1[0], r0[1], r1[1]}; OUT = __builtin_bit_cast(bf16x8, w); } while (0)

template <class F> __device__ __forceinline__ void scan_u(LAS float* U, LAS float* scan, int n, F lf) {
    const int tid = threadIdx.x, lane = tid & 63, wid = tid >> 6, t0 = 4 * tid;
    float v0 = t0 < n ? lf(t0) : 0.f, v1 = t0 + 1 < n ? lf(t0 + 1) : 0.f, v2 = t0 + 2 < n ? lf(t0 + 2) : 0.f, v3 = t0 + 3 < n ? lf(t0 + 3) : 0.f;
    v1 += v0; v2 += v1; v3 += v2;
    float x = v3;
#pragma unroll
    for (int o = 1; o < 64; o <<= 1) { const float y = __shfl_up(x, o); if (lane >= o) x += y; }
    if (lane == 63) scan[wid] = x;
    __syncthreads();
    float pre = x - v3;
    for (int w = 0; w < wid; ++w) pre += scan[w];
    f32x4 r = {-(v0 + pre) * LOG2E, -(v1 + pre) * LOG2E, -(v2 + pre) * LOG2E, -(v3 + pre) * LOG2E};
    *(LAS f32x4*)(U + t0) = r;
    __syncthreads();
}

__device__ __forceinline__ int islot(int rho) { return (rho & 0x23) | (((rho >> 3) & 3) << 2) | (((rho >> 2) & 1) << 4); }
template <int MODE>
__device__ __forceinline__ void attn_unit(LAS unsigned char* lds, const bf16* Q, const bf16* K, const bf16* V, bf16* O, int P0, int Tk, int nact) {
    const int tid = threadIdx.x, wid = __builtin_amdgcn_readfirstlane(tid >> 6), lane = tid & 63, r32 = lane & 31, hi = lane >> 5;
    const bool active = wid < nact;
    const int nrows = 32 * nact;
    const int NT = (P0 + nrows + 63) >> 6;
    LAS unsigned char* V_lds = lds + OFF_V; LAS unsigned char* K_lds = lds + OFF_K;
    LAS float* wsf = (LAS float*)(lds + OFF_WS) + wid * 64; LAS float* li_l = wsf; LAS float* al_l = wsf + 32;
    LAS const float* U = (LAS const float*)(lds + OFF_U);
    int kkey[2], kcol[2], vkey[2], vcol[2];
#pragma unroll
    for (int i = 0; i < 2; ++i) {
        const int q = wid * 2 + i;
        { const int rho = q * 4 + (lane >> 4), cpos = lane & 15; kkey[i] = islot(rho); kcol[i] = (cpos ^ (rho & 7)) * 8; }
        { const int sub = q * 2 + (lane >> 5), kk = (sub >> 2) * 8 + ((lane & 31) >> 2), ks = (kk & ~0xC) | ((kk & 4) << 1) | ((kk & 8) >> 1); vkey[i] = islot(ks); vcol[i] = (sub & 3) * 32 + (lane & 3) * 8; }
    }
    const int vb0 = (int)(size_t)V_lds + v_rd_base(lane);
    const int qlo = P0 + wid * 32, tq = qlo + r32;
    bf16x8 qr[8];
    if (active) {
#pragma unroll
        for (int d0 = 0; d0 < 8; ++d0) qr[d0] = *(const bf16x8*)(Q + (size_t)(wid * 32 + r32) * DM + d0 * 16 + hi * 8);
    } else {
#pragma unroll
        for (int d0 = 0; d0 < 8; ++d0) qr[d0] = bf16x8{};
    }
#define TILE_OF(t) (MODE == 0 ? (t) : NT - 1 - (t))
#define STAGE(j, bf) do { _Pragma("unroll") for (int _i = 0; _i < 2; ++_i) { \
        int kk_ = (j) * 64 + kkey[_i]; kk_ = kk_ < Tk ? kk_ : Tk - 1; int vk_ = (j) * 64 + vkey[_i]; vk_ = vk_ < Tk ? vk_ : Tk - 1; \
        __builtin_amdgcn_global_load_lds((const unsigned*)(K + (size_t)kk_ * WG + kcol[_i]), (LAS unsigned*)(K_lds + (bf) * SHM_K + (wid * 2 + _i) * 1024), 16, 0, 0); \
        __builtin_amdgcn_global_load_lds((const unsigned*)(V + (size_t)vk_ * WG + vcol[_i]), (LAS unsigned*)(V_lds + (bf) * SHM_V + (wid * 2 + _i) * 1024), 16, 0, 0); } } while (0)
    STAGE(TILE_OF(0), 0); VM_WAIT();
    __syncthreads();
    float m_reg = -1e30f, l_reg = 0.f, carry = 0.f;
    f32x16 o[4] = {};
    for (int t = 0; t < NT; ++t) {
        const int j = TILE_OF(t), kb = j * 64, bufo = (t & 1) * SHM_K;
        if (t + 1 < NT) STAGE(TILE_OF(t + 1), (t + 1) & 1);
        if (active && kb <= qlo + 31) {
            f32x16 p0, p1;
            qkt(p0, p1, K_lds + bufo, r32, hi, qr);
            bf16x8 pa0, pa1, pa2, pa3;
            const int dq = tq - kb - 16 * hi;
            const bool need_mask = kb + 63 >= qlo;
            if (MODE == 0) {
                LAS const f32x4* up0 = (LAS const f32x4*)(U + kb + 16 * hi); LAS const f32x4* up1 = (LAS const f32x4*)(U + kb + 32 + 16 * hi);
#pragma unroll
                for (int g = 0; g < 4; ++g) { const f32x4 a = up0[g], b = up1[g];
#pragma unroll
                    for (int jj = 0; jj < 4; ++jj) { p0[4 * g + jj] += a[jj]; p1[4 * g + jj] += b[jj]; } }
                if (need_mask) { const float NEG = -__builtin_inff();
#pragma unroll
                    for (int r = 0; r < 16; ++r) { if (r > dq) p0[r] = NEG; if (r + 32 > dq) p1[r] = NEG; } }
                float pmax = p0[0];
#pragma unroll
                for (int r = 1; r < 16; ++r) pmax = fmaxf(pmax, p0[r]);
#pragma unroll
                for (int r = 0; r < 16; ++r) pmax = fmaxf(pmax, p1[r]);
                pmax = fmaxf(pmax, partner(pmax, hi));
                const float mn = fmaxf(m_reg, pmax);
                const float alpha = __builtin_amdgcn_exp2f(m_reg - mn);
                m_reg = mn;
                float ps = 0.f;
#pragma unroll
                for (int r = 0; r < 16; ++r) { p0[r] = __builtin_amdgcn_exp2f(p0[r] - mn); p1[r] = __builtin_amdgcn_exp2f(p1[r] - mn); ps += p0[r] + p1[r]; }
                ps += partner(ps, hi);
                l_reg = l_reg * alpha + ps;
                if (hi == 0) al_l[r32] = alpha;
                LDS_WAIT();
#pragma unroll
                for (int g = 0; g < 4; ++g) { const f32x4 a = *(LAS const f32x4*)(al_l + 8 * g + 4 * hi);
#pragma unroll
                    for (int jj = 0; jj < 4; ++jj)
#pragma unroll
                        for (int d_ = 0; d_ < 4; ++d_) o[d_][4 * g + jj] *= a[jj]; }
            } else {
                f32x16 l1;
#pragma unroll
                for (int r = 0; r < 16; ++r) l1[r] = -(fmaxf(p1[r], 0.f) + __builtin_amdgcn_logf(1.0f + __builtin_amdgcn_exp2f(-fabsf(p1[r]))));
                if (need_mask) {
#pragma unroll
                    for (int r = 0; r < 16; ++r) if (r + 32 >= dq) l1[r] = 0.f; }
#pragma unroll
                for (int r = 14; r >= 0; --r) l1[r] += l1[r + 1];
                const float T1 = l1[0], oT1 = partner(T1, hi);
                const float off1 = carry + (hi ? 0.f : oT1);
#pragma unroll
                for (int r = 0; r < 16; ++r) p1[r] = __builtin_amdgcn_exp2f(p1[r] + l1[r] + off1);
                if (need_mask) {
#pragma unroll
                    for (int r = 0; r < 16; ++r) if (r + 32 >= dq) p1[r] = 0.f; }
                f32x16 l0;
#pragma unroll
                for (int r = 0; r < 16; ++r) l0[r] = -(fmaxf(p0[r], 0.f) + __builtin_amdgcn_logf(1.0f + __builtin_amdgcn_exp2f(-fabsf(p0[r]))));
                if (need_mask) {
#pragma unroll
                    for (int r = 0; r < 16; ++r) if (r >= dq) l0[r] = 0.f; }
#pragma unroll
                for (int r = 14; r >= 0; --r) l0[r] += l0[r + 1];
                const float T0 = l0[0], oT0 = partner(T0, hi);
                const float off0 = carry + T1 + oT1 + (hi ? 0.f : oT0);
                carry += (T0 + oT0) + (T1 + oT1);
#pragma unroll
                for (int r = 0; r < 16; ++r) p0[r] = __builtin_amdgcn_exp2f(p0[r] + l0[r] + off0);
                if (need_mask) {
#pragma unroll
                    for (int r = 0; r < 16; ++r) if (r >= dq) p0[r] = 0.f; }
            }
            PK4(p0, 0, pa0); PK4(p0, 8, pa1); PK4(p1, 0, pa2); PK4(p1, 8, pa3);
            pv_tile(o, vb0 + bufo, pa0, pa1, pa2, pa3);
        }
        VM_WAIT();
        __syncthreads();
    }
    if (active) {
        if (MODE == 0) {
            if (hi == 0) li_l[r32] = 1.0f / l_reg;
            LDS_WAIT();
#pragma unroll
            for (int g = 0; g < 4; ++g) { const f32x4 a = *(LAS const f32x4*)(li_l + 8 * g + 4 * hi);
#pragma unroll
                for (int jj = 0; jj < 4; ++jj)
#pragma unroll
                    for (int d_ = 0; d_ < 4; ++d_) o[d_][4 * g + jj] *= a[jj]; }
        }
        bf16* Ow = O + (size_t)(wid * 32) * DM;
#pragma unroll
        for (int r = 0; r < 16; ++r) { const int orow = crow(r, hi);
#pragma unroll
            for (int d0 = 0; d0 < 4; ++d0) { const float v = o[d0][r]; const float vn = __shfl_xor(v, 1);
                if ((r32 & 1) == 0) *(unsigned*)(Ow + (size_t)orow * DM + d0 * 32 + r32) = cvt_pk_bf16(v, vn); } }
    }
    __syncthreads();
#undef TILE_OF
#undef STAGE
}
#undef PK4
}

#define XB_TMO      128
#define XB_XCNT(j)  (256  + 64 * (j))
#define XB_XSUB(j)  (1280 + 64 * (j))
#define XB_XGEN(j)  (2304 + 64 * (j))
#define XB_TOP      3328
#define XB_TOPGEN   3392
#define XCD_BAR_WORDS 3456
#define XB_SPIN_CAP (1u << 18)
__device__ __forceinline__ unsigned xb_ld(unsigned* p)              { return __hip_atomic_load(p, __ATOMIC_RELAXED, __HIP_MEMORY_SCOPE_AGENT); }
__device__ __forceinline__ unsigned xb_add(unsigned* p, unsigned v) { return __hip_atomic_fetch_add(p, v, __ATOMIC_RELAXED, __HIP_MEMORY_SCOPE_AGENT); }
__device__ __forceinline__ unsigned xb_xcc_id() { return (unsigned)__builtin_amdgcn_s_getreg((3 << 11) | 20) & 0xFu; }
#define XB_SPIN(cond, bar) do { unsigned _sp = 0; while (cond) { __builtin_amdgcn_s_sleep(1); \
    if ((++_sp & 255u) == 0u) { if (xb_ld(&(bar)[XB_TMO])) break; if (_sp > XB_SPIN_CAP) { atomicAdd(&(bar)[XB_TMO], 1u); break; } } } } while (0)
struct XcdBarrier { unsigned* bar; unsigned x; volatile LAS unsigned* st; };
__device__ __forceinline__ XcdBarrier xcd_barrier_post(unsigned* bar, volatile LAS unsigned* st) {
    XcdBarrier b; b.bar = bar; b.x = xb_xcc_id(); b.st = st;
    if (threadIdx.x == 0) (void)xb_add(&bar[XB_XCNT(b.x)], 1u);
    return b;
}
__device__ __forceinline__ void xcd_barrier_complete(unsigned* bar, unsigned x, unsigned& nloc, unsigned& nx) {
    const unsigned G = gridDim.x * gridDim.y * gridDim.z;
    unsigned sum, cnt, mine, sp = 0u;
    for (;;) {
        sum = 0u; cnt = 0u; mine = 0u;
#pragma unroll
        for (unsigned j = 0; j < 16; ++j) { const unsigned c = xb_ld(&bar[XB_XCNT(j)]); sum += c; cnt += (c > 0u) ? 1u : 0u; mine = (j == x) ? c : mine; }
        if (sum == G) break;
        __builtin_amdgcn_s_sleep(1);
        if ((++sp & 255u) == 0u) { if (xb_ld(&bar[XB_TMO])) break; if (sp > XB_SPIN_CAP) { atomicAdd(&bar[XB_TMO], 1u); break; } }
    }
    nloc = mine > 0u ? mine : 1u; nx = cnt > 0u ? cnt : 1u;
}
__device__ __forceinline__ void xcd_barrier(const XcdBarrier& b) {
    asm volatile("s_waitcnt vmcnt(0)" ::: "memory");
    __syncthreads();
    if (threadIdx.x == 0) {
        unsigned* bar = b.bar;
        __builtin_amdgcn_s_waitcnt(0);
        unsigned nloc = b.st[0], nx = b.st[1];
        if (nloc == 0u) { xcd_barrier_complete(bar, b.x, nloc, nx); b.st[0] = nloc; b.st[1] = nx; }
        const unsigned old = xb_add(&bar[XB_XSUB(b.x)], 1u);
        const unsigned gen = old / nloc;
        if (old + 1u == (gen + 1u) * nloc) {
            __builtin_amdgcn_fence(__ATOMIC_RELEASE, "agent");
            asm volatile("s_waitcnt vmcnt(0)" ::: "memory");
            const unsigned og = xb_add(&bar[XB_TOP], 1u);
            const unsigned tg = og / nx;
            if (og + 1u == (tg + 1u) * nx) xb_add(&bar[XB_TOPGEN], 1u);
            else XB_SPIN(xb_ld(&bar[XB_TOPGEN]) == tg, bar);
            __builtin_amdgcn_fence(__ATOMIC_ACQUIRE, "agent");
            xb_add(&bar[XB_XGEN(b.x)], 1u);
            asm volatile("s_waitcnt vmcnt(0)" ::: "memory");
        } else {
            XB_SPIN(xb_ld(&bar[XB_XGEN(b.x)]) == gen, bar);
            __builtin_amdgcn_fence(__ATOMIC_ACQUIRE, "agent");
            asm volatile("s_waitcnt vmcnt(0)" ::: "memory");
        }
    }
    __syncthreads();
}

struct Args { const float* in[18]; float* out; unsigned char* ws; int ph_lo, ph_hi; };

__device__ __forceinline__ float wave_sum(float v) {
#pragma unroll
    for (int o = 1; o < 64; o <<= 1) v += __shfl_xor(v, o);
    return v;
}
__device__ __forceinline__ void tr_item(const float* W, int ldw, int K, int k0, int nsrc0, int ncols, bf16* WT, int drow0, LAS float* scr, int lane, const float* ksc = nullptr) {
    const int c = lane & 31;
#pragma unroll 8
    for (int i = 0; i < 32; ++i) { const int kk = 2 * i + (lane >> 5); float w = (c < ncols) ? W[(size_t)(k0 + kk) * ldw + nsrc0 + c] : 0.f; if (ksc) w *= ksc[k0 + kk]; scr[kk * 33 + c] = w; }
    LDS_WAIT(); asm volatile("" ::: "memory");
    const int c8 = lane & 7;
#pragma unroll
    for (int j = 0; j < 4; ++j) { const int n = (lane >> 3) + 8 * j; const LAS float* s = scr + (8 * c8) * 33 + n;
        v4u o; o.x = cvt_pk_bf16(s[0 * 33], s[1 * 33]); o.y = cvt_pk_bf16(s[2 * 33], s[3 * 33]); o.z = cvt_pk_bf16(s[4 * 33], s[5 * 33]); o.w = cvt_pk_bf16(s[6 * 33], s[7 * 33]);
        if (n < ncols) *(GAS v4u*)(WT + (size_t)(drow0 + n) * K + k0 + 8 * c8) = o; }
    LDS_WAIT(); asm volatile("" ::: "memory");
}
__device__ __forceinline__ void rms_row_bf16(const float* xrow, const float* g, bf16* orow, int lane) {
    const f32x4* xr = (const f32x4*)xrow + lane; const f32x4* gr = (const f32x4*)g + lane;
    f32x4 v[16]; float s = 0.f;
#pragma unroll
    for (int j = 0; j < 16; ++j) { v[j] = xr[64 * j]; s += (v[j].x * v[j].x + v[j].y * v[j].y) + (v[j].z * v[j].z + v[j].w * v[j].w); }
    const float rstd = rsqrtf(wave_sum(s) * (1.f / DM) + EPS);
    v2u* o8 = (v2u*)orow + lane;
#pragma unroll
    for (int j = 0; j < 16; ++j) { const f32x4 gg = gr[64 * j]; v2u w; w.x = cvt_pk_bf16(v[j].x * rstd * gg.x, v[j].y * rstd * gg.y); w.y = cvt_pk_bf16(v[j].z * rstd * gg.z, v[j].w * rstd * gg.w); o8[64 * j] = w; }
}
__device__ __forceinline__ float bf_lo(unsigned w) { return __uint_as_float(w << 16); }
__device__ __forceinline__ float bf_hi(unsigned w) { return __uint_as_float(w & 0xffff0000u); }

__global__ void __launch_bounds__(NWAVES * 64, 2) fwd_kernel(Args args) {
    extern __shared__ __attribute__((aligned(16))) unsigned char lds_raw[];
    LAS unsigned char* lds = (LAS unsigned char*)lds_raw;
    volatile LAS unsigned* MISC = (volatile LAS unsigned*)(lds + MISC_OFF);
    const int tid = threadIdx.x, lane = tid & 63, wave = __builtin_amdgcn_readfirstlane(tid >> 6);
    const int G = gridDim.x; const int bx = blockIdx.x; const int vcu = (G % 8 == 0) ? (bx % 8) * (G / 8) + bx / 8 : bx;
    unsigned char* ws = args.ws; float* out = args.out;
    gu32* ctl = (gu32*)(ws + WS_CTL);
    const float* x_prompt = args.in[0]; const float* x_sample = args.in[1];
    const float* cache_fk = args.in[2]; const float* cache_fv = args.in[3]; const float* cache_fl = args.in[4]; const float* cache_sk = args.in[5]; const float* cache_sv = args.in[6];
    const float* g_attn = args.in[7]; const float* w_in = args.in[8]; const float* b_forget = args.in[9]; const float* g_of = args.in[10]; const float* g_os = args.in[11];
    const float* w_out = args.in[12]; const float* g_ffn = args.in[13]; const float* w_gate = args.in[14]; const float* w_up = args.in[15]; const float* w_down = args.in[16]; const float* g_final = args.in[17];
    bf16* Win_t = (bf16*)(ws + WS_WIN); bf16* Wout_t = (bf16*)(ws + WS_WOUT); bf16* Wgu_t = (bf16*)(ws + WS_WGU); bf16* Wdn_t = (bf16*)(ws + WS_WDN);
    bf16* XN = (bf16*)(ws + WS_XN); bf16* QO = (bf16*)(ws + WS_QO); bf16* KVB = (bf16*)(ws + WS_KV); bf16* ACT = (bf16*)(ws + WS_ACT);

    for (int u = tid; u < (LDS_BYTES - LDSCTL_OFF) / 4; u += NWAVES * 64) ((LAS unsigned*)(lds + LDSCTL_OFF))[u] = 0u;
    __syncthreads();
    XcdBarrier bar; bar.bar = (unsigned*)(ctl + CW_BAR); bar.x = 0; bar.st = nullptr;
    if (MK_N_LAUNCHES == 1) bar = xcd_barrier_post((unsigned*)(ctl + CW_BAR), MISC + 8);
    const int lo = args.ph_lo, hi_ph = args.ph_hi;
#ifndef PH_MASK
#define PH_MASK 0x1ff
#endif
#define IN(k) (((PH_MASK >> (k)) & 1) && lo <= (k) && (k) < hi_ph)
#define BOTH(k) (IN(k) && IN((k) + 1))
#define GRID_BAR() do { if (MK_N_LAUNCHES == 1) xcd_barrier(bar); } while (0)
    const int gw = vcu * NWAVES + wave, NGW = G * NWAVES;

    if (IN(0)) {
        LAS float* scr = (LAS float*)(lds + RING_OFF + wave * 16384);
        constexpr int KB4 = DM / 64;
        constexpr int I_INA = KB4 * (3 * WG / 32), I_INB = I_INA, I_FL = KB4, I_OUT = KB4 * (DM / 32), I_G = KB4 * (DFF / 32), I_U = I_G, I_D = (DFF / 64) * (DM / 32);
        constexpr int NITEMS = I_INA + I_INB + I_FL + I_OUT + I_G + I_U + I_D;
        for (int it = gw; it < NITEMS; it += NGW) {
            int r = it;
            if (r < I_INA) { const int kb = r / 192, nb = r % 192; tr_item(w_in, DIN, DM, 64 * kb, 32 * nb, 32, Win_t, 32 * nb, scr, lane); continue; } r -= I_INA;
            if (r < I_INB) { const int kb = r / 192, nb = r % 192; tr_item(w_in, DIN, DM, 64 * kb, 3 * WG + NHG + 32 * nb, 32, Win_t, 3 * WG + 32 * nb, scr, lane); continue; } r -= I_INB;
            if (r < I_FL) { tr_item(w_in, DIN, DM, 64 * r, 3 * WG, 16, Win_t, 6 * WG, scr, lane); continue; } r -= I_FL;
            if (r < I_OUT) { const int kb = r / 128, nb = r % 128; tr_item(w_out, DM, DM, 64 * kb, 32 * nb, 32, Wout_t, 32 * nb, scr, lane); continue; } r -= I_OUT;
            if (r < I_G) { const int kb = r / 344, nb = r % 344; const int n0 = 32 * nb; tr_item(w_gate, DFF, DM, 64 * kb, n0, 32, Wgu_t, (n0 >> 7) * 256 + (n0 & 127), scr, lane, g_ffn); continue; } r -= I_G;
            if (r < I_U) { const int kb = r / 344, nb = r % 344; const int n0 = 32 * nb; tr_item(w_up, DFF, DM, 64 * kb, n0, 32, Wgu_t, (n0 >> 7) * 256 + 128 + (n0 & 127), scr, lane, g_ffn); continue; } r -= I_U;
            { const int kb = r / 128, nb = r % 128; tr_item(w_down, DM, DFF, 64 * kb, 32 * nb, 32, Wdn_t, 32 * nb, scr, lane); }
        }
        for (int i = gw * 64 + lane; i < 240 * DM / 8; i += NGW * 64) *(v4u*)(Win_t + (size_t)(6 * WG + 16) * DM + (size_t)i * 8) = (v4u){0u, 0u, 0u, 0u};
        for (int m = gw; m < MT; m += NGW) rms_row_bf16(m < MP ? x_prompt + (size_t)m * DM : x_sample + (size_t)(m - MP) * DM, g_attn, XN + (size_t)m * DM, lane);
        for (int it = gw; it < 4 * DB * PAST; it += NGW) { const int kvi = it / (DB * PAST), rr = it % (DB * PAST), b = rr / PAST, t = rr % PAST;
            const float* src = (kvi == 0 ? cache_fk : kvi == 1 ? cache_fv : kvi == 2 ? cache_sk : cache_sv) + (size_t)rr * WG;
            bf16* dst = KVB + (size_t)kvi * (KV_STRIDE / 2) + (size_t)(MP + b * TKS + t) * WG;
#pragma unroll
            for (int j = 0; j < 8; ++j) { const f32x4 v = ((const f32x4*)src)[lane + 64 * j]; v2u w; w.x = cvt_pk_bf16(v.x, v.y); w.y = cvt_pk_bf16(v.z, v.w); ((v2u*)dst)[lane + 64 * j] = w; } }
        if (BOTH(0)) GRID_BAR();
    }

    if (IN(1)) {
        pg8::Gemm g{XN, Win_t, MT, NIN, DM}; pg8::StaticOrder S; S.init(MT, NIN, G, bx);
        pg8::EpiIn E{QO, KVB, out, b_forget};
        pg8::gemm_phase<pg8::EpiIn, pg8::StaticOrder, true, true>(lds + RING_OFF, g, S, E);
        if (BOTH(1)) GRID_BAR();
    }

    if (IN(2)) {
        LAS float* U = (LAS float*)(lds + att::OFF_U); LAS float* scn = (LAS float*)(lds + att::OFF_SCAN);
        constexpr int N_ITEMS = 512 + 512 + 256 + 256;
        for (int it = vcu; it < N_ITEMS; it += G) {
            if (it < 1024) {
                const int mode = it >> 9, r = it & 511, bh = r >> 2, pi = r & 3, b = bh >> 4, h = bh & 15;
                const bf16* Kp = KVB + (size_t)(mode * 2) * (KV_STRIDE / 2) + (size_t)(b * SEQ) * WG + h * HD;
                const bf16* Vp = Kp + (KV_STRIDE / 2);
                bf16* Qp = QO + (size_t)(b * SEQ) * DM + mode * WG + h * HD;
                if (mode == 0) {
                    const float* lf = out + O_PFL + (size_t)(b * SEQ) * NHG + h;
                    att::scan_u(U, scn, SEQ, [&](int t) { return lf[(size_t)t * NHG]; });
                }
#pragma unroll 1
                for (int pass = 0; pass < 2; ++pass) { const int qb = pass ? 7 - pi : pi; bf16* Qb = Qp + (size_t)(qb * 256) * DM;
#ifndef NO_FOX
                    if (mode == 0) att::attn_unit<0>(lds + RING_OFF, Qb, Kp, Vp, Qb, qb * 256, SEQ, 8);
#endif
#ifndef NO_SB
                    if (mode == 1) att::attn_unit<1>(lds + RING_OFF, Qb, Kp, Vp, Qb, qb * 256, SEQ, 8);
#endif
 }
            } else {
                const int r = it - 1024, mode = r >> 8, bh = r & 255, b = bh >> 4, h = bh & 15;
                const bf16* Kp = KVB + (size_t)(mode * 2) * (KV_STRIDE / 2) + (size_t)(MP + b * TKS) * WG + h * HD;
                const bf16* Vp = Kp + (KV_STRIDE / 2);
                bf16* Qb = QO + (size_t)(MP + b * DS) * DM + mode * WG + h * HD;
                if (mode == 0) {
                    const float* lfc = cache_fl + (size_t)(b * PAST) * NHG + h; const float* lfn = out + O_SFL + (size_t)(b * DS) * NHG + h;
                    att::scan_u(U, scn, TKS, [&](int t) { return t < PAST ? lfc[(size_t)t * NHG] : lfn[(size_t)(t - PAST) * NHG]; });
#ifndef NO_FOX
                    att::attn_unit<0>(lds + RING_OFF, Qb, Kp, Vp, Qb, PAST, TKS, 1);
#endif
                } else {
#ifndef NO_SB
                    att::attn_unit<1>(lds + RING_OFF, Qb, Kp, Vp, Qb, PAST, TKS, 1);
#endif
                }
            }
        }
        if (BOTH(2)) GRID_BAR();
    }

    if (IN(3)) {
        for (int m = gw; m < MT; m += NGW) { v4u* row = (v4u*)(QO + (size_t)m * DM) + lane;
            v4u v[8]; float sf = 0.f, ss = 0.f;
#pragma unroll
            for (int j = 0; j < 8; ++j) { v[j] = row[64 * j]; float s = 0.f;
#pragma unroll
                for (int e = 0; e < 4; ++e) { const float a = bf_lo(v[j][e]), b = bf_hi(v[j][e]); s += a * a + b * b; }
                if (j < 4) sf += s; else ss += s; }
            const float rf = rsqrtf(wave_sum(sf) * (1.f / WG) + EPS), rs = rsqrtf(wave_sum(ss) * (1.f / WG) + EPS);
#pragma unroll
            for (int j = 0; j < 8; ++j) { const float rr = j < 4 ? rf : rs; const float* gp = (j < 4 ? g_of : g_os) + (lane + 64 * (j & 3)) * 8;
                const f32x4 g0 = *(const f32x4*)gp, g1 = *(const f32x4*)(gp + 4); v4u w;
                w.x = cvt_pk_bf16(bf_lo(v[j].x) * rr * g0.x, bf_hi(v[j].x) * rr * g0.y); w.y = cvt_pk_bf16(bf_lo(v[j].y) * rr * g0.z, bf_hi(v[j].y) * rr * g0.w);
                w.z = cvt_pk_bf16(bf_lo(v[j].z) * rr * g1.x, bf_hi(v[j].z) * rr * g1.y); w.w = cvt_pk_bf16(bf_lo(v[j].w) * rr * g1.z, bf_hi(v[j].w) * rr * g1.w);
                row[64 * j] = w; } }
        { constexpr size_t CH_PER = (size_t)MP * WG / 8, NCH = 4 * CH_PER;
          for (size_t g = (size_t)gw * 64 + lane; g < NCH; g += (size_t)NGW * 64) { const int kvi = (int)(g / CH_PER); const size_t rem = g % CH_PER;
              const v4u x = *(const v4u*)(KVB + (size_t)kvi * (KV_STRIDE / 2) + rem * 8);
              float* dst = out + O_PFK + (size_t)kvi * ((size_t)MP * WG) + (kvi >= 2 ? (size_t)MP * NHG : 0) + rem * 8;
              *(f32x4*)dst = (f32x4){bf_lo(x.x), bf_hi(x.x), bf_lo(x.y), bf_hi(x.y)}; *(f32x4*)(dst + 4) = (f32x4){bf_lo(x.z), bf_hi(x.z), bf_lo(x.w), bf_hi(x.w)}; } }
        if (BOTH(3)) GRID_BAR();
    }

    float* SSQ = (float*)(ctl + CW_SSQ);
    if (IN(4)) {
        pg8::Gemm g{QO, Wout_t, MT, DM, DM}; pg8::StaticOrder S; S.init(MT, DM, G, bx);
        pg8::EpiX2 E{x_prompt, x_sample, XN, SSQ};
        pg8::gemm_phase<pg8::EpiX2, pg8::StaticOrder, true, true>(lds + RING_OFF, g, S, E);
        if (BOTH(4)) GRID_BAR();
    }

    if (IN(6)) {
        pg8::Gemm g{XN, Wgu_t, MT, 2 * DFF, DM}; pg8::StaticOrder S; S.init(MT, 2 * DFF, G, bx);
        pg8::EpiGlu E{ACT, SSQ};
        pg8::gemm_phase<pg8::EpiGlu, pg8::StaticOrder, true, true>(lds + RING_OFF, g, S, E);
        if (BOTH(6)) GRID_BAR();
    }

    if (IN(7)) {
        pg8::Gemm g{ACT, Wdn_t, MT, DM, DFF}; pg8::StaticOrder S; S.init(MT, DM, G, bx);
        pg8::EpiDown E{XN, out};
        pg8::gemm_phase<pg8::EpiDown, pg8::StaticOrder, true, true>(lds + RING_OFF, g, S, E);
        if (BOTH(7)) GRID_BAR();
    }

    if (IN(8)) {
        for (int m = gw; m < MT; m += NGW) { f32x4* xr = (f32x4*)(out + (size_t)m * DM) + lane; const f32x4* gr = (const f32x4*)g_final + lane;
            f32x4 v[16]; float s = 0.f;
#pragma unroll
            for (int j = 0; j < 16; ++j) { v[j] = xr[64 * j]; s += (v[j].x * v[j].x + v[j].y * v[j].y) + (v[j].z * v[j].z + v[j].w * v[j].w); }
            const float rstd = rsqrtf(wave_sum(s) * (1.f / DM) + EPS);
#pragma unroll
            for (int j = 0; j < 16; ++j) { const f32x4 gg = gr[64 * j]; xr[64 * j] = v[j] * rstd * gg; } }
    }
#undef IN
#undef BOTH
#undef GRID_BAR
}

extern "C" void kernel_launch(void* const* d_in, const int* in_sizes, int n_in, void* d_out, int out_size, void* d_ws, size_t ws_size, hipStream_t stream) {
    static int grid = 0;
    if (grid == 0) {
        if (n_in != 18 || (size_t)out_size != O_END || ws_size < WS_END) { fprintf(stderr, "kernel_launch: unexpected shapes (n_in %d, out %d, ws %zu)\n", n_in, out_size, ws_size); grid = -1; return; }
        int dev = 0, cus = 0;
        if (hipGetDevice(&dev) != hipSuccess || hipDeviceGetAttribute(&cus, hipDeviceAttributeMultiprocessorCount, dev) != hipSuccess) { grid = -1; return; }
        if (hipFuncSetAttribute((const void*)fwd_kernel, hipFuncAttributeMaxDynamicSharedMemorySize, LDS_BYTES) != hipSuccess) { fprintf(stderr, "kernel_launch: hipFuncSetAttribute failed\n"); grid = -1; return; }
        int per_cu = 0;
        if (hipOccupancyMaxActiveBlocksPerMultiprocessor(&per_cu, (const void*)fwd_kernel, NWAVES * 64, LDS_BYTES) != hipSuccess || per_cu < 1) fprintf(stderr, "kernel_launch: occupancy query says %d\n", per_cu);
        (void)hipGetLastError();
        grid = cus;
    }
    if (grid < 0) return;
    (void)hipMemsetAsync((char*)d_ws + WS_CTL, 0, CTL_ZERO_BYTES, stream);
    Args a{};
    for (int i = 0; i < 18; ++i) a.in[i] = (const float*)d_in[i];
    a.out = (float*)d_out; a.ws = (unsigned char*)d_ws;
#if MK_N_LAUNCHES == 1
    a.ph_lo = 0; a.ph_hi = 9;
    hipLaunchKernelGGL(fwd_kernel, dim3(grid), dim3(NWAVES * 64), LDS_BYTES, stream, a);
#else
    for (int p = 0; p < 9; ++p) { a.ph_lo = p; a.ph_hi = p + 1; hipLaunchKernelGGL(fwd_kernel, dim3(grid), dim3(NWAVES * 64), LDS_BYTES, stream, a); }
#endif
}
```

```cpp
#include <hip/hip_runtime.h>
#include <cstdio>
#include <cstdint>

#ifndef MK_N_LAUNCHES
#define MK_N_LAUNCHES 1
#endif

#define GAS __attribute__((address_space(1)))
#define LAS __attribute__((address_space(3)))
typedef unsigned short bf16;
typedef unsigned v4u __attribute__((ext_vector_type(4)));
typedef unsigned v2u __attribute__((ext_vector_type(2)));
typedef float f32x4 __attribute__((ext_vector_type(4)));
typedef float f32x16 __attribute__((ext_vector_type(16)));
typedef short bf16x8 __attribute__((ext_vector_type(8)));
typedef short s16x4 __attribute__((ext_vector_type(4)));
typedef GAS unsigned gu32;

constexpr int DM = 4096, NB = 8, SEQ = 2048, DB = 16, DS = 32, PAST = 1024, HD = 128, NHG = 16;
constexpr int WG = NHG * HD;
constexpr int DFF = 11008;
constexpr int MP = NB * SEQ, MS = DB * DS, MT = MP + MS;
constexpr int DIN = 3 * WG + NHG + 3 * WG;
constexpr int NIN = 6 * WG + 256;
constexpr int TKS = PAST + DS;
constexpr int KVROWS = MP + DB * TKS;
constexpr float EPS = 1e-6f;
constexpr float LOG2E = 1.4426950408889634f;
constexpr float QSCALE = 0.08838834764831845f * LOG2E;

constexpr size_t O_YP = 0, O_YS = O_YP + (size_t)MP * DM;
constexpr size_t O_PFK = O_YS + (size_t)MS * DM, O_PFV = O_PFK + (size_t)MP * WG, O_PFL = O_PFV + (size_t)MP * WG;
constexpr size_t O_PSK = O_PFL + (size_t)MP * NHG, O_PSV = O_PSK + (size_t)MP * WG;
constexpr size_t O_SFK = O_PSV + (size_t)MP * WG, O_SFV = O_SFK + (size_t)MS * WG, O_SFL = O_SFV + (size_t)MS * WG;
constexpr size_t O_SSK = O_SFL + (size_t)MS * NHG, O_SSV = O_SSK + (size_t)MS * WG, O_END = O_SSV + (size_t)MS * WG;

constexpr size_t MiB = 1u << 20;
constexpr size_t WS_CTL = 0, CTL_ZERO_BYTES = 1 * MiB;
constexpr size_t WS_WIN = 2 * MiB;
constexpr size_t WS_WOUT = 100 * MiB;
constexpr size_t WS_WGU = 132 * MiB;
constexpr size_t WS_WDN = 304 * MiB;
constexpr size_t WS_XN = 390 * MiB;
constexpr size_t WS_QO = 522 * MiB;
constexpr size_t WS_KV = 654 * MiB, KV_STRIDE = 130 * MiB;
constexpr size_t WS_ACT = 654 * MiB;
constexpr size_t WS_PART = 1174 * MiB;
constexpr size_t WS_END = 1238 * MiB;
static_assert((size_t)NIN * DM * 2 == 98 * MiB && (size_t)2 * DFF * DM * 2 == 172 * MiB && (size_t)DM * DFF * 2 == 86 * MiB && (size_t)MT * DM * 2 == 132 * MiB && (size_t)KVROWS * WG * 2 == KV_STRIDE, "ws map");
static_assert(WS_ACT + (size_t)MT * DFF * 2 <= WS_PART && WS_KV + 4 * KV_STRIDE == WS_PART && WS_PART + (size_t)8 * MS * DM * 4 == WS_END, "ws map");
constexpr int CW_TMO = 0, CW_CODE = 1, CW_BAR = 4096, CW_SSQ = 16384;
static_assert((CW_SSQ + MT) * 4 <= (int)CTL_ZERO_BYTES, "ctl");

constexpr int NWAVES = 8;
constexpr int RING_OFF = 0, RING_BYTES = 131072;
constexpr int LDSCTL_OFF = RING_BYTES, MISC_OFF = LDSCTL_OFF + 320;
constexpr int LDS_BYTES = 147456;

#define RLX_AGENT __ATOMIC_RELAXED, __HIP_MEMORY_SCOPE_AGENT
#define LDS_WAIT() asm volatile("s_waitcnt lgkmcnt(0)" ::: "memory")
#define VM_WAIT() asm volatile("s_waitcnt vmcnt(0)" ::: "memory")

__device__ __forceinline__ unsigned cvt_pk_bf16(float lo, float hi) { unsigned r; asm volatile("v_cvt_pk_bf16_f32 %0, %1, %2" : "=v"(r) : "v"(lo), "v"(hi)); return r; }

namespace pg8 {
#define PG8_LAS __attribute__((address_space(3)))
typedef unsigned short bf16_t;
constexpr int BM = 256, BK = 64, HALF = 128, HTB = HALF * BK * 2, STAGE_BYTES = 8 * HTB, NXCD = 8, WGM = 8;
__host__ __device__ __forceinline__ int lds_byte(int r, int c) { const int st = (r >> 4) * 2 + (c >> 5), rr = r & 15, cc = c & 31, ob = rr * 64 + cc * 2; return st * 1024 + (ob ^ (((ob >> 9) & 1) << 5)); }
__host__ __device__ __forceinline__ void stage_rc(int b, int& R, int& C) { const int st = b / 1024, sb = b % 1024, swz = sb ^ (((sb >> 9) & 1) << 5); R = (st >> 1) * 16 + swz / 64; C = (st & 1) * 32 + (swz % 64) / 2; }
__host__ __device__ __forceinline__ int perm32(int rho) { const int n = rho >> 4, i = rho & 15; return 8 * (i >> 2) + 4 * n + (i & 3); }
struct Unit { int pm, pn, kt0, nkt, ks; };
struct Gemm { const bf16_t* A; const bf16_t* Bt; int M, N, K; };
struct StaticOrder {
    int nM, nN, nwg, G, c, nkt_full;
    __host__ __device__ void init(int M, int N, int K, int G_, int c_) { nM = M / BM; nN = N / BM; nwg = nM * nN; G = G_; c = c_; nkt_full = K / BK; }
    __host__ __device__ __forceinline__ void decode(int L, int& pm, int& pn) const {
        int wgid = L; { const int q = nwg / NXCD, r = nwg % NXCD, xcd = wgid % NXCD, off = wgid / NXCD; wgid = (xcd < r ? xcd * (q + 1) : r * (q + 1) + (xcd - r) * q) + off; }
        const int nig = WGM * nN, gid = wgid / nig, fm = gid * WGM, gsz = (nM - fm) < WGM ? (nM - fm) : WGM;
        pm = fm + ((wgid % nig) % gsz); pn = (wgid % nig) / gsz;
    }
    __host__ __device__ __forceinline__ bool next(int i, Unit& u) const {
        const long L = (long)i * G + c; if (L >= nwg) return false;
        int pm, pn; decode((int)L, pm, pn);
        u.pm = pm; u.pn = pn; u.kt0 = 0; u.nkt = nkt_full; u.ks = -1; return true;
    }
    __device__ __forceinline__ void a_ready(const Unit&) const {}
    __device__ __forceinline__ void done(const Unit&) const {}
};
struct DownOrder : StaticOrder {
    __device__ __forceinline__ bool next(int i, Unit& u) const {
        const long L = (long)i * G + c; const bool g256 = (G == 256);
        if (g256 ? (i > 4) : (L >= nwg + 32)) return false;
        const bool stat = g256 ? (i < 4) : (L < nwg), spl = g256 && i == 4;
        const int tile = g256 ? (c >> 3) : (int)(L - nwg), ks = c & 7;
        int pm, pn; decode(stat ? (int)L : 0, pm, pn);
        u.pm = stat ? pm : MP / BM + (tile >> 4); u.pn = stat ? pn : (tile & 15);
        u.ks = spl ? ks : -1; u.kt0 = spl ? (ks < 6 ? 22 * ks : 132 + 20 * (ks - 6)) : 0; u.nkt = spl ? (ks < 6 ? 22 : 20) : nkt_full;
        return true;
    }
};
template <class Epi, class Sched, bool ALIGN_EPI = false, bool SP2 = false>
__device__ __forceinline__ void gemm_phase(PG8_LAS unsigned char* lds, const Gemm g, const Sched& S, const Epi& E) {
    const int tid = threadIdx.x, wid = __builtin_amdgcn_readfirstlane(tid >> 6), lane = tid & 63, wr = wid >> 2, wc = wid & 3, fr = lane & 15, fq = lane >> 4;
    const int K = g.K;
    unsigned voffA[2], voffB[2];
#pragma unroll
    for (int i = 0; i < 2; ++i) { int R, C; stage_rc(tid * 16 + i * 8192, R, C); const int Rb = Epi::PERM ? ((R & ~31) + perm32(R & 31)) : R;
        voffA[i] = (unsigned)(R * K + C) * 2u; voffB[i] = (unsigned)(Rb * K + C) * 2u; }
    const size_t kstep = (size_t)(BK * 2);
    const size_t hstep = (size_t)HALF * K * 2;
    const size_t tstep = 2 * hstep;
    const unsigned ldsw = (unsigned)wid * 1024u;
    const int aoff = lds_byte(wr * 64 + fr, fq * 8), boff = lds_byte(wc * 32 + fr, fq * 8);
#define PG8_SA(b, h) (((b) * 2 + (h)) * HTB)
#define PG8_SB(b, h) ((4 + (b) * 2 + (h)) * HTB)
#define PG8_STAGE(bufoff, gbase, voff) do { _Pragma("unroll") for (int _i = 0; _i < 2; ++_i) \
        __builtin_amdgcn_global_load_lds((const unsigned*)((const char*)(gbase) + (voff)[_i]), (PG8_LAS unsigned*)(lds + (bufoff) + ldsw + _i * 8192), 16, 0, 0); } while (0)
#define PG8_LDA(dst, b, h) do { _Pragma("unroll") for (int m = 0; m < 4; ++m) _Pragma("unroll") for (int k = 0; k < 2; ++k) dst[m][k] = *(const PG8_LAS bf16x8*)(lds + PG8_SA(b, h) + aoff + m * 2048 + k * 1024); } while (0)
#define PG8_LDB(dst, b, h) do { _Pragma("unroll") for (int n = 0; n < 2; ++n) _Pragma("unroll") for (int k = 0; k < 2; ++k) dst[n][k] = *(const PG8_LAS bf16x8*)(lds + PG8_SB(b, h) + boff + n * 2048 + k * 1024); } while (0)
#define PG8_MMA(ai, bj, At, Bt) do { __builtin_amdgcn_s_setprio(1); _Pragma("unroll") for (int m = 0; m < 4; ++m) _Pragma("unroll") for (int n = 0; n < 2; ++n) _Pragma("unroll") for (int k = 0; k < 2; ++k) \
        acc[ai][bj][m][n] = __builtin_amdgcn_mfma_f32_16x16x32_bf16(Bt[n][k], At[m][k], acc[ai][bj][m][n], 0, 0, 0); __builtin_amdgcn_s_setprio(0); } while (0)
#define PG8_WAIT_V(n) asm volatile("s_waitcnt vmcnt(" #n ")" ::: "memory")
#define PG8_WAIT_L(n) asm volatile("s_waitcnt lgkmcnt(" #n ")" ::: "memory")
#define PG8_BAR __builtin_amdgcn_s_barrier()
#define PG8_SCHED __builtin_amdgcn_sched_barrier(0)
    Unit cur, nxt; int ui = 0;
    if (!S.next(0, cur)) return;
    f32x4 acc[2][2][4][2];
#pragma unroll
    for (int a = 0; a < 2; ++a)
#pragma unroll
        for (int b = 0; b < 2; ++b)
#pragma unroll
            for (int m = 0; m < 4; ++m)
#pragma unroll
                for (int n = 0; n < 2; ++n) acc[a][b][m][n] = (f32x4){0.f, 0.f, 0.f, 0.f};
    bf16x8 At[4][2], B0[2][2], B1[2][2];
    const char* cA = (const char*)g.A + (size_t)cur.pm * tstep + (size_t)cur.kt0 * kstep; const char* cB = (const char*)g.Bt + (size_t)cur.pn * tstep + (size_t)cur.kt0 * kstep;
    S.a_ready(cur);
    if constexpr (SP2) {
        PG8_STAGE(PG8_SB(0, 0), cB, voffB); PG8_STAGE(PG8_SB(0, 1), cB + hstep, voffB); PG8_STAGE(PG8_SA(0, 0), cA, voffA); PG8_STAGE(PG8_SA(0, 1), cA + hstep, voffA);
        if (wr == 1) PG8_BAR;
        PG8_WAIT_V(2); PG8_BAR;
        PG8_STAGE(PG8_SB(1, 0), cB + kstep, voffB); PG8_STAGE(PG8_SA(1, 0), cA + kstep, voffA); PG8_STAGE(PG8_SB(1, 1), cB + hstep + kstep, voffB);
        PG8_WAIT_V(6); PG8_BAR;
    } else {
        PG8_STAGE(PG8_SB(0, 0), cB, voffB); PG8_STAGE(PG8_SA(0, 0), cA, voffA); PG8_STAGE(PG8_SB(0, 1), cB + hstep, voffB); PG8_STAGE(PG8_SA(0, 1), cA + hstep, voffA);
        if (wr == 1) PG8_BAR;
        PG8_WAIT_V(4); PG8_BAR;
        PG8_STAGE(PG8_SB(1, 0), cB + kstep, voffB); PG8_STAGE(PG8_SA(1, 0), cA + kstep, voffA); PG8_STAGE(PG8_SB(1, 1), cB + hstep + kstep, voffB);
        PG8_WAIT_V(6); PG8_BAR;
    }
    for (;;) {
        const bool has_next = S.next(ui + 1, nxt);
        const char* nA = has_next ? (const char*)g.A + (size_t)nxt.pm * tstep + (size_t)nxt.kt0 * kstep : cA; const char* nB = has_next ? (const char*)g.Bt + (size_t)nxt.pn * tstep + (size_t)nxt.kt0 * kstep : cB;
        const int nt = cur.nkt;
        for (int t = 0; t < nt; t += 2) {
            const bool last = (t == nt - 2);
            const char* a1 = cA + (size_t)(t + 1) * kstep;
            const char* a2 = last ? nA : cA + (size_t)(t + 2) * kstep; const char* b2 = last ? nB : cB + (size_t)(t + 2) * kstep;
            const char* a3 = a2 + kstep; const char* b3 = b2 + kstep;
            if (last && has_next) S.a_ready(nxt);
            if constexpr (SP2) {
            PG8_LDB(B0, 0, 0); PG8_LDB(B1, 0, 1); PG8_SCHED; PG8_LDA(At, 0, 0); PG8_STAGE(PG8_SA(1, 1), a1 + hstep, voffA);
            PG8_WAIT_V(8); PG8_WAIT_L(0); PG8_BAR; PG8_MMA(0, 0, At, B0); PG8_MMA(0, 1, At, B1); PG8_BAR; PG8_SCHED;
            PG8_LDA(At, 0, 1); PG8_STAGE(PG8_SB(0, 0), b2, voffB); PG8_STAGE(PG8_SB(0, 1), b2 + hstep, voffB); PG8_STAGE(PG8_SA(0, 0), a2, voffA);
            PG8_WAIT_V(8); PG8_WAIT_L(0); PG8_BAR; PG8_MMA(1, 0, At, B0); PG8_MMA(1, 1, At, B1); PG8_BAR; PG8_SCHED;
            PG8_LDB(B0, 1, 0); PG8_LDB(B1, 1, 1); PG8_SCHED; PG8_LDA(At, 1, 0); PG8_STAGE(PG8_SA(0, 1), a2 + hstep, voffA);
            PG8_WAIT_V(8); PG8_WAIT_L(0); PG8_BAR; PG8_MMA(0, 0, At, B0); PG8_MMA(0, 1, At, B1); PG8_BAR; PG8_SCHED;
            PG8_LDA(At, 1, 1); PG8_STAGE(PG8_SB(1, 0), b3, voffB); PG8_STAGE(PG8_SB(1, 1), b3 + hstep, voffB); PG8_STAGE(PG8_SA(1, 0), a3, voffA);
            PG8_WAIT_V(8); PG8_WAIT_L(0); PG8_BAR; PG8_MMA(1, 0, At, B0); PG8_MMA(1, 1, At, B1); PG8_BAR; PG8_SCHED;
            } else {
            PG8_LDB(B0, 0, 0); PG8_SCHED; PG8_LDA(At, 0, 0); PG8_STAGE(PG8_SA(1, 1), a1 + hstep, voffA);
            PG8_WAIT_L(8); PG8_BAR; PG8_WAIT_L(0); PG8_MMA(0, 0, At, B0); PG8_BAR; PG8_SCHED;
            PG8_LDB(B1, 0, 1); PG8_STAGE(PG8_SB(0, 0), b2, voffB);
            PG8_BAR; PG8_WAIT_L(0); PG8_MMA(0, 1, At, B1); PG8_BAR;
            PG8_LDA(At, 0, 1); PG8_STAGE(PG8_SA(0, 0), a2, voffA);
            PG8_BAR; PG8_WAIT_L(0); PG8_MMA(1, 0, At, B0); PG8_BAR; PG8_SCHED;
            PG8_STAGE(PG8_SB(0, 1), b2 + hstep, voffB);
            PG8_WAIT_V(6); PG8_BAR; PG8_MMA(1, 1, At, B1); PG8_BAR;
            PG8_LDB(B0, 1, 0); PG8_SCHED; PG8_LDA(At, 1, 0); PG8_STAGE(PG8_SA(0, 1), a2 + hstep, voffA);
            PG8_WAIT_L(8); PG8_BAR; PG8_WAIT_L(0); PG8_MMA(0, 0, At, B0); PG8_BAR; PG8_SCHED;
            PG8_LDB(B1, 1, 1); PG8_STAGE(PG8_SB(1, 0), b3, voffB);
            PG8_BAR; PG8_WAIT_L(0); PG8_MMA(0, 1, At, B1); PG8_BAR;
            PG8_LDA(At, 1, 1); PG8_STAGE(PG8_SA(1, 0), a3, voffA);
            PG8_BAR; PG8_WAIT_L(0); PG8_MMA(1, 0, At, B0); PG8_BAR; PG8_SCHED;
            PG8_STAGE(PG8_SB(1, 1), b3 + hstep, voffB);
            PG8_WAIT_V(6); PG8_BAR; PG8_MMA(1, 1, At, B1); PG8_BAR;
            }
        }
        if constexpr (ALIGN_EPI) { if (wr == 0) PG8_BAR; }
        E(acc, cur, wr, wc, fr, fq); S.done(cur);
        if (!has_next) break;
#pragma unroll
        for (int a = 0; a < 2; ++a)
#pragma unroll
            for (int b = 0; b < 2; ++b)
#pragma unroll
                for (int m = 0; m < 4; ++m)
#pragma unroll
                    for (int n = 0; n < 2; ++n) acc[a][b][m][n] = (f32x4){0.f, 0.f, 0.f, 0.f};
        cur = nxt; cA = nA; cB = nB; ++ui;
        if constexpr (ALIGN_EPI) { if (wr == 1) PG8_BAR; }
    }
    PG8_WAIT_V(0);
    if constexpr (!ALIGN_EPI) { if (wr == 0) PG8_BAR; }
    PG8_BAR;
#undef PG8_SA
#undef PG8_SB
#undef PG8_STAGE
#undef PG8_LDA
#undef PG8_LDB
#undef PG8_MMA
#undef PG8_WAIT_V
#undef PG8_WAIT_L
#undef PG8_BAR
#undef PG8_SCHED
}

__device__ __forceinline__ float log_sigmoid_f(float x) { return -(fmaxf(-x, 0.f) + log1pf(expf(-fabsf(x)))); }
struct EpiIn {
    static constexpr bool PERM = true;
    bf16_t* QO; bf16_t* KV; float* out; const float* bfg;
    __device__ __forceinline__ void operator()(const f32x4 (&acc)[2][2][4][2], const Unit& u, int wr, int wc, int fr, int fq) const {
        const int seg = u.pn >> 3;
        const int row0 = u.pm * BM + wr * 64 + fr;
        const int cseg = (u.pn & 7) * BM + wc * 32 + 8 * fq;
        const bool prompt = u.pm < (MP / BM);
        if (seg == 6) {
            if (wc == 0 && fq < 2) {
                const f32x4 b0 = *(const f32x4*)(bfg + 8 * fq), b1 = *(const f32x4*)(bfg + 8 * fq + 4);
#pragma unroll
                for (int ai = 0; ai < 2; ++ai)
#pragma unroll
                    for (int m = 0; m < 4; ++m) { const int row = row0 + ai * HALF + m * 16;
                        float* dst = prompt ? out + O_PFL + (size_t)row * NHG + 8 * fq : out + O_SFL + (size_t)(row - MP) * NHG + 8 * fq;
                        const f32x4 v0 = acc[ai][0][m][0] + b0, v1 = acc[ai][0][m][1] + b1; f32x4 r0, r1;
#pragma unroll
                        for (int j = 0; j < 4; ++j) { r0[j] = log_sigmoid_f(v0[j]); r1[j] = log_sigmoid_f(v1[j]); }
                        *(f32x4*)dst = r0; *(f32x4*)(dst + 4) = r1; }
            }
        } else if (seg == 0 || seg == 3) {
            bf16_t* base = QO + (seg == 3 ? WG : 0) + cseg;
#pragma unroll
            for (int ai = 0; ai < 2; ++ai)
#pragma unroll
                for (int m = 0; m < 4; ++m) { bf16_t* rowp = base + (size_t)(row0 + ai * HALF + m * 16) * DM;
#pragma unroll
                    for (int bj = 0; bj < 2; ++bj) { const f32x4 v0 = acc[ai][bj][m][0] * QSCALE, v1 = acc[ai][bj][m][1] * QSCALE;
                        v4u w; w.x = cvt_pk_bf16(v0[0], v0[1]); w.y = cvt_pk_bf16(v0[2], v0[3]); w.z = cvt_pk_bf16(v1[0], v1[1]); w.w = cvt_pk_bf16(v1[2], v1[3]);
                        *(v4u*)(rowp + bj * HALF) = w; } }
        } else {
            const int kvi = (seg == 1) ? 0 : (seg == 2) ? 1 : (seg == 4) ? 2 : 3;
            bf16_t* kvb = KV + (size_t)kvi * (KV_STRIDE / 2) + cseg;
            float* ob = out + (prompt ? O_PFK + (size_t)kvi * ((size_t)MP * WG) + (kvi >= 2 ? (size_t)MP * NHG : 0)
                                      : O_SFK + (size_t)kvi * ((size_t)MS * WG) + (kvi >= 2 ? (size_t)MS * NHG : 0)) + cseg;
#pragma unroll
            for (int ai = 0; ai < 2; ++ai)
#pragma unroll
                for (int m = 0; m < 4; ++m) { const int row = row0 + ai * HALF + m * 16; const int rs = row - MP;
                    const int kvrow = prompt ? row : MP + (rs >> 5) * TKS + PAST + (rs & 31);
                    const int orow = prompt ? row : rs;
                    bf16_t* rowp = kvb + (size_t)kvrow * WG; float* op = ob + (size_t)orow * WG;
#pragma unroll
                    for (int bj = 0; bj < 2; ++bj) { const f32x4 v0 = acc[ai][bj][m][0], v1 = acc[ai][bj][m][1];
                        v4u w; w.x = cvt_pk_bf16(v0[0], v0[1]); w.y = cvt_pk_bf16(v0[2], v0[3]); w.z = cvt_pk_bf16(v1[0], v1[1]); w.w = cvt_pk_bf16(v1[2], v1[3]);
                        *(v4u*)(rowp + bj * HALF) = w; if (!prompt) { *(f32x4*)(op + bj * HALF) = v0; *(f32x4*)(op + bj * HALF + 4) = v1; } } }
        }
    }
};
struct EpiX2 {
    static constexpr bool PERM = true;
    const float* rp; const float* rs; bf16_t* X2; float* ssq;
    __device__ __forceinline__ void operator()(const f32x4 (&acc)[2][2][4][2], const Unit& u, int wr, int wc, int fr, int fq) const {
        const int row0 = u.pm * BM + wr * 64 + fr, col0 = u.pn * BM + wc * 32 + 8 * fq;
        const bool prompt = u.pm < (MP / BM);
#pragma unroll
        for (int ai = 0; ai < 2; ++ai)
#pragma unroll
            for (int m = 0; m < 4; ++m) { const int row = row0 + ai * HALF + m * 16;
                const float* rr = (prompt ? rp + (size_t)row * DM : rs + (size_t)(row - MP) * DM) + col0; bf16_t* op = X2 + (size_t)row * DM + col0;
                f32x4 rv[2][2];
#pragma unroll
                for (int bj = 0; bj < 2; ++bj)
#pragma unroll
                    for (int n = 0; n < 2; ++n) rv[bj][n] = *(const f32x4*)(rr + bj * HALF + n * 4);
                float s = 0.f;
#pragma unroll
                for (int bj = 0; bj < 2; ++bj) { const f32x4 v0 = acc[ai][bj][m][0] + rv[bj][0], v1 = acc[ai][bj][m][1] + rv[bj][1];
                    s += (v0[0] * v0[0] + v0[1] * v0[1]) + (v0[2] * v0[2] + v0[3] * v0[3]) + (v1[0] * v1[0] + v1[1] * v1[1]) + (v1[2] * v1[2] + v1[3] * v1[3]);
                    v4u w; w.x = cvt_pk_bf16(v0[0], v0[1]); w.y = cvt_pk_bf16(v0[2], v0[3]); w.z = cvt_pk_bf16(v1[0], v1[1]); w.w = cvt_pk_bf16(v1[2], v1[3]);
                    *(v4u*)(op + bj * HALF) = w; }
                s += __shfl_xor(s, 16); s += __shfl_xor(s, 32);
                if (fq == 0) __hip_atomic_fetch_add(ssq + row, s, __ATOMIC_RELAXED, __HIP_MEMORY_SCOPE_AGENT); }
    }
};
struct EpiDown {
    static constexpr bool PERM = true;
    const bf16_t* X2; float* out; float* part;
    __device__ __forceinline__ void operator()(const f32x4 (&acc)[2][2][4][2], const Unit& u, int wr, int wc, int fr, int fq) const {
        const int row0 = u.pm * BM + wr * 64 + fr, col0 = u.pn * BM + wc * 32 + 8 * fq;
        if (u.ks >= 0) {
            float* pb = part + (size_t)u.ks * ((size_t)MS * DM);
#pragma unroll
            for (int ai = 0; ai < 2; ++ai)
#pragma unroll
                for (int m = 0; m < 4; ++m) { float* op = pb + (size_t)(row0 + ai * HALF + m * 16 - MP) * DM + col0;
#pragma unroll
                    for (int bj = 0; bj < 2; ++bj) { *(f32x4*)(op + bj * HALF) = acc[ai][bj][m][0]; *(f32x4*)(op + bj * HALF + 4) = acc[ai][bj][m][1]; } }
            return;
        }
#pragma unroll
        for (int ai = 0; ai < 2; ++ai)
#pragma unroll
            for (int m = 0; m < 4; ++m) { const size_t off = (size_t)(row0 + ai * HALF + m * 16) * DM + col0;
                v4u xv[2];
#pragma unroll
                for (int bj = 0; bj < 2; ++bj) xv[bj] = *(const v4u*)(X2 + off + bj * HALF);
#pragma unroll
                for (int bj = 0; bj < 2; ++bj) { const v4u x = xv[bj];
                    const f32x4 r0 = {__uint_as_float(x.x << 16), __uint_as_float(x.x & 0xffff0000u), __uint_as_float(x.y << 16), __uint_as_float(x.y & 0xffff0000u)};
                    const f32x4 r1 = {__uint_as_float(x.z << 16), __uint_as_float(x.z & 0xffff0000u), __uint_as_float(x.w << 16), __uint_as_float(x.w & 0xffff0000u)};
                    *(f32x4*)(out + off + bj * HALF) = acc[ai][bj][m][0] + r0; *(f32x4*)(out + off + bj * HALF + 4) = acc[ai][bj][m][1] + r1; } }
    }
};
struct EpiGlu {
    static constexpr bool PERM = true;
    bf16_t* ACT; const float* ssq;
    __device__ __forceinline__ void operator()(const f32x4 (&acc)[2][2][4][2], const Unit& u, int wr, int wc, int fr, int fq) const {
        const int row0 = u.pm * BM + wr * 64 + fr, col0 = u.pn * HALF + wc * 32 + 8 * fq;
#pragma unroll
        for (int ai = 0; ai < 2; ++ai)
#pragma unroll
            for (int m = 0; m < 4; ++m) { const int row = row0 + ai * HALF + m * 16; bf16_t* rowp = ACT + (size_t)row * DFF + col0; float r[8];
                const float rstd = rsqrtf(ssq[row] * (1.f / DM) + EPS);
#pragma unroll
                for (int n = 0; n < 2; ++n)
#pragma unroll
                    for (int j = 0; j < 4; ++j) { const float g = acc[ai][0][m][n][j] * rstd, up = acc[ai][1][m][n][j] * rstd;
                        r[n * 4 + j] = g * __builtin_amdgcn_rcpf(1.0f + __builtin_amdgcn_exp2f(-g * LOG2E)) * up; }
                v4u w; w.x = cvt_pk_bf16(r[0], r[1]); w.y = cvt_pk_bf16(r[2], r[3]); w.z = cvt_pk_bf16(r[4], r[5]); w.w = cvt_pk_bf16(r[6], r[7]);
                *(v4u*)rowp = w; }
    }
};
}

namespace att {
constexpr int SHM_V = 16384, SHM_K = 16384;
constexpr int OFF_V = 0, OFF_K = 2 * SHM_V, OFF_WS = 4 * 16384, OFF_U = OFF_WS + NWAVES * 256, OFF_SCAN = OFF_U + (2048 + 64) * 4, ATT_LDS = OFF_SCAN + 64;
static_assert(ATT_LDS <= RING_BYTES, "attention LDS");
#define KSWZ(row, colB) ((row) * 256 + ((colB) ^ (((row) & 7) << 4)))
#define SBAR() __builtin_amdgcn_sched_barrier(0)
__device__ __forceinline__ int slot32(int k) { return (k & 3) | (((k >> 2) & 3) << 3) | (((k >> 4) & 1) << 2); }
__device__ __forceinline__ int v_st(int k, int c) { const int kk = (k & ~0xC) | ((k & 4) << 1) | ((k & 8) >> 1); return ((kk >> 3) * 4 + (c >> 5)) * 512 + ((kk & 7) * 32 + (c & 31)) * 2; }
__device__ __forceinline__ int v_rd_base(int lane) { return ((lane & 3) << 3) | (((lane >> 2) & 3) << 6) | (((lane >> 4) & 1) << 5) | (((lane >> 5) & 1) << 8); }
constexpr int v_rd_off(int d0, int ks, int half) { return d0 * 512 + ks * 4096 + half * 2048; }
__device__ __forceinline__ int crow(int r, int hi) { return (r & 3) + 8 * (r >> 2) + 4 * hi; }
__device__ __forceinline__ float partner(float x, int hi) { auto rr = __builtin_amdgcn_permlane32_swap(__float_as_uint(x), __float_as_uint(x), false, false); return __uint_as_float(hi ? rr[0] : rr[1]); }

__device__ __forceinline__ void qkt(f32x16& p0, f32x16& p1, LAS const unsigned char* Kt, int r32, int hi, const bf16x8* qr) {
    p0 = f32x16{}; p1 = f32x16{};
    LAS const unsigned char* kb[4];
#pragma unroll
    for (int dd = 0; dd < 4; ++dd) kb[dd] = Kt + KSWZ(r32, (dd * 16 + hi * 8) * 2);
#pragma unroll
    for (int d0 = 0; d0 < 8; ++d0) { LAS const unsigned char* a = kb[d0 & 3] + (d0 >> 2) * 128;
        const bf16x8 b0 = *(LAS const bf16x8*)a;
        const bf16x8 b1 = *(LAS const bf16x8*)(a + 32 * 256);
        p0 = __builtin_amdgcn_mfma_f32_32x32x16_bf16(b0, qr[d0], p0, 0, 0, 0);
        p1 = __builtin_amdgcn_mfma_f32_32x32x16_bf16(b1, qr[d0], p1, 0, 0, 0); }
}
__device__ __forceinline__ void pv_tile(f32x16* o, int vb0, bf16x8 pa0, bf16x8 pa1, bf16x8 pa2, bf16x8 pa3) {
#define TRRD(dst, off) asm volatile("ds_read_b64_tr_b16 %0, %1 offset:%2" : "=&v"(dst) : "v"(vb0), "i"(off) : "memory")
#define PV_D0(d0) do { s16x4 l0, l1, l2, l3, h0, h1, h2, h3; constexpr int b_ = v_rd_off(d0, 0, 0); \
        TRRD(l0, b_); TRRD(h0, b_ + 2048); TRRD(l1, b_ + 4096); TRRD(h1, b_ + 6144); TRRD(l2, b_ + 8192); TRRD(h2, b_ + 10240); TRRD(l3, b_ + 12288); TRRD(h3, b_ + 14336); \
        asm volatile("s_waitcnt lgkmcnt(0)" ::: "memory"); SBAR(); \
        o[d0] = __builtin_amdgcn_mfma_f32_32x32x16_bf16(pa0, (bf16x8){l0[0], l0[1], l0[2], l0[3], h0[0], h0[1], h0[2], h0[3]}, o[d0], 0, 0, 0); \
        o[d0] = __builtin_amdgcn_mfma_f32_32x32x16_bf16(pa1, (bf16x8){l1[0], l1[1], l1[2], l1[3], h1[0], h1[1], h1[2], h1[3]}, o[d0], 0, 0, 0); \
        o[d0] = __builtin_amdgcn_mfma_f32_32x32x16_bf16(pa2, (bf16x8){l2[0], l2[1], l2[2], l2[3], h2[0], h2[1], h2[2], h2[3]}, o[d0], 0, 0, 0); \
        o[d0] = __builtin_amdgcn_mfma_f32_32x32x16_bf16(pa3, (bf16x8){l3[0], l3[1], l3[2], l3[3], h3[0], h3[1], h3[2], h3[3]}, o[d0], 0, 0, 0); } while (0)
    PV_D0(0); PV_D0(1); PV_D0(2); PV_D0(3);
#undef PV_D0
#undef TRRD
}
#define PK4(P, B_, OUT) do { unsigned a0 = cvt_pk_bf16(P[B_+0], P[B_+1]), a1 = cvt_pk_bf16(P[B_+2], P[B_+3]); \
        unsigned b0 = cvt_pk_bf16(P[B_+4], P[B_+5]), b1 = cvt_pk_bf16(P[B_+6], P[B_+7]); \
        auto r0 = __builtin_amdgcn_permlane32_swap(a0, b0, false, false); auto r1 = __builtin_amdgcn_permlane32_swap(a1, b1, false, false); \
        v4u w = {r0[0], r1[0], r0[1], r1[1]}; OUT = __builtin_bit_cast(bf16x8, w); } while (0)

template <class F> __device__ __forceinline__ void scan_u(LAS float* U, LAS float* scan, int n, F lf) {
    const int tid = threadIdx.x, lane = tid & 63, wid = tid >> 6, t0 = 4 * tid;
    float v0 = t0 < n ? lf(t0) : 0.f, v1 = t0 + 1 < n ? lf(t0 + 1) : 0.f, v2 = t0 + 2 < n ? lf(t0 + 2) : 0.f, v3 = t0 + 3 < n ? lf(t0 + 3) : 0.f;
    v1 += v0; v2 += v1; v3 += v2;
    float x = v3;
#pragma unroll
    for (int o = 1; o < 64; o <<= 1) { const float y = __shfl_up(x, o); if (lane >= o) x += y; }
    if (lane == 63) scan[wid] = x;
    __syncthreads();
    float pre = x - v3;
    for (int w = 0; w < wid; ++w) pre += scan[w];
    f32x4 r = {-(v0 + pre) * LOG2E, -(v1 + pre) * LOG2E, -(v2 + pre) * LOG2E, -(v3 + pre) * LOG2E};
    *(LAS f32x4*)(U + t0) = r;
    __syncthreads();
}

__device__ __forceinline__ int islot(int rho) { return (rho & 0x23) | (((rho >> 3) & 3) << 2) | (((rho >> 2) & 1) << 4); }
template <int MODE>
__device__ __forceinline__ void attn_unit(LAS unsigned char* lds, const bf16* Q, const bf16* K, const bf16* V, bf16* O, int P0, int Tk, int nact) {
    const int tid = threadIdx.x, wid = __builtin_amdgcn_readfirstlane(tid >> 6), lane = tid & 63, r32 = lane & 31, hi = lane >> 5;
    const bool active = wid < nact;
    const int nrows = 32 * nact;
    const int NT = (P0 + nrows + 63) >> 6;
    LAS unsigned char* V_lds = lds + OFF_V; LAS unsigned char* K_lds = lds + OFF_K;
    LAS float* wsf = (LAS float*)(lds + OFF_WS) + wid * 64; LAS float* li_l = wsf; LAS float* al_l = wsf + 32;
    LAS const float* U = (LAS const float*)(lds + OFF_U);
    int kkey[2], kcol[2], vkey[2], vcol[2];
#pragma unroll
    for (int i = 0; i < 2; ++i) {
        const int q = wid * 2 + i;
        { const int rho = q * 4 + (lane >> 4), cpos = lane & 15; kkey[i] = islot(rho); kcol[i] = (cpos ^ (rho & 7)) * 8; }
        { const int sub = q * 2 + (lane >> 5), kk = (sub >> 2) * 8 + ((lane & 31) >> 2), ks = (kk & ~0xC) | ((kk & 4) << 1) | ((kk & 8) >> 1); vkey[i] = islot(ks); vcol[i] = (sub & 3) * 32 + (lane & 3) * 8; }
    }
    const int vb0 = (int)(size_t)V_lds + v_rd_base(lane);
    const int qlo = P0 + wid * 32, tq = qlo + r32;
    bf16x8 qr[8];
    if (active) {
#pragma unroll
        for (int d0 = 0; d0 < 8; ++d0) qr[d0] = *(const bf16x8*)(Q + (size_t)(wid * 32 + r32) * DM + d0 * 16 + hi * 8);
    } else {
#pragma unroll
        for (int d0 = 0; d0 < 8; ++d0) qr[d0] = bf16x8{};
    }
#define TILE_OF(t) (NT - 1 - (t))
#define STAGE(j, bf) do { _Pragma("unroll") for (int _i = 0; _i < 2; ++_i) { \
        int kk_ = (j) * 64 + kkey[_i]; kk_ = kk_ < Tk ? kk_ : Tk - 1; int vk_ = (j) * 64 + vkey[_i]; vk_ = vk_ < Tk ? vk_ : Tk - 1; \
        __builtin_amdgcn_global_load_lds((const unsigned*)(K + (size_t)kk_ * WG + kcol[_i]), (LAS unsigned*)(K_lds + (bf) * SHM_K + (wid * 2 + _i) * 1024), 16, 0, 0); \
        __builtin_amdgcn_global_load_lds((const unsigned*)(V + (size_t)vk_ * WG + vcol[_i]), (LAS unsigned*)(V_lds + (bf) * SHM_V + (wid * 2 + _i) * 1024), 16, 0, 0); } } while (0)
    STAGE(TILE_OF(0), 0); VM_WAIT();
    __syncthreads();
    float m_reg = -1e30f, l_reg = 0.f, carry = 0.f;
    f32x16 o[4] = {};
    for (int t = 0; t < NT; ++t) {
        const int j = TILE_OF(t), kb = j * 64, bufo = (t & 1) * SHM_K;
        if (t + 1 < NT) STAGE(TILE_OF(t + 1), (t + 1) & 1);
        if (active && kb <= qlo + 31) {
            f32x16 p0, p1;
            qkt(p0, p1, K_lds + bufo, r32, hi, qr);
            bf16x8 pa0, pa1, pa2, pa3;
            const int dq = tq - kb - 16 * hi;
            const bool need_mask = kb + 63 >= qlo;
            if (MODE == 0) {
                LAS const f32x4* up0 = (LAS const f32x4*)(U + kb + 16 * hi); LAS const f32x4* up1 = (LAS const f32x4*)(U + kb + 32 + 16 * hi);
#pragma unroll
                for (int g = 0; g < 4; ++g) { const f32x4 a = up0[g], b = up1[g];
#pragma unroll
                    for (int jj = 0; jj < 4; ++jj) { p0[4 * g + jj] += a[jj]; p1[4 * g + jj] += b[jj]; } }
                if (need_mask) { const float NEG = -__builtin_inff();
#pragma unroll
                    for (int r = 0; r < 16; ++r) { if (r > dq) p0[r] = NEG; if (r + 32 > dq) p1[r] = NEG; } }
                float pmax = p0[0];
#pragma unroll
                for (int r = 1; r < 16; ++r) pmax = fmaxf(pmax, p0[r]);
#pragma unroll
                for (int r = 0; r < 16; ++r) pmax = fmaxf(pmax, p1[r]);
                pmax = fmaxf(pmax, partner(pmax, hi));
                const float mn = fmaxf(m_reg, pmax);
                const bool grew = __any(mn > m_reg);
                float ps = 0.f;
#pragma unroll
                for (int r = 0; r < 16; ++r) { p0[r] = __builtin_amdgcn_exp2f(p0[r] - mn); p1[r] = __builtin_amdgcn_exp2f(p1[r] - mn); ps += p0[r] + p1[r]; }
                ps += partner(ps, hi);
                if (grew) {
                    const float alpha = __builtin_amdgcn_exp2f(m_reg - mn);
                    l_reg = l_reg * alpha + ps;
                    if (hi == 0) al_l[r32] = alpha;
                    LDS_WAIT();
#pragma unroll
                    for (int g = 0; g < 4; ++g) { const f32x4 a = *(LAS const f32x4*)(al_l + 8 * g + 4 * hi);
#pragma unroll
                        for (int jj = 0; jj < 4; ++jj)
#pragma unroll
                            for (int d_ = 0; d_ < 4; ++d_) o[d_][4 * g + jj] *= a[jj]; }
                } else l_reg += ps;
                m_reg = mn;
            } else {
                f32x16 l1;
#pragma unroll
                for (int r = 0; r < 16; ++r) l1[r] = -(fmaxf(p1[r], 0.f) + __builtin_amdgcn_logf(1.0f + __builtin_amdgcn_exp2f(-fabsf(p1[r]))));
                if (need_mask) {
#pragma unroll
                    for (int r = 0; r < 16; ++r) if (r + 32 >= dq) l1[r] = 0.f; }
#pragma unroll
                for (int r = 14; r >= 0; --r) l1[r] += l1[r + 1];
                const float T1 = l1[0], oT1 = partner(T1, hi);
                const float off1 = carry + (hi ? 0.f : oT1);
#pragma unroll
                for (int r = 0; r < 16; ++r) p1[r] = __builtin_amdgcn_exp2f(p1[r] + l1[r] + off1);
                if (need_mask) {
#pragma unroll
                    for (int r = 0; r < 16; ++r) if (r + 32 >= dq) p1[r] = 0.f; }
                f32x16 l0;
#pragma unroll
                for (int r = 0; r < 16; ++r) l0[r] = -(fmaxf(p0[r], 0.f) + __builtin_amdgcn_logf(1.0f + __builtin_amdgcn_exp2f(-fabsf(p0[r]))));
                if (need_mask) {
#pragma unroll
                    for (int r = 0; r < 16; ++r) if (r >= dq) l0[r] = 0.f; }
#pragma unroll
                for (int r = 14; r >= 0; --r) l0[r] += l0[r + 1];
                const float T0 = l0[0], oT0 = partner(T0, hi);
                const float off0 = carry + T1 + oT1 + (hi ? 0.f : oT0);
                carry += (T0 + oT0) + (T1 + oT1);
#pragma unroll
                for (int r = 0; r < 16; ++r) p0[r] = __builtin_amdgcn_exp2f(p0[r] + l0[r] + off0);
                if (need_mask) {
#pragma unroll
                    for (int r = 0; r < 16; ++r) if (r >= dq) p0[r] = 0.f; }
            }
            PK4(p0, 0, pa0); PK4(p0, 8, pa1); PK4(p1, 0, pa2); PK4(p1, 8, pa3);
            pv_tile(o, vb0 + bufo, pa0, pa1, pa2, pa3);
        }
        VM_WAIT();
        __syncthreads();
    }
    if (active) {
        if (MODE == 0) {
            if (hi == 0) li_l[r32] = 1.0f / l_reg;
            LDS_WAIT();
#pragma unroll
            for (int g = 0; g < 4; ++g) { const f32x4 a = *(LAS const f32x4*)(li_l + 8 * g + 4 * hi);
#pragma unroll
                for (int jj = 0; jj < 4; ++jj)
#pragma unroll
                    for (int d_ = 0; d_ < 4; ++d_) o[d_][4 * g + jj] *= a[jj]; }
        }
        bf16* Ow = O + (size_t)(wid * 32) * DM;
#pragma unroll
        for (int r = 0; r < 16; ++r) { const int orow = crow(r, hi);
#pragma unroll
            for (int d0 = 0; d0 < 4; ++d0) { const float v = o[d0][r]; const float vn = __shfl_xor(v, 1);
                if ((r32 & 1) == 0) *(unsigned*)(Ow + (size_t)orow * DM + d0 * 32 + r32) = cvt_pk_bf16(v, vn); } }
    }
    __syncthreads();
#undef TILE_OF
#undef STAGE
}
#undef PK4
}

#define XB_TMO      128
#define XB_XCNT(j)  (256  + 64 * (j))
#define XB_XSUB(j)  (1280 + 64 * (j))
#define XB_XGEN(j)  (2304 + 64 * (j))
#define XB_TOP      3328
#define XB_TOPGEN   3392
#define XCD_BAR_WORDS 3456
#define XB_SPIN_CAP (1u << 18)
__device__ __forceinline__ unsigned xb_ld(unsigned* p)              { return __hip_atomic_load(p, __ATOMIC_RELAXED, __HIP_MEMORY_SCOPE_AGENT); }
__device__ __forceinline__ unsigned xb_add(unsigned* p, unsigned v) { return __hip_atomic_fetch_add(p, v, __ATOMIC_RELAXED, __HIP_MEMORY_SCOPE_AGENT); }
__device__ __forceinline__ unsigned xb_xcc_id() { return (unsigned)__builtin_amdgcn_s_getreg((3 << 11) | 20) & 0xFu; }
#define XB_SPIN(cond, bar) do { unsigned _sp = 0; while (cond) { __builtin_amdgcn_s_sleep(1); \
    if ((++_sp & 255u) == 0u) { if (xb_ld(&(bar)[XB_TMO])) break; if (_sp > XB_SPIN_CAP) { atomicAdd(&(bar)[XB_TMO], 1u); break; } } } } while (0)
struct XcdBarrier { unsigned* bar; unsigned x; volatile LAS unsigned* st; };
__device__ __forceinline__ XcdBarrier xcd_barrier_post(unsigned* bar, volatile LAS unsigned* st) {
    XcdBarrier b; b.bar = bar; b.x = xb_xcc_id(); b.st = st;
    if (threadIdx.x == 0) (void)xb_add(&bar[XB_XCNT(b.x)], 1u);
    return b;
}
__device__ __forceinline__ void xcd_barrier_complete(unsigned* bar, unsigned x, unsigned& nloc, unsigned& nx) {
    const unsigned G = gridDim.x * gridDim.y * gridDim.z;
    unsigned sum, cnt, mine, sp = 0u;
    for (;;) {
        sum = 0u; cnt = 0u; mine = 0u;
#pragma unroll
        for (unsigned j = 0; j < 16; ++j) { const unsigned c = xb_ld(&bar[XB_XCNT(j)]); sum += c; cnt += (c > 0u) ? 1u : 0u; mine = (j == x) ? c : mine; }
        if (sum == G) break;
        __builtin_amdgcn_s_sleep(1);
        if ((++sp & 255u) == 0u) { if (xb_ld(&bar[XB_TMO])) break; if (sp > XB_SPIN_CAP) { atomicAdd(&bar[XB_TMO], 1u); break; } }
    }
    nloc = mine > 0u ? mine : 1u; nx = cnt > 0u ? cnt : 1u;
}
__device__ __forceinline__ void xcd_barrier(const XcdBarrier& b) {
    asm volatile("s_waitcnt vmcnt(0)" ::: "memory");
    __syncthreads();
    if (threadIdx.x == 0) {
        unsigned* bar = b.bar;
        __builtin_amdgcn_s_waitcnt(0);
        unsigned nloc = b.st[0], nx = b.st[1];
        if (nloc == 0u) { xcd_barrier_complete(bar, b.x, nloc, nx); b.st[0] = nloc; b.st[1] = nx; }
        const unsigned old = xb_add(&bar[XB_XSUB(b.x)], 1u);
        const unsigned gen = old / nloc;
        if (old + 1u == (gen + 1u) * nloc) {
            __builtin_amdgcn_fence(__ATOMIC_RELEASE, "agent");
            asm volatile("s_waitcnt vmcnt(0)" ::: "memory");
            const unsigned og = xb_add(&bar[XB_TOP], 1u);
            const unsigned tg = og / nx;
            if (og + 1u == (tg + 1u) * nx) xb_add(&bar[XB_TOPGEN], 1u);
            else XB_SPIN(xb_ld(&bar[XB_TOPGEN]) == tg, bar);
            __builtin_amdgcn_fence(__ATOMIC_ACQUIRE, "agent");
            xb_add(&bar[XB_XGEN(b.x)], 1u);
            asm volatile("s_waitcnt vmcnt(0)" ::: "memory");
        } else {
            XB_SPIN(xb_ld(&bar[XB_XGEN(b.x)]) == gen, bar);
            __builtin_amdgcn_fence(__ATOMIC_ACQUIRE, "agent");
            asm volatile("s_waitcnt vmcnt(0)" ::: "memory");
        }
    }
    __syncthreads();
}

struct Args { const float* in[18]; float* out; unsigned char* ws; int ph_lo, ph_hi; };

__device__ __forceinline__ float wave_sum(float v) {
#pragma unroll
    for (int o = 1; o < 64; o <<= 1) v += __shfl_xor(v, o);
    return v;
}
__device__ __forceinline__ void tr_load(f32x4 (&r)[8], const float* W, int ldw, int k0, int n0, int lane) {
    const float* p = W + (size_t)(k0 + (lane >> 3)) * ldw + n0 + 4 * (lane & 7);
#pragma unroll
    for (int j = 0; j < 8; ++j) r[j] = *(const f32x4*)(p + (size_t)(8 * j) * ldw);
}
__device__ __forceinline__ void tr_proc(const f32x4 (&r)[8], const float* ksc, int K, int k0, int ncols, bf16* WT, int drow0, LAS float* scr, int lane) {
    const int c = 4 * (lane & 7);
#pragma unroll
    for (int j = 0; j < 8; ++j) { const int kk = 8 * j + (lane >> 3); const float sc = ksc ? ksc[k0 + kk] : 1.f; LAS float* d = scr + kk * 33 + c;
        d[0] = r[j].x * sc; d[1] = r[j].y * sc; d[2] = r[j].z * sc; d[3] = r[j].w * sc; }
    LDS_WAIT(); asm volatile("" ::: "memory");
    const int c8 = lane & 7;
#pragma unroll
    for (int j = 0; j < 4; ++j) { const int n = (lane >> 3) + 8 * j; const LAS float* s = scr + (8 * c8) * 33 + n;
        v4u o; o.x = cvt_pk_bf16(s[0 * 33], s[1 * 33]); o.y = cvt_pk_bf16(s[2 * 33], s[3 * 33]); o.z = cvt_pk_bf16(s[4 * 33], s[5 * 33]); o.w = cvt_pk_bf16(s[6 * 33], s[7 * 33]);
        if (n < ncols) *(GAS v4u*)(WT + (size_t)(drow0 + n) * K + k0 + 8 * c8) = o; }
    LDS_WAIT(); asm volatile("" ::: "memory");
}
__device__ __forceinline__ void rms_row_bf16(const float* xrow, const float* g, bf16* orow, int lane) {
    const f32x4* xr = (const f32x4*)xrow + lane; const f32x4* gr = (const f32x4*)g + lane;
    f32x4 v[16]; float s = 0.f;
#pragma unroll
    for (int j = 0; j < 16; ++j) { v[j] = xr[64 * j]; s += (v[j].x * v[j].x + v[j].y * v[j].y) + (v[j].z * v[j].z + v[j].w * v[j].w); }
    const float rstd = rsqrtf(wave_sum(s) * (1.f / DM) + EPS);
    v2u* o8 = (v2u*)orow + lane;
#pragma unroll
    for (int j = 0; j < 16; ++j) { const f32x4 gg = gr[64 * j]; v2u w; w.x = cvt_pk_bf16(v[j].x * rstd * gg.x, v[j].y * rstd * gg.y); w.y = cvt_pk_bf16(v[j].z * rstd * gg.z, v[j].w * rstd * gg.w); o8[64 * j] = w; }
}
__device__ __forceinline__ float bf_lo(unsigned w) { return __uint_as_float(w << 16); }
__device__ __forceinline__ float bf_hi(unsigned w) { return __uint_as_float(w & 0xffff0000u); }

__global__ void __launch_bounds__(NWAVES * 64, 2) fwd_kernel(Args args) {
    extern __shared__ __attribute__((aligned(16))) unsigned char lds_raw[];
    LAS unsigned char* lds = (LAS unsigned char*)lds_raw;
    volatile LAS unsigned* MISC = (volatile LAS unsigned*)(lds + MISC_OFF);
    const int tid = threadIdx.x, lane = tid & 63, wave = __builtin_amdgcn_readfirstlane(tid >> 6);
    const int G = gridDim.x; const int bx = blockIdx.x; const int vcu = (G % 8 == 0) ? (bx % 8) * (G / 8) + bx / 8 : bx;
    unsigned char* ws = args.ws; float* out = args.out;
    gu32* ctl = (gu32*)(ws + WS_CTL);
    const float* x_prompt = args.in[0]; const float* x_sample = args.in[1];
    const float* cache_fk = args.in[2]; const float* cache_fv = args.in[3]; const float* cache_fl = args.in[4]; const float* cache_sk = args.in[5]; const float* cache_sv = args.in[6];
    const float* g_attn = args.in[7]; const float* w_in = args.in[8]; const float* b_forget = args.in[9]; const float* g_of = args.in[10]; const float* g_os = args.in[11];
    const float* w_out = args.in[12]; const float* g_ffn = args.in[13]; const float* w_gate = args.in[14]; const float* w_up = args.in[15]; const float* w_down = args.in[16]; const float* g_final = args.in[17];
    bf16* Win_t = (bf16*)(ws + WS_WIN); bf16* Wout_t = (bf16*)(ws + WS_WOUT); bf16* Wgu_t = (bf16*)(ws + WS_WGU); bf16* Wdn_t = (bf16*)(ws + WS_WDN);
    bf16* XN = (bf16*)(ws + WS_XN); bf16* QO = (bf16*)(ws + WS_QO); bf16* KVB = (bf16*)(ws + WS_KV); bf16* ACT = (bf16*)(ws + WS_ACT); float* PART = (float*)(ws + WS_PART);

    for (int u = tid; u < (LDS_BYTES - LDSCTL_OFF) / 4; u += NWAVES * 64) ((LAS unsigned*)(lds + LDSCTL_OFF))[u] = 0u;
    __syncthreads();
    XcdBarrier bar; bar.bar = (unsigned*)(ctl + CW_BAR); bar.x = 0; bar.st = nullptr;
    if (MK_N_LAUNCHES == 1) bar = xcd_barrier_post((unsigned*)(ctl + CW_BAR), MISC + 8);
    const int lo = args.ph_lo, hi_ph = args.ph_hi;
#ifndef PH_MASK
#define PH_MASK 0x1ff
#endif
#define IN(k) (((PH_MASK >> (k)) & 1) && lo <= (k) && (k) < hi_ph)
#define BOTH(k) (IN(k) && IN((k) + 1))
#define GRID_BAR() do { if (MK_N_LAUNCHES == 1) xcd_barrier(bar); } while (0)
    const int gw = vcu * NWAVES + wave, NGW = G * NWAVES;

    if (IN(0)) {
        LAS float* scr = (LAS float*)(lds + RING_OFF + wave * 16384);
        constexpr int KB4 = DM / 64;
        constexpr int I_INA = KB4 * (3 * WG / 32), I_INB = I_INA, I_FL = KB4, I_OUT = KB4 * (DM / 32), I_G = KB4 * (DFF / 32), I_U = I_G, I_D = (DFF / 64) * (DM / 32);
        constexpr int NITEMS = I_INA + I_INB + I_FL + I_OUT + I_G + I_U + I_D;
#define TR_DECODE(it_, W_, ksc_, WT_, ldw_, K_, k0_, n0_, nc_, dr_) do { int r_ = (it_); ksc_ = nullptr; nc_ = 32; ldw_ = DIN; K_ = DM; W_ = w_in; WT_ = Win_t; \
            if (r_ < I_INA) { const int kb = r_ / 192, nb = r_ % 192; k0_ = 64 * kb; n0_ = 32 * nb; dr_ = 32 * nb; } \
            else if ((r_ -= I_INA) < I_INB) { const int kb = r_ / 192, nb = r_ % 192; k0_ = 64 * kb; n0_ = 3 * WG + NHG + 32 * nb; dr_ = 3 * WG + 32 * nb; } \
            else if ((r_ -= I_INB) < I_FL) { k0_ = 64 * r_; n0_ = 3 * WG; nc_ = 16; dr_ = 6 * WG; } \
            else if ((r_ -= I_FL) < I_OUT) { const int kb = r_ / 128, nb = r_ % 128; W_ = w_out; ldw_ = DM; WT_ = Wout_t; k0_ = 64 * kb; n0_ = 32 * nb; dr_ = 32 * nb; } \
            else if ((r_ -= I_OUT) < I_G) { const int kb = r_ / 344, nb = r_ % 344; W_ = w_gate; ldw_ = DFF; WT_ = Wgu_t; ksc_ = g_ffn; k0_ = 64 * kb; n0_ = 32 * nb; dr_ = (n0_ >> 7) * 256 + (n0_ & 127); } \
            else if ((r_ -= I_G) < I_U) { const int kb = r_ / 344, nb = r_ % 344; W_ = w_up; ldw_ = DFF; WT_ = Wgu_t; ksc_ = g_ffn; k0_ = 64 * kb; n0_ = 32 * nb; dr_ = (n0_ >> 7) * 256 + 128 + (n0_ & 127); } \
            else { r_ -= I_U; const int kb = r_ / 128, nb = r_ % 128; W_ = w_down; ldw_ = DM; K_ = DFF; WT_ = Wdn_t; k0_ = 64 * kb; n0_ = 32 * nb; dr_ = 32 * nb; } } while (0)
        if (gw < NITEMS) {
            const float* W; const float* ksc; bf16* WT; int ldw, K, k0, n0, nc, dr;
            f32x4 ra[8], rb[8];
            int it = gw;
            TR_DECODE(it, W, ksc, WT, ldw, K, k0, n0, nc, dr);
            tr_load(ra, W, ldw, k0, n0, lane);
            for (;;) {
                const int itn = it + NGW; const bool more = itn < NITEMS;
                const float* W2 = W; const float* ksc2 = ksc; bf16* WT2 = WT; int ldw2 = ldw, K2 = K, k02 = k0, n02 = n0, nc2 = nc, dr2 = dr;
                if (more) { TR_DECODE(itn, W2, ksc2, WT2, ldw2, K2, k02, n02, nc2, dr2); tr_load(rb, W2, ldw2, k02, n02, lane); }
                tr_proc(ra, ksc, K, k0, nc, WT, dr, scr, lane);
                if (!more) break;
#pragma unroll
                for (int j = 0; j < 8; ++j) ra[j] = rb[j];
                W = W2; ksc = ksc2; WT = WT2; ldw = ldw2; K = K2; k0 = k02; n0 = n02; nc = nc2; dr = dr2; it = itn;
            }
        }
#undef TR_DECODE
        for (int i = gw * 64 + lane; i < 240 * DM / 8; i += NGW * 64) *(v4u*)(Win_t + (size_t)(6 * WG + 16) * DM + (size_t)i * 8) = (v4u){0u, 0u, 0u, 0u};
        for (int m = gw; m < MT; m += NGW) rms_row_bf16(m < MP ? x_prompt + (size_t)m * DM : x_sample + (size_t)(m - MP) * DM, g_attn, XN + (size_t)m * DM, lane);
        for (int it = gw; it < 4 * DB * PAST; it += NGW) { const int kvi = it / (DB * PAST), rr = it % (DB * PAST), b = rr / PAST, t = rr % PAST;
            const float* src = (kvi == 0 ? cache_fk : kvi == 1 ? cache_fv : kvi == 2 ? cache_sk : cache_sv) + (size_t)rr * WG;
            bf16* dst = KVB + (size_t)kvi * (KV_STRIDE / 2) + (size_t)(MP + b * TKS + t) * WG;
#pragma unroll
            for (int j = 0; j < 8; ++j) { const f32x4 v = ((const f32x4*)src)[lane + 64 * j]; v2u w; w.x = cvt_pk_bf16(v.x, v.y); w.y = cvt_pk_bf16(v.z, v.w); ((v2u*)dst)[lane + 64 * j] = w; } }
        if (BOTH(0)) GRID_BAR();
    }

    if (IN(1)) {
        pg8::Gemm g{XN, Win_t, MT, NIN, DM}; pg8::StaticOrder S; S.init(MT, NIN, DM, G, bx);
        pg8::EpiIn E{QO, KVB, out, b_forget};
        pg8::gemm_phase<pg8::EpiIn, pg8::StaticOrder, true, true>(lds + RING_OFF, g, S, E);
        if (BOTH(1)) GRID_BAR();
    }

    if (IN(2)) {
        LAS float* U = (LAS float*)(lds + att::OFF_U); LAS float* scn = (LAS float*)(lds + att::OFF_SCAN);
        constexpr int N_ITEMS = 512 + 512 + 256 + 256;
        for (int it = vcu; it < N_ITEMS; it += G) {
            if (it < 1024) {
                const int mode = it >> 9, r = it & 511, bh = r >> 2, pi = r & 3, b = bh >> 4, h = bh & 15;
                const bf16* Kp = KVB + (size_t)(mode * 2) * (KV_STRIDE / 2) + (size_t)(b * SEQ) * WG + h * HD;
                const bf16* Vp = Kp + (KV_STRIDE / 2);
                bf16* Qp = QO + (size_t)(b * SEQ) * DM + mode * WG + h * HD;
                if (mode == 0) {
                    const float* lf = out + O_PFL + (size_t)(b * SEQ) * NHG + h;
                    att::scan_u(U, scn, SEQ, [&](int t) { return lf[(size_t)t * NHG]; });
                }
#pragma unroll 1
                for (int pass = 0; pass < 2; ++pass) { const int qb = pass ? 7 - pi : pi; bf16* Qb = Qp + (size_t)(qb * 256) * DM;
#ifndef NO_FOX
                    if (mode == 0) att::attn_unit<0>(lds + RING_OFF, Qb, Kp, Vp, Qb, qb * 256, SEQ, 8);
#endif
#ifndef NO_SB
                    if (mode == 1) att::attn_unit<1>(lds + RING_OFF, Qb, Kp, Vp, Qb, qb * 256, SEQ, 8);
#endif
 }
            } else {
                const int r = it - 1024, mode = r >> 8, bh = r & 255, b = bh >> 4, h = bh & 15;
                const bf16* Kp = KVB + (size_t)(mode * 2) * (KV_STRIDE / 2) + (size_t)(MP + b * TKS) * WG + h * HD;
                const bf16* Vp = Kp + (KV_STRIDE / 2);
                bf16* Qb = QO + (size_t)(MP + b * DS) * DM + mode * WG + h * HD;
                if (mode == 0) {
                    const float* lfc = cache_fl + (size_t)(b * PAST) * NHG + h; const float* lfn = out + O_SFL + (size_t)(b * DS) * NHG + h;
                    att::scan_u(U, scn, TKS, [&](int t) { return t < PAST ? lfc[(size_t)t * NHG] : lfn[(size_t)(t - PAST) * NHG]; });
#ifndef NO_FOX
                    att::attn_unit<0>(lds + RING_OFF, Qb, Kp, Vp, Qb, PAST, TKS, 1);
#endif
                } else {
#ifndef NO_SB
                    att::attn_unit<1>(lds + RING_OFF, Qb, Kp, Vp, Qb, PAST, TKS, 1);
#endif
                }
            }
        }
        if (BOTH(2)) GRID_BAR();
    }

    if (IN(3)) {
        for (int m = gw; m < MT; m += NGW) { v4u* row = (v4u*)(QO + (size_t)m * DM) + lane;
            v4u v[8]; float sf = 0.f, ss = 0.f;
#pragma unroll
            for (int j = 0; j < 8; ++j) { v[j] = row[64 * j]; float s = 0.f;
#pragma unroll
                for (int e = 0; e < 4; ++e) { const float a = bf_lo(v[j][e]), b = bf_hi(v[j][e]); s += a * a + b * b; }
                if (j < 4) sf += s; else ss += s; }
            const float rf = rsqrtf(wave_sum(sf) * (1.f / WG) + EPS), rs = rsqrtf(wave_sum(ss) * (1.f / WG) + EPS);
#pragma unroll
            for (int j = 0; j < 8; ++j) { const float rr = j < 4 ? rf : rs; const float* gp = (j < 4 ? g_of : g_os) + (lane + 64 * (j & 3)) * 8;
                const f32x4 g0 = *(const f32x4*)gp, g1 = *(const f32x4*)(gp + 4); v4u w;
                w.x = cvt_pk_bf16(bf_lo(v[j].x) * rr * g0.x, bf_hi(v[j].x) * rr * g0.y); w.y = cvt_pk_bf16(bf_lo(v[j].y) * rr * g0.z, bf_hi(v[j].y) * rr * g0.w);
                w.z = cvt_pk_bf16(bf_lo(v[j].z) * rr * g1.x, bf_hi(v[j].z) * rr * g1.y); w.w = cvt_pk_bf16(bf_lo(v[j].w) * rr * g1.z, bf_hi(v[j].w) * rr * g1.w);
                row[64 * j] = w; } }
        { constexpr size_t CH_PER = (size_t)MP * WG / 8, NCH = 4 * CH_PER;
          for (size_t g0 = (size_t)gw * 256 + lane; g0 < NCH; g0 += (size_t)NGW * 256) { const int kvi = (int)(g0 / CH_PER); const size_t rem = g0 % CH_PER;
              const bf16* sp = KVB + (size_t)kvi * (KV_STRIDE / 2) + rem * 8;
              float* dst = out + O_PFK + (size_t)kvi * ((size_t)MP * WG) + (kvi >= 2 ? (size_t)MP * NHG : 0) + rem * 8;
              v4u x[4];
#pragma unroll
              for (int e = 0; e < 4; ++e) x[e] = *(const v4u*)(sp + (size_t)e * 512);
#pragma unroll
              for (int e = 0; e < 4; ++e) { *(f32x4*)(dst + (size_t)e * 512) = (f32x4){bf_lo(x[e].x), bf_hi(x[e].x), bf_lo(x[e].y), bf_hi(x[e].y)};
                  *(f32x4*)(dst + (size_t)e * 512 + 4) = (f32x4){bf_lo(x[e].z), bf_hi(x[e].z), bf_lo(x[e].w), bf_hi(x[e].w)}; } } }
        if (BOTH(3)) GRID_BAR();
    }

    float* SSQ = (float*)(ctl + CW_SSQ);
    if (IN(4)) {
        pg8::Gemm g{QO, Wout_t, MT, DM, DM}; pg8::StaticOrder S; S.init(MT, DM, DM, G, bx);
        pg8::EpiX2 E{x_prompt, x_sample, XN, SSQ};
        pg8::gemm_phase<pg8::EpiX2, pg8::StaticOrder, true, true>(lds + RING_OFF, g, S, E);
        if (BOTH(4)) GRID_BAR();
    }

    if (IN(6)) {
#ifndef PROBE_REP6
#define PROBE_REP6 1
#endif
#pragma unroll 1
        for (int rep = 0; rep < PROBE_REP6; ++rep) {
        pg8::Gemm g{XN, Wgu_t, MT, 2 * DFF, DM}; pg8::StaticOrder S; S.init(MT, 2 * DFF, DM, G, bx);
        pg8::EpiGlu E{ACT, SSQ};
        pg8::gemm_phase<pg8::EpiGlu, pg8::StaticOrder, true, true>(lds + RING_OFF, g, S, E);
        if (BOTH(6)) GRID_BAR();
        }
    }

    if (IN(7)) {
        pg8::Gemm g{ACT, Wdn_t, MT, DM, DFF}; pg8::DownOrder S; S.init(MP, DM, DFF, G, bx);
        pg8::EpiDown E{XN, out, PART};
        pg8::gemm_phase<pg8::EpiDown, pg8::DownOrder, true, true>(lds + RING_OFF, g, S, E);
        if (BOTH(7)) GRID_BAR();
    }

    if (IN(8)) {
        for (int m = gw; m < MT; m += NGW) { f32x4* xr = (f32x4*)(out + (size_t)m * DM) + lane; const f32x4* gr = (const f32x4*)g_final + lane;
            f32x4 v[16]; float s = 0.f;
            if (m >= MP && G == 256) {
                const v2u* x2r = (const v2u*)(XN + (size_t)m * DM) + lane;
#pragma unroll
                for (int j = 0; j < 16; ++j) { const v2u x = x2r[64 * j]; v[j] = (f32x4){bf_lo(x.x), bf_hi(x.x), bf_lo(x.y), bf_hi(x.y)}; }
#pragma unroll 1
                for (int ks = 0; ks < 8; ++ks) { const f32x4* pr = (const f32x4*)(PART + (size_t)ks * ((size_t)MS * DM) + (size_t)(m - MP) * DM) + lane;
#pragma unroll
                    for (int j = 0; j < 16; ++j) v[j] += pr[64 * j]; }
            } else {
#pragma unroll
                for (int j = 0; j < 16; ++j) v[j] = xr[64 * j];
            }
#pragma unroll
            for (int j = 0; j < 16; ++j) s += (v[j].x * v[j].x + v[j].y * v[j].y) + (v[j].z * v[j].z + v[j].w * v[j].w);
            const float rstd = rsqrtf(wave_sum(s) * (1.f / DM) + EPS);
#pragma unroll
            for (int j = 0; j < 16; ++j) { const f32x4 gg = gr[64 * j]; xr[64 * j] = v[j] * rstd * gg; } }
    }
#undef IN
#undef BOTH
#undef GRID_BAR
}

extern "C" void kernel_launch(void* const* d_in, const int* in_sizes, int n_in, void* d_out, int out_size, void* d_ws, size_t ws_size, hipStream_t stream) {
    static int grid = 0;
    if (grid == 0) {
        if (n_in != 18 || (size_t)out_size != O_END || ws_size < WS_END) { fprintf(stderr, "kernel_launch: unexpected shapes (n_in %d, out %d, ws %zu)\n", n_in, out_size, ws_size); grid = -1; return; }
        int dev = 0, cus = 0;
        if (hipGetDevice(&dev) != hipSuccess || hipDeviceGetAttribute(&cus, hipDeviceAttributeMultiprocessorCount, dev) != hipSuccess) { grid = -1; return; }
        if (hipFuncSetAttribute((const void*)fwd_kernel, hipFuncAttributeMaxDynamicSharedMemorySize, LDS_BYTES) != hipSuccess) { fprintf(stderr, "kernel_launch: hipFuncSetAttribute failed\n"); grid = -1; return; }
        int per_cu = 0;
        if (hipOccupancyMaxActiveBlocksPerMultiprocessor(&per_cu, (const void*)fwd_kernel, NWAVES * 64, LDS_BYTES) != hipSuccess || per_cu < 1) fprintf(stderr, "kernel_launch: occupancy query says %d\n", per_cu);
        (void)hipGetLastError();
        grid = cus;
    }
    if (grid < 0) return;
    (void)hipMemsetAsync((char*)d_ws + WS_CTL, 0, CTL_ZERO_BYTES, stream);
    Args a{};
    for (int i = 0; i < 18; ++i) a.in[i] = (const float*)d_in[i];
    a.out = (float*)d_out; a.ws = (unsigned char*)d_ws;
#if MK_N_LAUNCHES == 1
    a.ph_lo = 0; a.ph_hi = 9;
    hipLaunchKernelGGL(fwd_kernel, dim3(grid), dim3(NWAVES * 64), LDS_BYTES, stream, a);
#else
    for (int p = 0; p < 9; ++p) { a.ph_lo = p; a.ph_hi = p + 1; hipLaunchKernelGGL(fwd_kernel, dim3(grid), dim3(NWAVES * 64), LDS_BYTES, stream, a); }
#endif
}
```

```cpp
#include <hip/hip_runtime.h>
#include <cstdio>
#include <cstdint>

#ifndef MK_N_LAUNCHES
#define MK_N_LAUNCHES 1
#endif

#define GAS __attribute__((address_space(1)))
#define LAS __attribute__((address_space(3)))
typedef unsigned short bf16;
typedef unsigned v4u __attribute__((ext_vector_type(4)));
typedef unsigned v2u __attribute__((ext_vector_type(2)));
typedef float f32x4 __attribute__((ext_vector_type(4)));
typedef float f32x16 __attribute__((ext_vector_type(16)));
typedef short bf16x8 __attribute__((ext_vector_type(8)));
typedef short s16x4 __attribute__((ext_vector_type(4)));
typedef GAS unsigned gu32;

constexpr int DM = 4096, NB = 8, SEQ = 2048, DB = 16, DS = 32, PAST = 1024, HD = 128, NHG = 16;
constexpr int WG = NHG * HD;
constexpr int DFF = 11008;
constexpr int MP = NB * SEQ, MS = DB * DS, MT = MP + MS;
constexpr int DIN = 3 * WG + NHG + 3 * WG;
constexpr int NIN = 6 * WG + 256;
constexpr int TKS = PAST + DS;
constexpr int KVROWS = MP + DB * TKS;
constexpr float EPS = 1e-6f;
constexpr float LOG2E = 1.4426950408889634f;
constexpr float QSCALE = 0.08838834764831845f * LOG2E;

constexpr size_t O_YP = 0, O_YS = O_YP + (size_t)MP * DM;
constexpr size_t O_PFK = O_YS + (size_t)MS * DM, O_PFV = O_PFK + (size_t)MP * WG, O_PFL = O_PFV + (size_t)MP * WG;
constexpr size_t O_PSK = O_PFL + (size_t)MP * NHG, O_PSV = O_PSK + (size_t)MP * WG;
constexpr size_t O_SFK = O_PSV + (size_t)MP * WG, O_SFV = O_SFK + (size_t)MS * WG, O_SFL = O_SFV + (size_t)MS * WG;
constexpr size_t O_SSK = O_SFL + (size_t)MS * NHG, O_SSV = O_SSK + (size_t)MS * WG, O_END = O_SSV + (size_t)MS * WG;

constexpr size_t MiB = 1u << 20;
constexpr size_t WS_CTL = 0, CTL_ZERO_BYTES = 1 * MiB;
constexpr size_t WS_WIN = 2 * MiB;
constexpr size_t WS_WOUT = 100 * MiB;
constexpr size_t WS_WGU = 132 * MiB;
constexpr size_t WS_WDN = 304 * MiB;
constexpr size_t WS_XN = 390 * MiB;
constexpr size_t WS_QO = 522 * MiB;
constexpr size_t WS_KV = 654 * MiB, KV_STRIDE = 130 * MiB;
constexpr size_t WS_ACT = 654 * MiB;
constexpr size_t WS_PART = 1174 * MiB;
constexpr size_t WS_END = 1238 * MiB;
static_assert((size_t)NIN * DM * 2 == 98 * MiB && (size_t)2 * DFF * DM * 2 == 172 * MiB && (size_t)DM * DFF * 2 == 86 * MiB && (size_t)MT * DM * 2 == 132 * MiB && (size_t)KVROWS * WG * 2 == KV_STRIDE, "ws map");
static_assert(WS_ACT + (size_t)MT * DFF * 2 <= WS_PART && WS_KV + 4 * KV_STRIDE == WS_PART && WS_PART + (size_t)8 * MS * DM * 4 == WS_END, "ws map");
constexpr int CW_TMO = 0, CW_CODE = 1, CW_BAR = 4096, CW_SSQ = 16384;
static_assert((CW_SSQ + MT) * 4 <= (int)CTL_ZERO_BYTES, "ctl");

constexpr int NWAVES = 8;
constexpr int RING_OFF = 0, RING_BYTES = 131072;
constexpr int LDSCTL_OFF = RING_BYTES, MISC_OFF = LDSCTL_OFF + 320;
constexpr int LDS_BYTES = 147456;

#define RLX_AGENT __ATOMIC_RELAXED, __HIP_MEMORY_SCOPE_AGENT
#define LDS_WAIT() asm volatile("s_waitcnt lgkmcnt(0)" ::: "memory")
#define VM_WAIT() asm volatile("s_waitcnt vmcnt(0)" ::: "memory")

__device__ __forceinline__ unsigned cvt_pk_bf16(float lo, float hi) { unsigned r; asm volatile("v_cvt_pk_bf16_f32 %0, %1, %2" : "=v"(r) : "v"(lo), "v"(hi)); return r; }

namespace pg8 {
#define PG8_LAS __attribute__((address_space(3)))
typedef unsigned short bf16_t;
constexpr int BM = 256, BK = 64, HALF = 128, HTB = HALF * BK * 2, STAGE_BYTES = 8 * HTB, NXCD = 8, WGM = 8;
__host__ __device__ __forceinline__ int lds_byte(int r, int c) { const int st = (r >> 4) * 2 + (c >> 5), rr = r & 15, cc = c & 31, ob = rr * 64 + cc * 2; return st * 1024 + (ob ^ (((ob >> 9) & 1) << 5)); }
__host__ __device__ __forceinline__ void stage_rc(int b, int& R, int& C) { const int st = b / 1024, sb = b % 1024, swz = sb ^ (((sb >> 9) & 1) << 5); R = (st >> 1) * 16 + swz / 64; C = (st & 1) * 32 + (swz % 64) / 2; }
__host__ __device__ __forceinline__ int perm32(int rho) { const int n = rho >> 4, i = rho & 15; return 8 * (i >> 2) + 4 * n + (i & 3); }
struct Unit { int pm, pn, kt0, nkt, ks; };
struct Gemm { const bf16_t* A; const bf16_t* Bt; int M, N, K; };
struct StaticOrder {
    int nM, nN, nwg, G, c, nkt_full;
    __host__ __device__ void init(int M, int N, int K, int G_, int c_) { nM = M / BM; nN = N / BM; nwg = nM * nN; G = G_; c = c_; nkt_full = K / BK; }
    __host__ __device__ __forceinline__ void decode(int L, int& pm, int& pn) const {
        int wgid = L; { const int q = nwg / NXCD, r = nwg % NXCD, xcd = wgid % NXCD, off = wgid / NXCD; wgid = (xcd < r ? xcd * (q + 1) : r * (q + 1) + (xcd - r) * q) + off; }
        const int nig = WGM * nN, gid = wgid / nig, fm = gid * WGM, gsz = (nM - fm) < WGM ? (nM - fm) : WGM;
        pm = fm + ((wgid % nig) % gsz); pn = (wgid % nig) / gsz;
    }
    __host__ __device__ __forceinline__ bool next(int i, Unit& u) const {
        const long L = (long)i * G + c; if (L >= nwg) return false;
        int pm, pn; decode((int)L, pm, pn);
        u.pm = pm; u.pn = pn; u.kt0 = 0; u.nkt = nkt_full; u.ks = -1; return true;
    }
    __device__ __forceinline__ void a_ready(const Unit&) const {}
    __device__ __forceinline__ void done(const Unit&) const {}
};
struct DownOrder : StaticOrder {
    __device__ __forceinline__ bool next(int i, Unit& u) const {
        const long L = (long)i * G + c; const bool g256 = (G == 256);
        if (g256 ? (i > 4) : (L >= nwg + 32)) return false;
        const bool stat = g256 ? (i < 4) : (L < nwg), spl = g256 && i == 4;
        const int tile = g256 ? (c >> 3) : (int)(L - nwg), ks = c & 7;
        int pm, pn; decode(stat ? (int)L : 0, pm, pn);
        u.pm = stat ? pm : MP / BM + (tile >> 4); u.pn = stat ? pn : (tile & 15);
        u.ks = spl ? ks : -1; u.kt0 = spl ? (ks < 6 ? 22 * ks : 132 + 20 * (ks - 6)) : 0; u.nkt = spl ? (ks < 6 ? 22 : 20) : nkt_full;
        return true;
    }
};
template <class Epi, class Sched, bool ALIGN_EPI = false, bool SP2 = false>
__device__ __forceinline__ void gemm_phase(PG8_LAS unsigned char* lds, const Gemm g, const Sched& S, const Epi& E) {
    const int tid = threadIdx.x, wid = __builtin_amdgcn_readfirstlane(tid >> 6), lane = tid & 63, wr = wid >> 2, wc = wid & 3, fr = lane & 15, fq = lane >> 4;
    const int K = g.K;
    unsigned voffA[2], voffB[2];
#pragma unroll
    for (int i = 0; i < 2; ++i) { int R, C; stage_rc(tid * 16 + i * 8192, R, C); const int Rb = Epi::PERM ? ((R & ~31) + perm32(R & 31)) : R;
        voffA[i] = (unsigned)(R * K + C) * 2u; voffB[i] = (unsigned)(Rb * K + C) * 2u; }
    const size_t kstep = (size_t)(BK * 2);
    const size_t hstep = (size_t)HALF * K * 2;
    const size_t tstep = 2 * hstep;
    const unsigned ldsw = (unsigned)wid * 1024u;
    const int aoff = lds_byte(wr * 64 + fr, fq * 8), boff = lds_byte(wc * 32 + fr, fq * 8);
#define PG8_SA(b, h) (((b) * 2 + (h)) * HTB)
#define PG8_SB(b, h) ((4 + (b) * 2 + (h)) * HTB)
#define PG8_STAGE(bufoff, gbase, voff) do { _Pragma("unroll") for (int _i = 0; _i < 2; ++_i) \
        __builtin_amdgcn_global_load_lds((const unsigned*)((const char*)(gbase) + (voff)[_i]), (PG8_LAS unsigned*)(lds + (bufoff) + ldsw + _i * 8192), 16, 0, 0); } while (0)
#define PG8_LDA(dst, b, h) do { _Pragma("unroll") for (int m = 0; m < 4; ++m) _Pragma("unroll") for (int k = 0; k < 2; ++k) dst[m][k] = *(const PG8_LAS bf16x8*)(lds + PG8_SA(b, h) + aoff + m * 2048 + k * 1024); } while (0)
#define PG8_LDB(dst, b, h) do { _Pragma("unroll") for (int n = 0; n < 2; ++n) _Pragma("unroll") for (int k = 0; k < 2; ++k) dst[n][k] = *(const PG8_LAS bf16x8*)(lds + PG8_SB(b, h) + boff + n * 2048 + k * 1024); } while (0)
#define PG8_MMA(ai, bj, At, Bt) do { __builtin_amdgcn_s_setprio(1); _Pragma("unroll") for (int m = 0; m < 4; ++m) _Pragma("unroll") for (int n = 0; n < 2; ++n) _Pragma("unroll") for (int k = 0; k < 2; ++k) \
        acc[ai][bj][m][n] = __builtin_amdgcn_mfma_f32_16x16x32_bf16(Bt[n][k], At[m][k], acc[ai][bj][m][n], 0, 0, 0); __builtin_amdgcn_s_setprio(0); } while (0)
#define PG8_WAIT_V(n) asm volatile("s_waitcnt vmcnt(" #n ")" ::: "memory")
#define PG8_WAIT_L(n) asm volatile("s_waitcnt lgkmcnt(" #n ")" ::: "memory")
#define PG8_BAR __builtin_amdgcn_s_barrier()
#define PG8_SCHED __builtin_amdgcn_sched_barrier(0)
    Unit cur, nxt; int ui = 0;
    if (!S.next(0, cur)) return;
    f32x4 acc[2][2][4][2];
#pragma unroll
    for (int a = 0; a < 2; ++a)
#pragma unroll
        for (int b = 0; b < 2; ++b)
#pragma unroll
            for (int m = 0; m < 4; ++m)
#pragma unroll
                for (int n = 0; n < 2; ++n) acc[a][b][m][n] = (f32x4){0.f, 0.f, 0.f, 0.f};
    bf16x8 At[4][2], B0[2][2], B1[2][2];
    const char* cA = (const char*)g.A + (size_t)cur.pm * tstep + (size_t)cur.kt0 * kstep; const char* cB = (const char*)g.Bt + (size_t)cur.pn * tstep + (size_t)cur.kt0 * kstep;
    S.a_ready(cur);
    if constexpr (SP2) {
        PG8_STAGE(PG8_SB(0, 0), cB, voffB); PG8_STAGE(PG8_SB(0, 1), cB + hstep, voffB); PG8_STAGE(PG8_SA(0, 0), cA, voffA); PG8_STAGE(PG8_SA(0, 1), cA + hstep, voffA);
        if (wr == 1) PG8_BAR;
        PG8_WAIT_V(2); PG8_BAR;
        PG8_STAGE(PG8_SB(1, 0), cB + kstep, voffB); PG8_STAGE(PG8_SA(1, 0), cA + kstep, voffA); PG8_STAGE(PG8_SB(1, 1), cB + hstep + kstep, voffB);
        PG8_WAIT_V(6); PG8_BAR;
    } else {
        PG8_STAGE(PG8_SB(0, 0), cB, voffB); PG8_STAGE(PG8_SA(0, 0), cA, voffA); PG8_STAGE(PG8_SB(0, 1), cB + hstep, voffB); PG8_STAGE(PG8_SA(0, 1), cA + hstep, voffA);
        if (wr == 1) PG8_BAR;
        PG8_WAIT_V(4); PG8_BAR;
        PG8_STAGE(PG8_SB(1, 0), cB + kstep, voffB); PG8_STAGE(PG8_SA(1, 0), cA + kstep, voffA); PG8_STAGE(PG8_SB(1, 1), cB + hstep + kstep, voffB);
        PG8_WAIT_V(6); PG8_BAR;
    }
    for (;;) {
        const bool has_next = S.next(ui + 1, nxt);
        const char* nA = has_next ? (const char*)g.A + (size_t)nxt.pm * tstep + (size_t)nxt.kt0 * kstep : cA; const char* nB = has_next ? (const char*)g.Bt + (size_t)nxt.pn * tstep + (size_t)nxt.kt0 * kstep : cB;
        const int nt = cur.nkt;
        for (int t = 0; t < nt; t += 2) {
            const bool last = (t == nt - 2);
            const char* a1 = cA + (size_t)(t + 1) * kstep;
            const char* a2 = last ? nA : cA + (size_t)(t + 2) * kstep; const char* b2 = last ? nB : cB + (size_t)(t + 2) * kstep;
            const char* a3 = a2 + kstep; const char* b3 = b2 + kstep;
            if (last && has_next) S.a_ready(nxt);
            if constexpr (SP2) {
            PG8_LDB(B0, 0, 0); PG8_LDB(B1, 0, 1); PG8_SCHED; PG8_LDA(At, 0, 0); PG8_STAGE(PG8_SA(1, 1), a1 + hstep, voffA);
            PG8_WAIT_V(8); PG8_WAIT_L(0); PG8_BAR; PG8_MMA(0, 0, At, B0); PG8_MMA(0, 1, At, B1); PG8_BAR; PG8_SCHED;
            PG8_LDA(At, 0, 1); PG8_STAGE(PG8_SB(0, 0), b2, voffB); PG8_STAGE(PG8_SB(0, 1), b2 + hstep, voffB); PG8_STAGE(PG8_SA(0, 0), a2, voffA);
            PG8_WAIT_V(8); PG8_WAIT_L(0); PG8_BAR; PG8_MMA(1, 0, At, B0); PG8_MMA(1, 1, At, B1); PG8_BAR; PG8_SCHED;
            PG8_LDB(B0, 1, 0); PG8_LDB(B1, 1, 1); PG8_SCHED; PG8_LDA(At, 1, 0); PG8_STAGE(PG8_SA(0, 1), a2 + hstep, voffA);
            PG8_WAIT_V(8); PG8_WAIT_L(0); PG8_BAR; PG8_MMA(0, 0, At, B0); PG8_MMA(0, 1, At, B1); PG8_BAR; PG8_SCHED;
            PG8_LDA(At, 1, 1); PG8_STAGE(PG8_SB(1, 0), b3, voffB); PG8_STAGE(PG8_SB(1, 1), b3 + hstep, voffB); PG8_STAGE(PG8_SA(1, 0), a3, voffA);
            PG8_WAIT_V(8); PG8_WAIT_L(0); PG8_BAR; PG8_MMA(1, 0, At, B0); PG8_MMA(1, 1, At, B1); PG8_BAR; PG8_SCHED;
            } else {
            PG8_LDB(B0, 0, 0); PG8_SCHED; PG8_LDA(At, 0, 0); PG8_STAGE(PG8_SA(1, 1), a1 + hstep, voffA);
            PG8_WAIT_L(8); PG8_BAR; PG8_WAIT_L(0); PG8_MMA(0, 0, At, B0); PG8_BAR; PG8_SCHED;
            PG8_LDB(B1, 0, 1); PG8_STAGE(PG8_SB(0, 0), b2, voffB);
            PG8_BAR; PG8_WAIT_L(0); PG8_MMA(0, 1, At, B1); PG8_BAR;
            PG8_LDA(At, 0, 1); PG8_STAGE(PG8_SA(0, 0), a2, voffA);
            PG8_BAR; PG8_WAIT_L(0); PG8_MMA(1, 0, At, B0); PG8_BAR; PG8_SCHED;
            PG8_STAGE(PG8_SB(0, 1), b2 + hstep, voffB);
            PG8_WAIT_V(6); PG8_BAR; PG8_MMA(1, 1, At, B1); PG8_BAR;
            PG8_LDB(B0, 1, 0); PG8_SCHED; PG8_LDA(At, 1, 0); PG8_STAGE(PG8_SA(0, 1), a2 + hstep, voffA);
            PG8_WAIT_L(8); PG8_BAR; PG8_WAIT_L(0); PG8_MMA(0, 0, At, B0); PG8_BAR; PG8_SCHED;
            PG8_LDB(B1, 1, 1); PG8_STAGE(PG8_SB(1, 0), b3, voffB);
            PG8_BAR; PG8_WAIT_L(0); PG8_MMA(0, 1, At, B1); PG8_BAR;
            PG8_LDA(At, 1, 1); PG8_STAGE(PG8_SA(1, 0), a3, voffA);
            PG8_BAR; PG8_WAIT_L(0); PG8_MMA(1, 0, At, B0); PG8_BAR; PG8_SCHED;
            PG8_STAGE(PG8_SB(1, 1), b3 + hstep, voffB);
            PG8_WAIT_V(6); PG8_BAR; PG8_MMA(1, 1, At, B1); PG8_BAR;
            }
        }
        if constexpr (ALIGN_EPI) { if (wr == 0) PG8_BAR; }
        E(acc, cur, wr, wc, fr, fq); S.done(cur);
        if (!has_next) break;
#pragma unroll
        for (int a = 0; a < 2; ++a)
#pragma unroll
            for (int b = 0; b < 2; ++b)
#pragma unroll
                for (int m = 0; m < 4; ++m)
#pragma unroll
                    for (int n = 0; n < 2; ++n) acc[a][b][m][n] = (f32x4){0.f, 0.f, 0.f, 0.f};
        cur = nxt; cA = nA; cB = nB; ++ui;
        if constexpr (ALIGN_EPI) { if (wr == 1) PG8_BAR; }
    }
    PG8_WAIT_V(0);
    if constexpr (!ALIGN_EPI) { if (wr == 0) PG8_BAR; }
    PG8_BAR;
#undef PG8_SA
#undef PG8_SB
#undef PG8_STAGE
#undef PG8_LDA
#undef PG8_LDB
#undef PG8_MMA
#undef PG8_WAIT_V
#undef PG8_WAIT_L
#undef PG8_BAR
#undef PG8_SCHED
}

__device__ __forceinline__ float log_sigmoid_f(float x) { return -(fmaxf(-x, 0.f) + log1pf(expf(-fabsf(x)))); }
struct EpiIn {
    static constexpr bool PERM = true;
    bf16_t* QO; bf16_t* KV; float* out; const float* bfg;
    __device__ __forceinline__ void operator()(const f32x4 (&acc)[2][2][4][2], const Unit& u, int wr, int wc, int fr, int fq) const {
        const int seg = u.pn >> 3;
        const int row0 = u.pm * BM + wr * 64 + fr;
        const int cseg = (u.pn & 7) * BM + wc * 32 + 8 * fq;
        const bool prompt = u.pm < (MP / BM);
        if (seg == 6) {
            if (wc == 0 && fq < 2) {
                const f32x4 b0 = *(const f32x4*)(bfg + 8 * fq), b1 = *(const f32x4*)(bfg + 8 * fq + 4);
#pragma unroll
                for (int ai = 0; ai < 2; ++ai)
#pragma unroll
                    for (int m = 0; m < 4; ++m) { const int row = row0 + ai * HALF + m * 16;
                        float* dst = prompt ? out + O_PFL + (size_t)row * NHG + 8 * fq : out + O_SFL + (size_t)(row - MP) * NHG + 8 * fq;
                        const f32x4 v0 = acc[ai][0][m][0] + b0, v1 = acc[ai][0][m][1] + b1; f32x4 r0, r1;
#pragma unroll
                        for (int j = 0; j < 4; ++j) { r0[j] = log_sigmoid_f(v0[j]); r1[j] = log_sigmoid_f(v1[j]); }
                        *(f32x4*)dst = r0; *(f32x4*)(dst + 4) = r1; }
            }
        } else if (seg == 0 || seg == 3) {
            bf16_t* base = QO + (seg == 3 ? WG : 0) + cseg;
#pragma unroll
            for (int ai = 0; ai < 2; ++ai)
#pragma unroll
                for (int m = 0; m < 4; ++m) { bf16_t* rowp = base + (size_t)(row0 + ai * HALF + m * 16) * DM;
#pragma unroll
                    for (int bj = 0; bj < 2; ++bj) { const f32x4 v0 = acc[ai][bj][m][0] * QSCALE, v1 = acc[ai][bj][m][1] * QSCALE;
                        v4u w; w.x = cvt_pk_bf16(v0[0], v0[1]); w.y = cvt_pk_bf16(v0[2], v0[3]); w.z = cvt_pk_bf16(v1[0], v1[1]); w.w = cvt_pk_bf16(v1[2], v1[3]);
                        *(v4u*)(rowp + bj * HALF) = w; } }
        } else {
            const int kvi = (seg == 1) ? 0 : (seg == 2) ? 1 : (seg == 4) ? 2 : 3;
            bf16_t* kvb = KV + (size_t)kvi * (KV_STRIDE / 2) + cseg;
            float* ob = out + (prompt ? O_PFK + (size_t)kvi * ((size_t)MP * WG) + (kvi >= 2 ? (size_t)MP * NHG : 0)
                                      : O_SFK + (size_t)kvi * ((size_t)MS * WG) + (kvi >= 2 ? (size_t)MS * NHG : 0)) + cseg;
#pragma unroll
            for (int ai = 0; ai < 2; ++ai)
#pragma unroll
                for (int m = 0; m < 4; ++m) { const int row = row0 + ai * HALF + m * 16; const int rs = row - MP;
                    const int kvrow = prompt ? row : MP + (rs >> 5) * TKS + PAST + (rs & 31);
                    const int orow = prompt ? row : rs;
                    bf16_t* rowp = kvb + (size_t)kvrow * WG; float* op = ob + (size_t)orow * WG;
#pragma unroll
                    for (int bj = 0; bj < 2; ++bj) { const f32x4 v0 = acc[ai][bj][m][0], v1 = acc[ai][bj][m][1];
                        v4u w; w.x = cvt_pk_bf16(v0[0], v0[1]); w.y = cvt_pk_bf16(v0[2], v0[3]); w.z = cvt_pk_bf16(v1[0], v1[1]); w.w = cvt_pk_bf16(v1[2], v1[3]);
                        if (prompt) *(v4u*)(rowp + bj * HALF) = w;
                        *(f32x4*)(op + bj * HALF) = v0; *(f32x4*)(op + bj * HALF + 4) = v1; } }
        }
    }
};
struct EpiX2 {
    static constexpr bool PERM = true;
    const float* rp; const float* rs; bf16_t* X2; float* ssq;
    __device__ __forceinline__ void operator()(const f32x4 (&acc)[2][2][4][2], const Unit& u, int wr, int wc, int fr, int fq) const {
        const int row0 = u.pm * BM + wr * 64 + fr, col0 = u.pn * BM + wc * 32 + 8 * fq;
        const bool prompt = u.pm < (MP / BM);
#pragma unroll
        for (int ai = 0; ai < 2; ++ai)
#pragma unroll
            for (int m = 0; m < 4; ++m) { const int row = row0 + ai * HALF + m * 16;
                const float* rr = (prompt ? rp + (size_t)row * DM : rs + (size_t)(row - MP) * DM) + col0; bf16_t* op = X2 + (size_t)row * DM + col0;
                f32x4 rv[2][2];
#pragma unroll
                for (int bj = 0; bj < 2; ++bj)
#pragma unroll
                    for (int n = 0; n < 2; ++n) rv[bj][n] = *(const f32x4*)(rr + bj * HALF + n * 4);
                float s = 0.f;
#pragma unroll
                for (int bj = 0; bj < 2; ++bj) { const f32x4 v0 = acc[ai][bj][m][0] + rv[bj][0], v1 = acc[ai][bj][m][1] + rv[bj][1];
                    s += (v0[0] * v0[0] + v0[1] * v0[1]) + (v0[2] * v0[2] + v0[3] * v0[3]) + (v1[0] * v1[0] + v1[1] * v1[1]) + (v1[2] * v1[2] + v1[3] * v1[3]);
                    v4u w; w.x = cvt_pk_bf16(v0[0], v0[1]); w.y = cvt_pk_bf16(v0[2], v0[3]); w.z = cvt_pk_bf16(v1[0], v1[1]); w.w = cvt_pk_bf16(v1[2], v1[3]);
                    *(v4u*)(op + bj * HALF) = w; }
                s += __shfl_xor(s, 16); s += __shfl_xor(s, 32);
                if (fq == 0) __hip_atomic_fetch_add(ssq + row, s, __ATOMIC_RELAXED, __HIP_MEMORY_SCOPE_AGENT); }
    }
};
struct EpiDown {
    static constexpr bool PERM = true;
    const bf16_t* X2; float* out; float* part;
    __device__ __forceinline__ void operator()(const f32x4 (&acc)[2][2][4][2], const Unit& u, int wr, int wc, int fr, int fq) const {
        const int row0 = u.pm * BM + wr * 64 + fr, col0 = u.pn * BM + wc * 32 + 8 * fq;
        if (u.ks >= 0) {
            float* pb = part + (size_t)u.ks * ((size_t)MS * DM);
#pragma unroll
            for (int ai = 0; ai < 2; ++ai)
#pragma unroll
                for (int m = 0; m < 4; ++m) { float* op = pb + (size_t)(row0 + ai * HALF + m * 16 - MP) * DM + col0;
#pragma unroll
                    for (int bj = 0; bj < 2; ++bj) { *(f32x4*)(op + bj * HALF) = acc[ai][bj][m][0]; *(f32x4*)(op + bj * HALF + 4) = acc[ai][bj][m][1]; } }
            return;
        }
#pragma unroll
        for (int ai = 0; ai < 2; ++ai)
#pragma unroll
            for (int m = 0; m < 4; ++m) { const size_t off = (size_t)(row0 + ai * HALF + m * 16) * DM + col0;
                v4u xv[2];
#pragma unroll
                for (int bj = 0; bj < 2; ++bj) xv[bj] = *(const v4u*)(X2 + off + bj * HALF);
#pragma unroll
                for (int bj = 0; bj < 2; ++bj) { const v4u x = xv[bj];
                    const f32x4 r0 = {__uint_as_float(x.x << 16), __uint_as_float(x.x & 0xffff0000u), __uint_as_float(x.y << 16), __uint_as_float(x.y & 0xffff0000u)};
                    const f32x4 r1 = {__uint_as_float(x.z << 16), __uint_as_float(x.z & 0xffff0000u), __uint_as_float(x.w << 16), __uint_as_float(x.w & 0xffff0000u)};
                    *(f32x4*)(out + off + bj * HALF) = acc[ai][bj][m][0] + r0; *(f32x4*)(out + off + bj * HALF + 4) = acc[ai][bj][m][1] + r1; } }
    }
};
struct EpiGlu {
    static constexpr bool PERM = true;
    bf16_t* ACT; const float* ssq;
    __device__ __forceinline__ void operator()(const f32x4 (&acc)[2][2][4][2], const Unit& u, int wr, int wc, int fr, int fq) const {
        const int row0 = u.pm * BM + wr * 64 + fr, col0 = u.pn * HALF + wc * 32 + 8 * fq;
#pragma unroll
        for (int ai = 0; ai < 2; ++ai)
#pragma unroll
            for (int m = 0; m < 4; ++m) { const int row = row0 + ai * HALF + m * 16; bf16_t* rowp = ACT + (size_t)row * DFF + col0; float r[8];
                const float rstd = rsqrtf(ssq[row] * (1.f / DM) + EPS);
#pragma unroll
                for (int n = 0; n < 2; ++n)
#pragma unroll
                    for (int j = 0; j < 4; ++j) { const float g = acc[ai][0][m][n][j] * rstd, up = acc[ai][1][m][n][j] * rstd;
                        r[n * 4 + j] = g * __builtin_amdgcn_rcpf(1.0f + __builtin_amdgcn_exp2f(-g * LOG2E)) * up; }
                v4u w; w.x = cvt_pk_bf16(r[0], r[1]); w.y = cvt_pk_bf16(r[2], r[3]); w.z = cvt_pk_bf16(r[4], r[5]); w.w = cvt_pk_bf16(r[6], r[7]);
                *(v4u*)rowp = w; }
    }
};
}

namespace att {
constexpr int SHM_V = 16384, SHM_K = 16384;
constexpr int OFF_V = 0, OFF_K = 2 * SHM_V, OFF_WS = 4 * 16384, OFF_U = OFF_WS + NWAVES * 256, OFF_SCAN = OFF_U + (2048 + 64) * 4, OFF_FLAG = OFF_SCAN + 64, ATT_LDS = OFF_FLAG + 64;
static_assert(ATT_LDS <= RING_BYTES, "attention LDS");
#define KSWZ(row, colB) ((row) * 256 + ((colB) ^ (((row) & 7) << 4)))
#define SBAR() __builtin_amdgcn_sched_barrier(0)
__device__ __forceinline__ int slot32(int k) { return (k & 3) | (((k >> 2) & 3) << 3) | (((k >> 4) & 1) << 2); }
__device__ __forceinline__ int v_st(int k, int c) { const int kk = (k & ~0xC) | ((k & 4) << 1) | ((k & 8) >> 1); return ((kk >> 3) * 4 + (c >> 5)) * 512 + ((kk & 7) * 32 + (c & 31)) * 2; }
__device__ __forceinline__ int v_rd_base(int lane) { return ((lane & 3) << 3) | (((lane >> 2) & 3) << 6) | (((lane >> 4) & 1) << 5) | (((lane >> 5) & 1) << 8); }
constexpr int v_rd_off(int d0, int ks, int half) { return d0 * 512 + ks * 4096 + half * 2048; }
__device__ __forceinline__ int crow(int r, int hi) { return (r & 3) + 8 * (r >> 2) + 4 * hi; }
__device__ __forceinline__ float partner(float x, int hi) { auto rr = __builtin_amdgcn_permlane32_swap(__float_as_uint(x), __float_as_uint(x), false, false); return __uint_as_float(hi ? rr[0] : rr[1]); }

__device__ __forceinline__ void qkt(f32x16& p0, f32x16& p1, LAS const unsigned char* Kt, int r32, int hi, const bf16x8* qr) {
    LAS const unsigned char* kb[4];
#pragma unroll
    for (int dd = 0; dd < 4; ++dd) kb[dd] = Kt + KSWZ(r32, (dd * 16 + hi * 8) * 2);
#pragma unroll
    for (int d0 = 0; d0 < 8; ++d0) { LAS const unsigned char* a = kb[d0 & 3] + (d0 >> 2) * 128;
        const bf16x8 b0 = *(LAS const bf16x8*)a;
        const bf16x8 b1 = *(LAS const bf16x8*)(a + 32 * 256);
        p0 = __builtin_amdgcn_mfma_f32_32x32x16_bf16(b0, qr[d0], p0, 0, 0, 0);
        p1 = __builtin_amdgcn_mfma_f32_32x32x16_bf16(b1, qr[d0], p1, 0, 0, 0); }
}
__device__ __forceinline__ void pv_tile(f32x16* o, int vb0, bf16x8 pa0, bf16x8 pa1, bf16x8 pa2, bf16x8 pa3) {
#define TRRD(dst, off) asm volatile("ds_read_b64_tr_b16 %0, %1 offset:%2" : "=&v"(dst) : "v"(vb0), "i"(off) : "memory")
#define PV_D0(d0) do { s16x4 l0, l1, l2, l3, h0, h1, h2, h3; constexpr int b_ = v_rd_off(d0, 0, 0); \
        TRRD(l0, b_); TRRD(h0, b_ + 2048); TRRD(l1, b_ + 4096); TRRD(h1, b_ + 6144); TRRD(l2, b_ + 8192); TRRD(h2, b_ + 10240); TRRD(l3, b_ + 12288); TRRD(h3, b_ + 14336); \
        asm volatile("s_waitcnt lgkmcnt(0)" ::: "memory"); SBAR(); \
        o[d0] = __builtin_amdgcn_mfma_f32_32x32x16_bf16(pa0, (bf16x8){l0[0], l0[1], l0[2], l0[3], h0[0], h0[1], h0[2], h0[3]}, o[d0], 0, 0, 0); \
        o[d0] = __builtin_amdgcn_mfma_f32_32x32x16_bf16(pa1, (bf16x8){l1[0], l1[1], l1[2], l1[3], h1[0], h1[1], h1[2], h1[3]}, o[d0], 0, 0, 0); \
        o[d0] = __builtin_amdgcn_mfma_f32_32x32x16_bf16(pa2, (bf16x8){l2[0], l2[1], l2[2], l2[3], h2[0], h2[1], h2[2], h2[3]}, o[d0], 0, 0, 0); \
        o[d0] = __builtin_amdgcn_mfma_f32_32x32x16_bf16(pa3, (bf16x8){l3[0], l3[1], l3[2], l3[3], h3[0], h3[1], h3[2], h3[3]}, o[d0], 0, 0, 0); } while (0)
    PV_D0(0); PV_D0(1); PV_D0(2); PV_D0(3);
#undef PV_D0
#undef TRRD
}
#define PK4(P, B_, OUT) do { unsigned a0 = cvt_pk_bf16(P[B_+0], P[B_+1]), a1 = cvt_pk_bf16(P[B_+2], P[B_+3]); \
        unsigned b0 = cvt_pk_bf16(P[B_+4], P[B_+5]), b1 = cvt_pk_bf16(P[B_+6], P[B_+7]); \
        auto r0 = __builtin_amdgcn_permlane32_swap(a0, b0, false, false); auto r1 = __builtin_amdgcn_permlane32_swap(a1, b1, false, false); \
        v4u w = {r0[0], r1[0], r0[1], r1[1]}; OUT = __builtin_bit_cast(bf16x8, w); } while (0)

template <class F> __device__ __forceinline__ void scan_u(LAS float* U, LAS float* scan, int n, F lf) {
    const int tid = threadIdx.x, lane = tid & 63, wid = tid >> 6, t0 = 4 * tid;
    float v0 = t0 < n ? lf(t0) : 0.f, v1 = t0 + 1 < n ? lf(t0 + 1) : 0.f, v2 = t0 + 2 < n ? lf(t0 + 2) : 0.f, v3 = t0 + 3 < n ? lf(t0 + 3) : 0.f;
    v1 += v0; v2 += v1; v3 += v2;
    float x = v3;
#pragma unroll
    for (int o = 1; o < 64; o <<= 1) { const float y = __shfl_up(x, o); if (lane >= o) x += y; }
    if (lane == 63) scan[wid] = x;
    __syncthreads();
    float pre = x - v3;
    for (int w = 0; w < wid; ++w) pre += scan[w];
    f32x4 r = {-(v0 + pre) * LOG2E, -(v1 + pre) * LOG2E, -(v2 + pre) * LOG2E, -(v3 + pre) * LOG2E};
    *(LAS f32x4*)(U + t0) = r;
    __syncthreads();
}

__device__ __forceinline__ int islot(int rho) { return (rho & 0x23) | (((rho >> 3) & 3) << 2) | (((rho >> 2) & 1) << 4); }
template <int MODE, bool SAMPLE>
__device__ __forceinline__ void attn_unit(LAS unsigned char* lds, const bf16* Q, const bf16* K, const bf16* V, bf16* O, int P0, const float* Kc, const float* Vc, const float* Kn, const float* Vn) {
    int tid_ = threadIdx.x; asm volatile("" : "+v"(tid_));
    const int tid = tid_, wid = __builtin_amdgcn_readfirstlane(tid >> 6), lane = tid & 63, r32 = lane & 31, hi = lane >> 5;
    constexpr int nact = SAMPLE ? 1 : NWAVES, Tk = SAMPLE ? TKS : SEQ;
    const bool active = wid < nact;
    const int NT = (P0 + 32 * nact + 63) >> 6;
    LAS unsigned char* V_lds = lds + OFF_V; LAS unsigned char* K_lds = lds + OFF_K;
    LAS float* wsf = (LAS float*)(lds + OFF_WS) + wid * 64; LAS float* li_l = wsf; LAS float* al_l = wsf + 32;
    LAS const float* U = (LAS const float*)(lds + OFF_U);
    LAS unsigned* flg = (LAS unsigned*)(lds + OFF_FLAG);
    int kkey[2], kcol[2], vkey[2], vcol[2];
#pragma unroll
    for (int i = 0; i < 2; ++i) {
        const int q = wid * 2 + i;
        { const int rho = q * 4 + (lane >> 4), cpos = lane & 15; kkey[i] = islot(rho); kcol[i] = (cpos ^ (rho & 7)) * 8; }
        { const int sub = q * 2 + (lane >> 5), kk = (sub >> 2) * 8 + ((lane & 31) >> 2), ks = (kk & ~0xC) | ((kk & 4) << 1) | ((kk & 8) >> 1); vkey[i] = islot(ks); vcol[i] = (sub & 3) * 32 + (lane & 3) * 8; }
    }
    if (MODE == 1 && lane == 0) { flg[wid] = active ? 0u : 1u; flg[8 + wid] = active ? 0u : 1u; }
#define TILE_OF(t) (NT - 1 - (t))
#define STAGE_DMA(j, bf) do { _Pragma("unroll") for (int _i = 0; _i < 2; ++_i) { \
        int kk_ = (j) * 64 + kkey[_i]; kk_ = kk_ < Tk ? kk_ : Tk - 1; int vk_ = (j) * 64 + vkey[_i]; vk_ = vk_ < Tk ? vk_ : Tk - 1; \
        __builtin_amdgcn_global_load_lds((const unsigned*)(K + (size_t)kk_ * WG + kcol[_i]), (LAS unsigned*)(K_lds + (bf) * SHM_K + (wid * 2 + _i) * 1024), 16, 0, 0); \
        __builtin_amdgcn_global_load_lds((const unsigned*)(V + (size_t)vk_ * WG + vcol[_i]), (LAS unsigned*)(V_lds + (bf) * SHM_V + (wid * 2 + _i) * 1024), 16, 0, 0); } } while (0)
#define STAGE_F32(j, bf) do { const int lt_ = tid - 64; f32x4 fa_[5], fb_[5]; int dst_[5]; \
        _Pragma("unroll") for (int jj_ = 0; jj_ < 5; ++jj_) { const int i_ = lt_ + 448 * jj_; int key_, col_; const bool isv_ = i_ >= 1024; \
            if (!isv_) { const int rho = i_ >> 4, cpos = i_ & 15; key_ = islot(rho); col_ = (cpos ^ (rho & 7)) * 8; dst_[jj_] = OFF_K + (bf) * SHM_K + i_ * 16; } \
            else { const int iv = i_ - 1024, sub = iv >> 5, kk = (sub >> 2) * 8 + ((iv & 31) >> 2), ks = (kk & ~0xC) | ((kk & 4) << 1) | ((kk & 8) >> 1); key_ = islot(ks); col_ = (sub & 3) * 32 + (iv & 3) * 8; dst_[jj_] = OFF_V + (bf) * SHM_V + iv * 16; } \
            int ka_ = (j) * 64 + key_; ka_ = ka_ < Tk ? ka_ : Tk - 1; \
            const float* src_ = (ka_ < PAST ? (isv_ ? Vc : Kc) + (size_t)ka_ * WG : (isv_ ? Vn : Kn) + (size_t)(ka_ - PAST) * WG) + col_; \
            if (i_ < 2048) { fa_[jj_] = *(const f32x4*)src_; fb_[jj_] = *(const f32x4*)(src_ + 4); } } \
        _Pragma("unroll") for (int jj_ = 0; jj_ < 5; ++jj_) { const int i_ = lt_ + 448 * jj_; \
            if (i_ < 2048) { v4u w_; w_.x = cvt_pk_bf16(fa_[jj_].x, fa_[jj_].y); w_.y = cvt_pk_bf16(fa_[jj_].z, fa_[jj_].w); w_.z = cvt_pk_bf16(fb_[jj_].x, fb_[jj_].y); w_.w = cvt_pk_bf16(fb_[jj_].z, fb_[jj_].w); \
                *(LAS v4u*)(lds + dst_[jj_]) = w_; } } } while (0)
    if (SAMPLE && wid >= 1) {
        STAGE_F32(TILE_OF(0), 0); LDS_WAIT();
        __syncthreads();
        for (int t = 0; t < NT; ++t) {
            if (t + 1 < NT) STAGE_F32(TILE_OF(t + 1), (t + 1) & 1);
            LDS_WAIT();
            __syncthreads();
            if (MODE == 1) { const v4u fa = *(LAS const v4u*)(flg + (t & 1) * 8), fb = *(LAS const v4u*)(flg + (t & 1) * 8 + 4);
                if ((fa.x & fa.y & fa.z & fa.w & fb.x & fb.y & fb.z & fb.w) != 0u) break; }
        }
        __syncthreads();
        return;
    }
    const int vb0 = (int)(size_t)V_lds + v_rd_base(lane);
    const int qlo = P0 + wid * 32, tq = qlo + r32;
    bf16x8 qr[8];
#pragma unroll
    for (int d0 = 0; d0 < 8; ++d0) qr[d0] = *(const bf16x8*)(Q + (size_t)(wid * 32 + r32) * DM + d0 * 16 + hi * 8);
    if (!SAMPLE) { STAGE_DMA(TILE_OF(0), 0); VM_WAIT(); }
    __syncthreads();
    float m_reg = -1e30f, l_reg = 0.f, carry = 1.f;
    f32x16 o[4] = {};
    for (int t = 0; t < NT; ++t) {
        const int j = TILE_OF(t), kb = j * 64, bufo = (t & 1) * SHM_K;
        if (!SAMPLE && t + 1 < NT) STAGE_DMA(TILE_OF(t + 1), (t + 1) & 1);
        if (kb <= qlo + 31) {
            f32x16 p0, p1;
            if (MODE == 0) {
                LAS const f32x4* up0 = (LAS const f32x4*)(U + kb + 16 * hi); LAS const f32x4* up1 = (LAS const f32x4*)(U + kb + 32 + 16 * hi);
#pragma unroll
                for (int g = 0; g < 4; ++g) { const f32x4 a = up0[g], b = up1[g];
#pragma unroll
                    for (int jj = 0; jj < 4; ++jj) { p0[4 * g + jj] = a[jj]; p1[4 * g + jj] = b[jj]; } }
            } else { p0 = f32x16{}; p1 = f32x16{}; }
            qkt(p0, p1, K_lds + bufo, r32, hi, qr);
            bf16x8 pa0, pa1, pa2, pa3;
            const int dq = tq - kb - 16 * hi;
            const bool need_mask = kb + 63 >= qlo;
            if (MODE == 0) {
                if (need_mask) { const float NEG = -__builtin_inff();
#pragma unroll
                    for (int r = 0; r < 16; ++r) { if (r > dq) p0[r] = NEG; if (r + 32 > dq) p1[r] = NEG; } }
                float pmax = p0[0];
#pragma unroll
                for (int r = 1; r < 16; ++r) pmax = fmaxf(pmax, p0[r]);
#pragma unroll
                for (int r = 0; r < 16; ++r) pmax = fmaxf(pmax, p1[r]);
                pmax = fmaxf(pmax, partner(pmax, hi));
                const float mn = fmaxf(m_reg, pmax);
                const bool grew = __any(mn > m_reg);
                float ps = 0.f;
#pragma unroll
                for (int r = 0; r < 16; ++r) { p0[r] = __builtin_amdgcn_exp2f(p0[r] - mn); p1[r] = __builtin_amdgcn_exp2f(p1[r] - mn); ps += p0[r] + p1[r]; }
                ps += partner(ps, hi);
                if (grew) {
                    const float alpha = __builtin_amdgcn_exp2f(m_reg - mn);
                    l_reg = l_reg * alpha + ps;
                    if (hi == 0) al_l[r32] = alpha;
                    LDS_WAIT();
#pragma unroll
                    for (int g = 0; g < 4; ++g) { const f32x4 a = *(LAS const f32x4*)(al_l + 8 * g + 4 * hi);
#pragma unroll
                        for (int jj = 0; jj < 4; ++jj)
#pragma unroll
                            for (int d_ = 0; d_ < 4; ++d_) o[d_][4 * g + jj] *= a[jj]; }
                } else l_reg += ps;
                m_reg = mn;
            } else {
                f32x16 w1;
#pragma unroll
                for (int r = 0; r < 16; ++r) { p1[r] = __builtin_amdgcn_exp2f(fminf(p1[r], 80.f)); w1[r] = __builtin_amdgcn_rcpf(1.0f + p1[r]); }
                if (need_mask) {
#pragma unroll
                    for (int r = 0; r < 16; ++r) if (r + 32 >= dq) { p1[r] = 0.f; w1[r] = 1.f; } }
#pragma unroll
                for (int r = 14; r >= 0; --r) w1[r] *= w1[r + 1];
                const float T1 = w1[0], oT1 = partner(T1, hi);
                const float f1 = hi ? carry : carry * oT1;
#pragma unroll
                for (int r = 0; r < 16; ++r) p1[r] = p1[r] * (w1[r] * f1);
                f32x16 w0;
#pragma unroll
                for (int r = 0; r < 16; ++r) { p0[r] = __builtin_amdgcn_exp2f(fminf(p0[r], 80.f)); w0[r] = __builtin_amdgcn_rcpf(1.0f + p0[r]); }
                if (need_mask) {
#pragma unroll
                    for (int r = 0; r < 16; ++r) if (r >= dq) { p0[r] = 0.f; w0[r] = 1.f; } }
#pragma unroll
                for (int r = 14; r >= 0; --r) w0[r] *= w0[r + 1];
                const float T0 = w0[0], oT0 = partner(T0, hi);
                const float f0 = (carry * (T1 * oT1)) * (hi ? 1.f : oT0);
#pragma unroll
                for (int r = 0; r < 16; ++r) p0[r] = p0[r] * (w0[r] * f0);
                carry = carry * ((T0 * oT0) * (T1 * oT1));
            }
            PK4(p0, 0, pa0); PK4(p0, 8, pa1); PK4(p1, 0, pa2); PK4(p1, 8, pa3);
            pv_tile(o, vb0 + bufo, pa0, pa1, pa2, pa3);
        }
        if (MODE == 1) { const bool dead = __all(carry == 0.f) != 0; if (lane == 0) flg[(t & 1) * 8 + wid] = dead ? 1u : 0u; }
        if (!SAMPLE) VM_WAIT();
        LDS_WAIT();
        __syncthreads();
        if (MODE == 1) {
            const v4u fa = *(LAS const v4u*)(flg + (t & 1) * 8), fb = *(LAS const v4u*)(flg + (t & 1) * 8 + 4);
            if ((fa.x & fa.y & fa.z & fa.w & fb.x & fb.y & fb.z & fb.w) != 0u) break;
        }
    }
    {
        if (MODE == 0) {
            if (hi == 0) li_l[r32] = 1.0f / l_reg;
            LDS_WAIT();
#pragma unroll
            for (int g = 0; g < 4; ++g) { const f32x4 a = *(LAS const f32x4*)(li_l + 8 * g + 4 * hi);
#pragma unroll
                for (int jj = 0; jj < 4; ++jj)
#pragma unroll
                    for (int d_ = 0; d_ < 4; ++d_) o[d_][4 * g + jj] *= a[jj]; }
        }
        bf16* Ow = O + (size_t)(wid * 32) * DM;
#pragma unroll
        for (int r = 0; r < 16; ++r) { const int orow = crow(r, hi);
#pragma unroll
            for (int d0 = 0; d0 < 4; ++d0) { const float v = o[d0][r]; const float vn = __shfl_xor(v, 1);
                if ((r32 & 1) == 0) *(unsigned*)(Ow + (size_t)orow * DM + d0 * 32 + r32) = cvt_pk_bf16(v, vn); } }
    }
    __syncthreads();
#undef TILE_OF
#undef STAGE_DMA
#undef STAGE_F32
}
#undef PK4
}

#define XB_TMO      128
#define XB_XCNT(j)  (256  + 64 * (j))
#define XB_XSUB(j)  (1280 + 64 * (j))
#define XB_XGEN(j)  (2304 + 64 * (j))
#define XB_TOP      3328
#define XB_TOPGEN   3392
#define XCD_BAR_WORDS 3456
#define XB_SPIN_CAP (1u << 18)
__device__ __forceinline__ unsigned xb_ld(unsigned* p)              { return __hip_atomic_load(p, __ATOMIC_RELAXED, __HIP_MEMORY_SCOPE_AGENT); }
__device__ __forceinline__ unsigned xb_add(unsigned* p, unsigned v) { return __hip_atomic_fetch_add(p, v, __ATOMIC_RELAXED, __HIP_MEMORY_SCOPE_AGENT); }
__device__ __forceinline__ unsigned xb_xcc_id() { return (unsigned)__builtin_amdgcn_s_getreg((3 << 11) | 20) & 0xFu; }
#define XB_SPIN(cond, bar) do { unsigned _sp = 0; while (cond) { __builtin_amdgcn_s_sleep(1); \
    if ((++_sp & 255u) == 0u) { if (xb_ld(&(bar)[XB_TMO])) break; if (_sp > XB_SPIN_CAP) { atomicAdd(&(bar)[XB_TMO], 1u); break; } } } } while (0)
struct XcdBarrier { unsigned* bar; unsigned x; volatile LAS unsigned* st; };
__device__ __forceinline__ XcdBarrier xcd_barrier_post(unsigned* bar, volatile LAS unsigned* st) {
    XcdBarrier b; b.bar = bar; b.x = xb_xcc_id(); b.st = st;
    if (threadIdx.x == 0) (void)xb_add(&bar[XB_XCNT(b.x)], 1u);
    return b;
}
__device__ __forceinline__ void xcd_barrier_complete(unsigned* bar, unsigned x, unsigned& nloc, unsigned& nx) {
    const unsigned G = gridDim.x * gridDim.y * gridDim.z;
    unsigned sum, cnt, mine, sp = 0u;
    for (;;) {
        sum = 0u; cnt = 0u; mine = 0u;
#pragma unroll
        for (unsigned j = 0; j < 16; ++j) { const unsigned c = xb_ld(&bar[XB_XCNT(j)]); sum += c; cnt += (c > 0u) ? 1u : 0u; mine = (j == x) ? c : mine; }
        if (sum == G) break;
        __builtin_amdgcn_s_sleep(1);
        if ((++sp & 255u) == 0u) { if (xb_ld(&bar[XB_TMO])) break; if (sp > XB_SPIN_CAP) { atomicAdd(&bar[XB_TMO], 1u); break; } }
    }
    nloc = mine > 0u ? mine : 1u; nx = cnt > 0u ? cnt : 1u;
}
__device__ __forceinline__ void xcd_barrier(const XcdBarrier& b) {
    asm volatile("s_waitcnt vmcnt(0)" ::: "memory");
    __syncthreads();
    if (threadIdx.x == 0) {
        unsigned* bar = b.bar;
        __builtin_amdgcn_s_waitcnt(0);
        unsigned nloc = b.st[0], nx = b.st[1];
        if (nloc == 0u) { xcd_barrier_complete(bar, b.x, nloc, nx); b.st[0] = nloc; b.st[1] = nx; }
        const unsigned old = xb_add(&bar[XB_XSUB(b.x)], 1u);
        const unsigned gen = old / nloc;
        if (old + 1u == (gen + 1u) * nloc) {
            __builtin_amdgcn_fence(__ATOMIC_RELEASE, "agent");
            asm volatile("s_waitcnt vmcnt(0)" ::: "memory");
            const unsigned og = xb_add(&bar[XB_TOP], 1u);
            const unsigned tg = og / nx;
            if (og + 1u == (tg + 1u) * nx) xb_add(&bar[XB_TOPGEN], 1u);
            else XB_SPIN(xb_ld(&bar[XB_TOPGEN]) == tg, bar);
            __builtin_amdgcn_fence(__ATOMIC_ACQUIRE, "agent");
            xb_add(&bar[XB_XGEN(b.x)], 1u);
            asm volatile("s_waitcnt vmcnt(0)" ::: "memory");
        } else {
            XB_SPIN(xb_ld(&bar[XB_XGEN(b.x)]) == gen, bar);
            __builtin_amdgcn_fence(__ATOMIC_ACQUIRE, "agent");
            asm volatile("s_waitcnt vmcnt(0)" ::: "memory");
        }
    }
    __syncthreads();
}

struct Args { const float* in[18]; float* out; unsigned char* ws; int ph_lo, ph_hi; };

__device__ __forceinline__ float wave_sum(float v) {
#pragma unroll
    for (int o = 1; o < 64; o <<= 1) v += __shfl_xor(v, o);
    return v;
}
__device__ __forceinline__ void tr_load(f32x4 (&r)[8], const float* W, int ldw, int k0, int n0, int lane) {
    const float* p = W + (size_t)(k0 + (lane >> 3)) * ldw + n0 + 4 * (lane & 7);
#pragma unroll
    for (int j = 0; j < 8; ++j) r[j] = *(const f32x4*)(p + (size_t)(8 * j) * ldw);
}
__device__ __forceinline__ void tr_proc(const f32x4 (&r)[8], const float* ksc, int K, int k0, int ncols, bf16* WT, int drow0, LAS float* scr, int lane) {
    const int c = 4 * (lane & 7);
#pragma unroll
    for (int j = 0; j < 8; ++j) { const int kk = 8 * j + (lane >> 3); const float sc = ksc ? ksc[k0 + kk] : 1.f; LAS float* d = scr + kk * 33 + c;
        d[0] = r[j].x * sc; d[1] = r[j].y * sc; d[2] = r[j].z * sc; d[3] = r[j].w * sc; }
    LDS_WAIT(); asm volatile("" ::: "memory");
    const int c8 = lane & 7;
#pragma unroll
    for (int j = 0; j < 4; ++j) { const int n = (lane >> 3) + 8 * j; const LAS float* s = scr + (8 * c8) * 33 + n;
        v4u o; o.x = cvt_pk_bf16(s[0 * 33], s[1 * 33]); o.y = cvt_pk_bf16(s[2 * 33], s[3 * 33]); o.z = cvt_pk_bf16(s[4 * 33], s[5 * 33]); o.w = cvt_pk_bf16(s[6 * 33], s[7 * 33]);
        if (n < ncols) *(GAS v4u*)(WT + (size_t)(drow0 + n) * K + k0 + 8 * c8) = o; }
    LDS_WAIT(); asm volatile("" ::: "memory");
}
__device__ __forceinline__ void rms_row_bf16(const float* xrow, const float* g, bf16* orow, int lane) {
    const f32x4* xr = (const f32x4*)xrow + lane; const f32x4* gr = (const f32x4*)g + lane;
    f32x4 v[16]; float s = 0.f;
#pragma unroll
    for (int j = 0; j < 16; ++j) { v[j] = xr[64 * j]; s += (v[j].x * v[j].x + v[j].y * v[j].y) + (v[j].z * v[j].z + v[j].w * v[j].w); }
    const float rstd = rsqrtf(wave_sum(s) * (1.f / DM) + EPS);
    v2u* o8 = (v2u*)orow + lane;
#pragma unroll
    for (int j = 0; j < 16; ++j) { const f32x4 gg = gr[64 * j]; v2u w; w.x = cvt_pk_bf16(v[j].x * rstd * gg.x, v[j].y * rstd * gg.y); w.y = cvt_pk_bf16(v[j].z * rstd * gg.z, v[j].w * rstd * gg.w); o8[64 * j] = w; }
}
__device__ __forceinline__ float bf_lo(unsigned w) { return __uint_as_float(w << 16); }
__device__ __forceinline__ float bf_hi(unsigned w) { return __uint_as_float(w & 0xffff0000u); }

__global__ void __launch_bounds__(NWAVES * 64, 2) fwd_kernel(Args args) {
    extern __shared__ __attribute__((aligned(16))) unsigned char lds_raw[];
    LAS unsigned char* lds = (LAS unsigned char*)lds_raw;
    volatile LAS unsigned* MISC = (volatile LAS unsigned*)(lds + MISC_OFF);
    const int tid = threadIdx.x, lane = tid & 63, wave = __builtin_amdgcn_readfirstlane(tid >> 6);
    const int G = gridDim.x; const int bx = blockIdx.x; const int vcu = (G % 8 == 0) ? (bx % 8) * (G / 8) + bx / 8 : bx;
    unsigned char* ws = args.ws; float* out = args.out;
    gu32* ctl = (gu32*)(ws + WS_CTL);
    const float* x_prompt = args.in[0]; const float* x_sample = args.in[1];
    const float* cache_fk = args.in[2]; const float* cache_fv = args.in[3]; const float* cache_fl = args.in[4]; const float* cache_sk = args.in[5]; const float* cache_sv = args.in[6];
    const float* g_attn = args.in[7]; const float* w_in = args.in[8]; const float* b_forget = args.in[9]; const float* g_of = args.in[10]; const float* g_os = args.in[11];
    const float* w_out = args.in[12]; const float* g_ffn = args.in[13]; const float* w_gate = args.in[14]; const float* w_up = args.in[15]; const float* w_down = args.in[16]; const float* g_final = args.in[17];
    bf16* Win_t = (bf16*)(ws + WS_WIN); bf16* Wout_t = (bf16*)(ws + WS_WOUT); bf16* Wgu_t = (bf16*)(ws + WS_WGU); bf16* Wdn_t = (bf16*)(ws + WS_WDN);
    bf16* XN = (bf16*)(ws + WS_XN); bf16* QO = (bf16*)(ws + WS_QO); bf16* KVB = (bf16*)(ws + WS_KV); bf16* ACT = (bf16*)(ws + WS_ACT); float* PART = (float*)(ws + WS_PART);

    for (int u = tid; u < (LDS_BYTES - LDSCTL_OFF) / 4; u += NWAVES * 64) ((LAS unsigned*)(lds + LDSCTL_OFF))[u] = 0u;
    __syncthreads();
    XcdBarrier bar; bar.bar = (unsigned*)(ctl + CW_BAR); bar.x = 0; bar.st = nullptr;
    if (MK_N_LAUNCHES == 1) bar = xcd_barrier_post((unsigned*)(ctl + CW_BAR), MISC + 8);
    const int lo = args.ph_lo, hi_ph = args.ph_hi;
#ifndef PH_MASK
#define PH_MASK 0x1ff
#endif
#define IN(k) (((PH_MASK >> (k)) & 1) && lo <= (k) && (k) < hi_ph)
#define BOTH(k) (IN(k) && IN((k) + 1))
#define GRID_BAR() do { if (MK_N_LAUNCHES == 1) xcd_barrier(bar); } while (0)
    const int gw = vcu * NWAVES + wave, NGW = G * NWAVES;

    if (IN(0)) {
        LAS float* scr = (LAS float*)(lds + RING_OFF + wave * 16384);
        constexpr int KB4 = DM / 64;
        constexpr int I_INA = KB4 * (3 * WG / 32), I_INB = I_INA, I_FL = KB4, I_OUT = KB4 * (DM / 32), I_G = KB4 * (DFF / 32), I_U = I_G, I_D = (DFF / 64) * (DM / 32);
        constexpr int NITEMS = I_INA + I_INB + I_FL + I_OUT + I_G + I_U + I_D;
#define TR_DECODE(it_, W_, ksc_, WT_, ldw_, K_, k0_, n0_, nc_, dr_) do { int r_ = (it_); ksc_ = nullptr; nc_ = 32; ldw_ = DIN; K_ = DM; W_ = w_in; WT_ = Win_t; \
            if (r_ < I_INA) { const int kb = r_ / 192, nb = r_ % 192; k0_ = 64 * kb; n0_ = 32 * nb; dr_ = 32 * nb; } \
            else if ((r_ -= I_INA) < I_INB) { const int kb = r_ / 192, nb = r_ % 192; k0_ = 64 * kb; n0_ = 3 * WG + NHG + 32 * nb; dr_ = 3 * WG + 32 * nb; } \
            else if ((r_ -= I_INB) < I_FL) { k0_ = 64 * r_; n0_ = 3 * WG; nc_ = 16; dr_ = 6 * WG; } \
            else if ((r_ -= I_FL) < I_OUT) { const int kb = r_ / 128, nb = r_ % 128; W_ = w_out; ldw_ = DM; WT_ = Wout_t; k0_ = 64 * kb; n0_ = 32 * nb; dr_ = 32 * nb; } \
            else if ((r_ -= I_OUT) < I_G) { const int kb = r_ / 344, nb = r_ % 344; W_ = w_gate; ldw_ = DFF; WT_ = Wgu_t; ksc_ = g_ffn; k0_ = 64 * kb; n0_ = 32 * nb; dr_ = (n0_ >> 7) * 256 + (n0_ & 127); } \
            else if ((r_ -= I_G) < I_U) { const int kb = r_ / 344, nb = r_ % 344; W_ = w_up; ldw_ = DFF; WT_ = Wgu_t; ksc_ = g_ffn; k0_ = 64 * kb; n0_ = 32 * nb; dr_ = (n0_ >> 7) * 256 + 128 + (n0_ & 127); } \
            else { r_ -= I_U; const int kb = r_ / 128, nb = r_ % 128; W_ = w_down; ldw_ = DM; K_ = DFF; WT_ = Wdn_t; k0_ = 64 * kb; n0_ = 32 * nb; dr_ = 32 * nb; } } while (0)
        if (gw < NITEMS) {
            const float* W; const float* ksc; bf16* WT; int ldw, K, k0, n0, nc, dr;
            f32x4 ra[8], rb[8];
            int it = gw;
            TR_DECODE(it, W, ksc, WT, ldw, K, k0, n0, nc, dr);
            tr_load(ra, W, ldw, k0, n0, lane);
            for (;;) {
                const int itn = it + NGW; const bool more = itn < NITEMS;
                const float* W2 = W; const float* ksc2 = ksc; bf16* WT2 = WT; int ldw2 = ldw, K2 = K, k02 = k0, n02 = n0, nc2 = nc, dr2 = dr;
                if (more) { TR_DECODE(itn, W2, ksc2, WT2, ldw2, K2, k02, n02, nc2, dr2); tr_load(rb, W2, ldw2, k02, n02, lane); }
                tr_proc(ra, ksc, K, k0, nc, WT, dr, scr, lane);
                if (!more) break;
#pragma unroll
                for (int j = 0; j < 8; ++j) ra[j] = rb[j];
                W = W2; ksc = ksc2; WT = WT2; ldw = ldw2; K = K2; k0 = k02; n0 = n02; nc = nc2; dr = dr2; it = itn;
            }
        }
#undef TR_DECODE
        for (int i = gw * 64 + lane; i < 240 * DM / 8; i += NGW * 64) *(v4u*)(Win_t + (size_t)(6 * WG + 16) * DM + (size_t)i * 8) = (v4u){0u, 0u, 0u, 0u};
        for (int m = gw; m < MT; m += NGW) rms_row_bf16(m < MP ? x_prompt + (size_t)m * DM : x_sample + (size_t)(m - MP) * DM, g_attn, XN + (size_t)m * DM, lane);
        if (BOTH(0)) GRID_BAR();
    }

    if (IN(1)) {
        pg8::Gemm g{XN, Win_t, MT, NIN, DM}; pg8::StaticOrder S; S.init(MT, NIN, DM, G, bx);
        pg8::EpiIn E{QO, KVB, out, b_forget};
        pg8::gemm_phase<pg8::EpiIn, pg8::StaticOrder, true, true>(lds + RING_OFF, g, S, E);
        if (BOTH(1)) GRID_BAR();
    }

    if (IN(2)) {
        LAS float* U = (LAS float*)(lds + att::OFF_U); LAS float* scn = (LAS float*)(lds + att::OFF_SCAN);
        constexpr int N_ITEMS = 512 + 512 + 256 + 256;
        for (int it = vcu; it < N_ITEMS; it += G) {
            if (it < 1024) {
                const int mode = it >> 9, r = it & 511, bh = r >> 2, pi = r & 3, b = bh >> 4, h = bh & 15;
                const bf16* Kp = KVB + (size_t)(mode * 2) * (KV_STRIDE / 2) + (size_t)(b * SEQ) * WG + h * HD;
                const bf16* Vp = Kp + (KV_STRIDE / 2);
                bf16* Qp = QO + (size_t)(b * SEQ) * DM + mode * WG + h * HD;
                if (mode == 0) {
                    const float* lf = out + O_PFL + (size_t)(b * SEQ) * NHG + h;
                    att::scan_u(U, scn, SEQ, [&](int t) { return lf[(size_t)t * NHG]; });
                }
#pragma unroll 1
                for (int pass = 0; pass < 2; ++pass) { const int qb = pass ? 7 - pi : pi; bf16* Qb = Qp + (size_t)(qb * 256) * DM;
#ifndef NO_A0
                    if (mode == 0) att::attn_unit<0, false>(lds + RING_OFF, Qb, Kp, Vp, Qb, qb * 256, nullptr, nullptr, nullptr, nullptr);
#endif
#ifndef NO_A1
                    if (mode == 1) att::attn_unit<1, false>(lds + RING_OFF, Qb, Kp, Vp, Qb, qb * 256, nullptr, nullptr, nullptr, nullptr);
#endif
                }
            } else {
                const int r = it - 1024, mode = r >> 8, bh = r & 255, b = bh >> 4, h = bh & 15;
                bf16* Qb = QO + (size_t)(MP + b * DS) * DM + mode * WG + h * HD;
                const float* Kc = (mode ? cache_sk : cache_fk) + (size_t)(b * PAST) * WG + h * HD; const float* Vc = (mode ? cache_sv : cache_fv) + (size_t)(b * PAST) * WG + h * HD;
                const float* Kn = out + (mode ? O_SSK : O_SFK) + (size_t)(b * DS) * WG + h * HD; const float* Vn = out + (mode ? O_SSV : O_SFV) + (size_t)(b * DS) * WG + h * HD;
                if (mode == 0) {
                    const float* lfc = cache_fl + (size_t)(b * PAST) * NHG + h; const float* lfn = out + O_SFL + (size_t)(b * DS) * NHG + h;
                    att::scan_u(U, scn, TKS, [&](int t) { return t < PAST ? lfc[(size_t)t * NHG] : lfn[(size_t)(t - PAST) * NHG]; });
#ifndef NO_A2
                    att::attn_unit<0, true>(lds + RING_OFF, Qb, nullptr, nullptr, Qb, PAST, Kc, Vc, Kn, Vn);
#endif
                } else {
#ifndef NO_A3
                    att::attn_unit<1, true>(lds + RING_OFF, Qb, nullptr, nullptr, Qb, PAST, Kc, Vc, Kn, Vn);
#endif
                }
            }
        }
        if (BOTH(2)) GRID_BAR();
    }

    if (IN(3)) {
        for (int m = gw; m < MT; m += NGW) { v4u* row = (v4u*)(QO + (size_t)m * DM) + lane;
            v4u v[8]; float sf = 0.f, ss = 0.f;
#pragma unroll
            for (int j = 0; j < 8; ++j) { v[j] = row[64 * j]; float s = 0.f;
#pragma unroll
                for (int e = 0; e < 4; ++e) { const float a = bf_lo(v[j][e]), b = bf_hi(v[j][e]); s += a * a + b * b; }
                if (j < 4) sf += s; else ss += s; }
            const float rf = rsqrtf(wave_sum(sf) * (1.f / WG) + EPS), rs = rsqrtf(wave_sum(ss) * (1.f / WG) + EPS);
#pragma unroll
            for (int j = 0; j < 8; ++j) { const float rr = j < 4 ? rf : rs; const float* gp = (j < 4 ? g_of : g_os) + (lane + 64 * (j & 3)) * 8;
                const f32x4 g0 = *(const f32x4*)gp, g1 = *(const f32x4*)(gp + 4); v4u w;
                w.x = cvt_pk_bf16(bf_lo(v[j].x) * rr * g0.x, bf_hi(v[j].x) * rr * g0.y); w.y = cvt_pk_bf16(bf_lo(v[j].y) * rr * g0.z, bf_hi(v[j].y) * rr * g0.w);
                w.z = cvt_pk_bf16(bf_lo(v[j].z) * rr * g1.x, bf_hi(v[j].z) * rr * g1.y); w.w = cvt_pk_bf16(bf_lo(v[j].w) * rr * g1.z, bf_hi(v[j].w) * rr * g1.w);
                row[64 * j] = w; } }
        if (BOTH(3)) GRID_BAR();
    }

    float* SSQ = (float*)(ctl + CW_SSQ);
    if (IN(4)) {
        pg8::Gemm g{QO, Wout_t, MT, DM, DM}; pg8::StaticOrder S; S.init(MT, DM, DM, G, bx);
        pg8::EpiX2 E{x_prompt, x_sample, XN, SSQ};
        pg8::gemm_phase<pg8::EpiX2, pg8::StaticOrder, true, true>(lds + RING_OFF, g, S, E);
        if (BOTH(4)) GRID_BAR();
    }

    if (IN(6)) {
#ifndef PROBE_REP6
#define PROBE_REP6 1
#endif
#pragma unroll 1
        for (int rep = 0; rep < PROBE_REP6; ++rep) {
        pg8::Gemm g{XN, Wgu_t, MT, 2 * DFF, DM}; pg8::StaticOrder S; S.init(MT, 2 * DFF, DM, G, bx);
        pg8::EpiGlu E{ACT, SSQ};
        pg8::gemm_phase<pg8::EpiGlu, pg8::StaticOrder, true, true>(lds + RING_OFF, g, S, E);
        if (BOTH(6)) GRID_BAR();
        }
    }

    if (IN(7)) {
        pg8::Gemm g{ACT, Wdn_t, MT, DM, DFF}; pg8::DownOrder S; S.init(MP, DM, DFF, G, bx);
        pg8::EpiDown E{XN, out, PART};
        pg8::gemm_phase<pg8::EpiDown, pg8::DownOrder, true, true>(lds + RING_OFF, g, S, E);
        if (BOTH(7)) GRID_BAR();
    }

    if (IN(8)) {
        for (int m = gw; m < MT; m += NGW) { f32x4* xr = (f32x4*)(out + (size_t)m * DM) + lane; const f32x4* gr = (const f32x4*)g_final + lane;
            f32x4 v[16]; float s = 0.f;
            if (m >= MP && G == 256) {
                const v2u* x2r = (const v2u*)(XN + (size_t)m * DM) + lane;
#pragma unroll
                for (int j = 0; j < 16; ++j) { const v2u x = x2r[64 * j]; v[j] = (f32x4){bf_lo(x.x), bf_hi(x.x), bf_lo(x.y), bf_hi(x.y)}; }
#pragma unroll 1
                for (int ks = 0; ks < 8; ++ks) { const f32x4* pr = (const f32x4*)(PART + (size_t)ks * ((size_t)MS * DM) + (size_t)(m - MP) * DM) + lane;
#pragma unroll
                    for (int j = 0; j < 16; ++j) v[j] += pr[64 * j]; }
            } else {
#pragma unroll
                for (int j = 0; j < 16; ++j) v[j] = xr[64 * j];
            }
#pragma unroll
            for (int j = 0; j < 16; ++j) s += (v[j].x * v[j].x + v[j].y * v[j].y) + (v[j].z * v[j].z + v[j].w * v[j].w);
            const float rstd = rsqrtf(wave_sum(s) * (1.f / DM) + EPS);
#pragma unroll
            for (int j = 0; j < 16; ++j) { const f32x4 gg = gr[64 * j]; xr[64 * j] = v[j] * rstd * gg; } }
    }
#undef IN
#undef BOTH
#undef GRID_BAR
}

extern "C" void kernel_launch(void* const* d_in, const int* in_sizes, int n_in, void* d_out, int out_size, void* d_ws, size_t ws_size, hipStream_t stream) {
    static int grid = 0;
    if (grid == 0) {
        if (n_in != 18 || (size_t)out_size != O_END || ws_size < WS_END) { fprintf(stderr, "kernel_launch: unexpected shapes (n_in %d, out %d, ws %zu)\n", n_in, out_size, ws_size); grid = -1; return; }
        int dev = 0, cus = 0;
        if (hipGetDevice(&dev) != hipSuccess || hipDeviceGetAttribute(&cus, hipDeviceAttributeMultiprocessorCount, dev) != hipSuccess) { grid = -1; return; }
        if (hipFuncSetAttribute((const void*)fwd_kernel, hipFuncAttributeMaxDynamicSharedMemorySize, LDS_BYTES) != hipSuccess) { fprintf(stderr, "kernel_launch: hipFuncSetAttribute failed\n"); grid = -1; return; }
        int per_cu = 0;
        if (hipOccupancyMaxActiveBlocksPerMultiprocessor(&per_cu, (const void*)fwd_kernel, NWAVES * 64, LDS_BYTES) != hipSuccess || per_cu < 1) fprintf(stderr, "kernel_launch: occupancy query says %d\n", per_cu);
        (void)hipGetLastError();
        grid = cus;
    }
    if (grid < 0) return;
    (void)hipMemsetAsync((char*)d_ws + WS_CTL, 0, CTL_ZERO_BYTES, stream);
    Args a{};
    for (int i = 0; i < 18; ++i) a.in[i] = (const float*)d_in[i];
    a.out = (float*)d_out; a.ws = (unsigned char*)d_ws;
#if MK_N_LAUNCHES == 1
    a.ph_lo = 0; a.ph_hi = 9;
    hipLaunchKernelGGL(fwd_kernel, dim3(grid), dim3(NWAVES * 64), LDS_BYTES, stream, a);
#else
    for (int p = 0; p < 9; ++p) { a.ph_lo = p; a.ph_hi = p + 1; hipLaunchKernelGGL(fwd_kernel, dim3(grid), dim3(NWAVES * 64), LDS_BYTES, stream, a); }
#endif
}
```

```cpp
#include <hip/hip_runtime.h>
#include <cstdio>
#include <cstdint>

#ifndef MK_N_LAUNCHES
#define MK_N_LAUNCHES 1
#endif

#define GAS __attribute__((address_space(1)))
#define LAS __attribute__((address_space(3)))
typedef unsigned short bf16;
typedef unsigned v4u __attribute__((ext_vector_type(4)));
typedef unsigned v2u __attribute__((ext_vector_type(2)));
typedef float f32x4 __attribute__((ext_vector_type(4)));
typedef float f32x16 __attribute__((ext_vector_type(16)));
typedef short bf16x8 __attribute__((ext_vector_type(8)));
typedef short s16x4 __attribute__((ext_vector_type(4)));
typedef int i32x4 __attribute__((ext_vector_type(4)));
typedef GAS unsigned gu32;

constexpr int DM = 4096, NB = 8, SEQ = 2048, DB = 16, DS = 32, PAST = 1024, HD = 128, NHG = 16;
constexpr int WG = NHG * HD;
constexpr int DFF = 11008;
constexpr int MP = NB * SEQ, MS = DB * DS, MT = MP + MS;
constexpr int DIN = 3 * WG + NHG + 3 * WG;
constexpr int NIN = 6 * WG + 256;
constexpr int TKS = PAST + DS;
constexpr int KVROWS = MP + DB * TKS;
constexpr float EPS = 1e-6f;
constexpr float LOG2E = 1.4426950408889634f;
constexpr float QSCALE = 0.08838834764831845f * LOG2E;

constexpr size_t O_YP = 0, O_YS = O_YP + (size_t)MP * DM;
constexpr size_t O_PFK = O_YS + (size_t)MS * DM, O_PFV = O_PFK + (size_t)MP * WG, O_PFL = O_PFV + (size_t)MP * WG;
constexpr size_t O_PSK = O_PFL + (size_t)MP * NHG, O_PSV = O_PSK + (size_t)MP * WG;
constexpr size_t O_SFK = O_PSV + (size_t)MP * WG, O_SFV = O_SFK + (size_t)MS * WG, O_SFL = O_SFV + (size_t)MS * WG;
constexpr size_t O_SSK = O_SFL + (size_t)MS * NHG, O_SSV = O_SSK + (size_t)MS * WG, O_END = O_SSV + (size_t)MS * WG;

constexpr size_t MiB = 1u << 20;
constexpr size_t WS_CTL = 0, CTL_ZERO_BYTES = 2 * MiB;
constexpr size_t WS_WIN = 2 * MiB;
constexpr size_t WS_WOUT = 100 * MiB;
constexpr size_t WS_WGU = 132 * MiB;
constexpr size_t WS_WDN = 304 * MiB;
constexpr size_t WS_XN = 390 * MiB;
constexpr size_t WS_QO = 522 * MiB;
constexpr size_t WS_KV = 654 * MiB, KV_STRIDE = 130 * MiB;
constexpr size_t WS_ACT = 654 * MiB;
constexpr size_t WS_PART = 1174 * MiB;
constexpr size_t WS_XQ = 1238 * MiB;
constexpr size_t WS_ACTQ = 1304 * MiB;
constexpr size_t WS_END = 1482 * MiB;
static_assert((size_t)NIN * DM * 2 == 98 * MiB && (size_t)2 * DFF * DM * 2 == 172 * MiB && (size_t)DM * DFF * 2 == 86 * MiB && (size_t)MT * DM * 2 == 132 * MiB && (size_t)KVROWS * WG * 2 == KV_STRIDE, "ws map");
static_assert(WS_ACT + (size_t)MT * DFF * 2 <= WS_PART && WS_KV + 4 * KV_STRIDE == WS_PART && WS_PART + (size_t)8 * MS * DM * 4 == WS_XQ && WS_XQ + (size_t)MT * DM == WS_ACTQ && WS_ACTQ + (size_t)MT * DFF <= WS_END, "ws map");
constexpr int CW_TMO = 0, CW_CODE = 1, CW_BAR = 4096, CW_SSQ = 16384, CW_SSQ_DUMMY = 40960, CW_SSQ3 = 65536, CW_CNT7 = 163840, CW_OSQ = 180224, CW_SSQ0 = 229376, CW_CMAX = 262144, CW_AMAX = 294912, CW_AMAX2 = 311808, CW_CMAXD = 328704;
static_assert(CW_SSQ0 + MT <= CW_CMAX && CW_CMAX + 2 * DFF <= CW_AMAX && CW_AMAX + MT <= CW_AMAX2 && CW_AMAX2 + MT <= CW_CMAXD && (size_t)(CW_CMAXD + DM) * 4 <= CTL_ZERO_BYTES, "ctl");
static_assert(CW_CNT7 + 64 * 64 <= CW_OSQ && CW_OSQ + 2 * MT <= CW_SSQ0 && (CW_SSQ0 + MT) * 4 <= (int)CTL_ZERO_BYTES, "ctl");
static_assert(CW_SSQ_DUMMY + MT <= CW_SSQ3 && CW_SSQ3 + MP <= CW_CNT7 && (CW_CNT7 + 64 * 64) * 4 <= (int)CTL_ZERO_BYTES, "ctl");
static_assert((CW_SSQ + MT) * 4 <= (int)CTL_ZERO_BYTES, "ctl");

constexpr int NWAVES = 8;
constexpr int RING_OFF = 0, RING_BYTES = 131072;
static_assert(78848 + 8 * 8192 >= RING_BYTES && 78848 + 8 * 8192 + 448 <= 147456, "LDS map");
constexpr int BG_OFF = 78848, BG_BYTES = 8192;
constexpr int LDSCTL_OFF = BG_OFF + NWAVES * BG_BYTES, MISC_OFF = LDSCTL_OFF + 320;
constexpr int LDS_BYTES = 147456;

#define RLX_AGENT __ATOMIC_RELAXED, __HIP_MEMORY_SCOPE_AGENT
#define LDS_WAIT() asm volatile("s_waitcnt lgkmcnt(0)" ::: "memory")
#define VM_WAIT() asm volatile("s_waitcnt vmcnt(0)" ::: "memory")

__device__ __forceinline__ unsigned cvt_pk_bf16(float lo, float hi) { unsigned r; asm volatile("v_cvt_pk_bf16_f32 %0, %1, %2" : "=v"(r) : "v"(lo), "v"(hi)); return r; }

namespace pg8 {
#define PG8_LAS __attribute__((address_space(3)))
typedef unsigned short bf16_t;
constexpr int BM = 256, BK = 64, HALF = 128, HTB = HALF * BK * 2, STAGE_BYTES = 8 * HTB, NXCD = 8, WGM = 8;
__host__ __device__ __forceinline__ int lds_byte(int r, int c) { const int st = (r >> 4) * 2 + (c >> 5), rr = r & 15, cc = c & 31, ob = rr * 64 + cc * 2; return st * 1024 + (ob ^ (((ob >> 9) & 1) << 5)); }
__host__ __device__ __forceinline__ void stage_rc(int b, int& R, int& C) { const int st = b / 1024, sb = b % 1024, swz = sb ^ (((sb >> 9) & 1) << 5); R = (st >> 1) * 16 + swz / 64; C = (st & 1) * 32 + (swz % 64) / 2; }
__host__ __device__ __forceinline__ int perm32(int rho) { const int n = rho >> 4, i = rho & 15; return 8 * (i >> 2) + 4 * n + (i & 3); }
struct Unit { int pm, pn, kt0, nkt, ks; };
struct Gemm { const bf16_t* A; const bf16_t* Bt; int M, N, K; };
struct StaticOrder {
    int nM, nN, nwg, G, c, nkt_full;
    __host__ __device__ void init(int M, int N, int K, int G_, int c_) { nM = M / BM; nN = N / BM; nwg = nM * nN; G = G_; c = c_; nkt_full = K / BK; }
    __host__ __device__ __forceinline__ void decode(int L, int& pm, int& pn) const {
        int wgid = L; { const int q = nwg / NXCD, r = nwg % NXCD, xcd = wgid % NXCD, off = wgid / NXCD; wgid = (xcd < r ? xcd * (q + 1) : r * (q + 1) + (xcd - r) * q) + off; }
        const int nig = WGM * nN, gid = wgid / nig, fm = gid * WGM, gsz = (nM - fm) < WGM ? (nM - fm) : WGM;
        pm = fm + ((wgid % nig) % gsz); pn = (wgid % nig) / gsz;
    }
    __host__ __device__ __forceinline__ bool next(int i, Unit& u) const {
        const long L = (long)i * G + c; if (L >= nwg) return false;
        int pm, pn; decode((int)L, pm, pn);
        u.pm = pm; u.pn = pn; u.kt0 = 0; u.nkt = nkt_full; u.ks = -1; return true;
    }
    __device__ __forceinline__ void a_ready(const Unit&) const {}
    __device__ __forceinline__ void done(const Unit&) const {}
};
template <int A, int B, int C> struct TailSplitOrder : StaticOrder {
    __device__ __forceinline__ bool next(int i, Unit& u) const {
        const long L = (long)i * G + c; const bool g256 = (G == 256);
        if (g256 ? (i > 4) : (L >= nwg + 32)) return false;
        const bool stat = g256 ? (i < 4) : (L < nwg), spl = g256 && i == 4;
        const int tile = g256 ? (c >> 3) : (int)(L - nwg), ks = c & 7;
        int pm, pn; decode(stat ? (int)L : 0, pm, pn);
        u.pm = stat ? pm : MP / BM + (tile >> 4); u.pn = stat ? pn : (tile & 15);
        u.ks = spl ? ks : -1; u.kt0 = spl ? (ks < C ? A * ks : A * C + B * (ks - C)) : 0; u.nkt = spl ? (ks < C ? A : B) : nkt_full;
        return true;
    }
};
typedef TailSplitOrder<22, 20, 6> DownOrder;
typedef TailSplitOrder<8, 8, 8> OutOrder;
static_assert(6 * 22 + 2 * 20 == DFF / 64 && 8 * 8 == DM / 64, "K splits");
template <bool I8> struct AccSel { typedef f32x4 T; }; template <> struct AccSel<true> { typedef i32x4 T; };
template <class Epi, class Sched, bool ALIGN_EPI = false, bool SP2 = false, bool MIDK = false, bool I8 = false>
__device__ __forceinline__ void gemm_phase(PG8_LAS unsigned char* lds, const Gemm g, const Sched& S, const Epi& E) {
    const int tid = threadIdx.x, wid = __builtin_amdgcn_readfirstlane(tid >> 6), lane = tid & 63, wr = wid >> 2, wc = wid & 3, fr = lane & 15, fq = lane >> 4;
    const int K = g.K;
    unsigned voffA[2], voffB[2];
#pragma unroll
    for (int i = 0; i < 2; ++i) { int R, C; stage_rc(tid * 16 + i * 8192, R, C); const int Rb = Epi::PERM ? ((R & ~31) + perm32(R & 31)) : R;
        voffA[i] = (unsigned)(R * K + C) * 2u; voffB[i] = (unsigned)(Rb * K + C) * 2u; }
    const size_t kstep = (size_t)(BK * 2);
    const size_t hstep = (size_t)HALF * K * 2;
    const size_t tstep = 2 * hstep;
    const unsigned ldsw = (unsigned)wid * 1024u;
    const int aoff = lds_byte(wr * 64 + fr, fq * 8), boff = lds_byte(wc * 32 + fr, fq * 8);
#define PG8_SA(b, h) (((b) * 2 + (h)) * HTB)
#define PG8_SB(b, h) ((4 + (b) * 2 + (h)) * HTB)
#define PG8_STAGE(bufoff, gbase, voff) do { _Pragma("unroll") for (int _i = 0; _i < 2; ++_i) \
        __builtin_amdgcn_global_load_lds((const unsigned*)((const char*)(gbase) + (voff)[_i]), (PG8_LAS unsigned*)(lds + (bufoff) + ldsw + _i * 8192), 16, 0, 0); } while (0)
#define PG8_LDA(dst, b, h) do { _Pragma("unroll") for (int m = 0; m < 4; ++m) _Pragma("unroll") for (int k = 0; k < 2; ++k) dst[m][k] = *(const PG8_LAS bf16x8*)(lds + PG8_SA(b, h) + aoff + m * 2048 + k * 1024); } while (0)
#define PG8_LDB(dst, b, h) do { _Pragma("unroll") for (int n = 0; n < 2; ++n) _Pragma("unroll") for (int k = 0; k < 2; ++k) dst[n][k] = *(const PG8_LAS bf16x8*)(lds + PG8_SB(b, h) + boff + n * 2048 + k * 1024); } while (0)
#define PG8_MMA(ai, bj, At, Bt) do { __builtin_amdgcn_s_setprio(1); _Pragma("unroll") for (int m = 0; m < 4; ++m) _Pragma("unroll") for (int n = 0; n < 2; ++n) _Pragma("unroll") for (int k = 0; k < 2; ++k) \
        { if constexpr (I8) acc[ai][bj][m][n] = __builtin_amdgcn_mfma_i32_16x16x64_i8(__builtin_bit_cast(i32x4, Bt[n][k]), __builtin_bit_cast(i32x4, At[m][k]), acc[ai][bj][m][n], 0, 0, 0); \
          else acc[ai][bj][m][n] = __builtin_amdgcn_mfma_f32_16x16x32_bf16(Bt[n][k], At[m][k], acc[ai][bj][m][n], 0, 0, 0); } __builtin_amdgcn_s_setprio(0); } while (0)
#define PG8_WAIT_V(n) asm volatile("s_waitcnt vmcnt(" #n ")" ::: "memory")
#define PG8_WAIT_L(n) asm volatile("s_waitcnt lgkmcnt(" #n ")" ::: "memory")
#define PG8_BAR __builtin_amdgcn_s_barrier()
#define PG8_SCHED __builtin_amdgcn_sched_barrier(0)
    Unit cur, nxt; int ui = 0;
    if (!S.next(0, cur)) return;
    typedef typename AccSel<I8>::T acc_t; const acc_t acc_zero = {};
    acc_t acc[2][2][4][2];
#pragma unroll
    for (int a = 0; a < 2; ++a)
#pragma unroll
        for (int b = 0; b < 2; ++b)
#pragma unroll
            for (int m = 0; m < 4; ++m)
#pragma unroll
                for (int n = 0; n < 2; ++n) acc[a][b][m][n] = acc_zero;
    bf16x8 At[4][2], B0[2][2], B1[2][2];
    const char* cA = (const char*)g.A + (size_t)cur.pm * tstep + (size_t)cur.kt0 * kstep; const char* cB = (const char*)g.Bt + (size_t)cur.pn * tstep + (size_t)cur.kt0 * kstep;
    S.a_ready(cur);
    if constexpr (SP2) {
        PG8_STAGE(PG8_SB(0, 0), cB, voffB); PG8_STAGE(PG8_SB(0, 1), cB + hstep, voffB); PG8_STAGE(PG8_SA(0, 0), cA, voffA); PG8_STAGE(PG8_SA(0, 1), cA + hstep, voffA);
        if (wr == 1) PG8_BAR;
        PG8_WAIT_V(2); PG8_BAR;
        PG8_STAGE(PG8_SB(1, 0), cB + kstep, voffB); PG8_STAGE(PG8_SA(1, 0), cA + kstep, voffA); PG8_STAGE(PG8_SB(1, 1), cB + hstep + kstep, voffB);
        PG8_WAIT_V(6); PG8_BAR;
    } else {
        PG8_STAGE(PG8_SB(0, 0), cB, voffB); PG8_STAGE(PG8_SA(0, 0), cA, voffA); PG8_STAGE(PG8_SB(0, 1), cB + hstep, voffB); PG8_STAGE(PG8_SA(0, 1), cA + hstep, voffA);
        if (wr == 1) PG8_BAR;
        PG8_WAIT_V(4); PG8_BAR;
        PG8_STAGE(PG8_SB(1, 0), cB + kstep, voffB); PG8_STAGE(PG8_SA(1, 0), cA + kstep, voffA); PG8_STAGE(PG8_SB(1, 1), cB + hstep + kstep, voffB);
        PG8_WAIT_V(6); PG8_BAR;
    }
    for (;;) {
        const bool has_next = S.next(ui + 1, nxt);
        const char* nA = has_next ? (const char*)g.A + (size_t)nxt.pm * tstep + (size_t)nxt.kt0 * kstep : cA; const char* nB = has_next ? (const char*)g.Bt + (size_t)nxt.pn * tstep + (size_t)nxt.kt0 * kstep : cB;
        const int nt = cur.nkt;
        for (int t = 0; t < nt; t += 2) {
            const bool last = (t == nt - 2);
            const char* a1 = cA + (size_t)(t + 1) * kstep;
            const char* a2 = last ? nA : cA + (size_t)(t + 2) * kstep; const char* b2 = last ? nB : cB + (size_t)(t + 2) * kstep;
            const char* a3 = a2 + kstep; const char* b3 = b2 + kstep;
            if (last && has_next) S.a_ready(nxt);
            if constexpr (MIDK) { if (t == (nt >> 1) && cur.ks < 0) E.midk(acc, cur, wr, wc, fr, fq); }
            if constexpr (SP2) {
            PG8_LDB(B0, 0, 0); PG8_LDB(B1, 0, 1); PG8_SCHED; PG8_LDA(At, 0, 0); PG8_STAGE(PG8_SA(1, 1), a1 + hstep, voffA);
            PG8_WAIT_V(8); PG8_WAIT_L(0); PG8_BAR; PG8_MMA(0, 0, At, B0); PG8_MMA(0, 1, At, B1); PG8_BAR; PG8_SCHED;
            PG8_LDA(At, 0, 1); PG8_STAGE(PG8_SB(0, 0), b2, voffB); PG8_STAGE(PG8_SB(0, 1), b2 + hstep, voffB); PG8_STAGE(PG8_SA(0, 0), a2, voffA);
            PG8_WAIT_V(8); PG8_WAIT_L(0); PG8_BAR; PG8_MMA(1, 0, At, B0); PG8_MMA(1, 1, At, B1); PG8_BAR; PG8_SCHED;
            PG8_LDB(B0, 1, 0); PG8_LDB(B1, 1, 1); PG8_SCHED; PG8_LDA(At, 1, 0); PG8_STAGE(PG8_SA(0, 1), a2 + hstep, voffA);
            PG8_WAIT_V(8); PG8_WAIT_L(0); PG8_BAR; PG8_MMA(0, 0, At, B0); PG8_MMA(0, 1, At, B1); PG8_BAR; PG8_SCHED;
            PG8_LDA(At, 1, 1); PG8_STAGE(PG8_SB(1, 0), b3, voffB); PG8_STAGE(PG8_SB(1, 1), b3 + hstep, voffB); PG8_STAGE(PG8_SA(1, 0), a3, voffA);
            PG8_WAIT_V(8); PG8_WAIT_L(0); PG8_BAR; PG8_MMA(1, 0, At, B0); PG8_MMA(1, 1, At, B1); PG8_BAR; PG8_SCHED;
            } else {
            PG8_LDB(B0, 0, 0); PG8_SCHED; PG8_LDA(At, 0, 0); PG8_STAGE(PG8_SA(1, 1), a1 + hstep, voffA);
            PG8_WAIT_L(8); PG8_BAR; PG8_WAIT_L(0); PG8_MMA(0, 0, At, B0); PG8_BAR; PG8_SCHED;
            PG8_LDB(B1, 0, 1); PG8_STAGE(PG8_SB(0, 0), b2, voffB);
            PG8_BAR; PG8_WAIT_L(0); PG8_MMA(0, 1, At, B1); PG8_BAR;
            PG8_LDA(At, 0, 1); PG8_STAGE(PG8_SA(0, 0), a2, voffA);
            PG8_BAR; PG8_WAIT_L(0); PG8_MMA(1, 0, At, B0); PG8_BAR; PG8_SCHED;
            PG8_STAGE(PG8_SB(0, 1), b2 + hstep, voffB);
            PG8_WAIT_V(6); PG8_BAR; PG8_MMA(1, 1, At, B1); PG8_BAR;
            PG8_LDB(B0, 1, 0); PG8_SCHED; PG8_LDA(At, 1, 0); PG8_STAGE(PG8_SA(0, 1), a2 + hstep, voffA);
            PG8_WAIT_L(8); PG8_BAR; PG8_WAIT_L(0); PG8_MMA(0, 0, At, B0); PG8_BAR; PG8_SCHED;
            PG8_LDB(B1, 1, 1); PG8_STAGE(PG8_SB(1, 0), b3, voffB);
            PG8_BAR; PG8_WAIT_L(0); PG8_MMA(0, 1, At, B1); PG8_BAR;
            PG8_LDA(At, 1, 1); PG8_STAGE(PG8_SA(1, 0), a3, voffA);
            PG8_BAR; PG8_WAIT_L(0); PG8_MMA(1, 0, At, B0); PG8_BAR; PG8_SCHED;
            PG8_STAGE(PG8_SB(1, 1), b3 + hstep, voffB);
            PG8_WAIT_V(6); PG8_BAR; PG8_MMA(1, 1, At, B1); PG8_BAR;
            }
        }
        if constexpr (ALIGN_EPI) { if (wr == 0) PG8_BAR; }
        E(acc, cur, wr, wc, fr, fq); S.done(cur);
        if (!has_next) break;
#pragma unroll
        for (int a = 0; a < 2; ++a)
#pragma unroll
            for (int b = 0; b < 2; ++b)
#pragma unroll
                for (int m = 0; m < 4; ++m)
#pragma unroll
                    for (int n = 0; n < 2; ++n) acc[a][b][m][n] = acc_zero;
        cur = nxt; cA = nA; cB = nB; ++ui;
        if constexpr (ALIGN_EPI) { if (wr == 1) PG8_BAR; }
    }
    PG8_WAIT_V(0);
    if constexpr (!ALIGN_EPI) { if (wr == 0) PG8_BAR; }
    PG8_BAR;
#undef PG8_SA
#undef PG8_SB
#undef PG8_STAGE
#undef PG8_LDA
#undef PG8_LDB
#undef PG8_MMA
#undef PG8_WAIT_V
#undef PG8_WAIT_L
#undef PG8_BAR
#undef PG8_SCHED
}

__device__ __forceinline__ float log_sigmoid_f(float x) { return -(fmaxf(-x, 0.f) + log1pf(expf(-fabsf(x)))); }
struct EpiIn {
    static constexpr bool PERM = true;
    bf16_t* QO; bf16_t* KV; float* out; const float* bfg; const float* ssq0;
    __device__ __forceinline__ void operator()(const f32x4 (&acc)[2][2][4][2], const Unit& u, int wr, int wc, int fr, int fq) const {
        const int seg = u.pn >> 3;
        const int row0 = u.pm * BM + wr * 64 + fr;
        const int cseg = (u.pn & 7) * BM + wc * 32 + 8 * fq;
        const bool prompt = u.pm < (MP / BM);
        if (seg == 6) {
            if (wc == 0 && fq < 2) {
                const f32x4 b0 = *(const f32x4*)(bfg + 8 * fq), b1 = *(const f32x4*)(bfg + 8 * fq + 4);
#pragma unroll
                for (int ai = 0; ai < 2; ++ai)
#pragma unroll
                    for (int m = 0; m < 4; ++m) { const int row = row0 + ai * HALF + m * 16; const float rstd = rsqrtf(ssq0[row] * (1.f / DM) + EPS);
                        float* dst = prompt ? out + O_PFL + (size_t)row * NHG + 8 * fq : out + O_SFL + (size_t)(row - MP) * NHG + 8 * fq;
                        const f32x4 v0 = acc[ai][0][m][0] * rstd + b0, v1 = acc[ai][0][m][1] * rstd + b1; f32x4 r0, r1;
#pragma unroll
                        for (int j = 0; j < 4; ++j) { r0[j] = log_sigmoid_f(v0[j]); r1[j] = log_sigmoid_f(v1[j]); }
                        *(f32x4*)dst = r0; *(f32x4*)(dst + 4) = r1; }
            }
        } else if (seg == 0 || seg == 3) {
            bf16_t* base = QO + (seg == 3 ? WG : 0) + cseg;
#pragma unroll
            for (int ai = 0; ai < 2; ++ai)
#pragma unroll
                for (int m = 0; m < 4; ++m) { const int row = row0 + ai * HALF + m * 16; bf16_t* rowp = base + (size_t)row * DM; const float qs = rsqrtf(ssq0[row] * (1.f / DM) + EPS) * QSCALE;
#pragma unroll
                    for (int bj = 0; bj < 2; ++bj) { const f32x4 v0 = acc[ai][bj][m][0] * qs, v1 = acc[ai][bj][m][1] * qs;
                        v4u w; w.x = cvt_pk_bf16(v0[0], v0[1]); w.y = cvt_pk_bf16(v0[2], v0[3]); w.z = cvt_pk_bf16(v1[0], v1[1]); w.w = cvt_pk_bf16(v1[2], v1[3]);
                        *(v4u*)(rowp + bj * HALF) = w; } }
        } else {
            const int kvi = (seg == 1) ? 0 : (seg == 2) ? 1 : (seg == 4) ? 2 : 3;
            bf16_t* kvb = KV + (size_t)kvi * (KV_STRIDE / 2) + cseg;
            float* ob = out + (prompt ? O_PFK + (size_t)kvi * ((size_t)MP * WG) + (kvi >= 2 ? (size_t)MP * NHG : 0)
                                      : O_SFK + (size_t)kvi * ((size_t)MS * WG) + (kvi >= 2 ? (size_t)MS * NHG : 0)) + cseg;
#pragma unroll
            for (int ai = 0; ai < 2; ++ai)
#pragma unroll
                for (int m = 0; m < 4; ++m) { const int row = row0 + ai * HALF + m * 16; const int rs = row - MP;
                    const int kvrow = prompt ? row : MP + (rs >> 5) * TKS + PAST + (rs & 31);
                    const int orow = prompt ? row : rs;
                    bf16_t* rowp = kvb + (size_t)kvrow * WG; float* op = ob + (size_t)orow * WG; const float rstd = rsqrtf(ssq0[row] * (1.f / DM) + EPS);
#pragma unroll
                    for (int bj = 0; bj < 2; ++bj) { const f32x4 v0 = acc[ai][bj][m][0] * rstd, v1 = acc[ai][bj][m][1] * rstd;
                        v4u w; w.x = cvt_pk_bf16(v0[0], v0[1]); w.y = cvt_pk_bf16(v0[2], v0[3]); w.z = cvt_pk_bf16(v1[0], v1[1]); w.w = cvt_pk_bf16(v1[2], v1[3]);
                        if (prompt) *(v4u*)(rowp + bj * HALF) = w;
                        *(f32x4*)(op + bj * HALF) = v0; *(f32x4*)(op + bj * HALF + 4) = v1; } }
        }
    }
};
struct EpiX2 {
    static constexpr bool PERM = true;
    bf16_t* X2; float* ssq; float* part; const float* osq; unsigned* amax;
    __device__ __forceinline__ void midk(f32x4 (&acc)[2][2][4][2], const Unit& u, int wr, int wc, int fr, int fq) const {
        const int row0 = u.pm * BM + wr * 64 + fr;
#pragma unroll
        for (int ai = 0; ai < 2; ++ai)
#pragma unroll
            for (int m = 0; m < 4; ++m) { const int row = row0 + ai * HALF + m * 16;
                const float a = osq[2 * row], b = osq[2 * row + 1];
                const float ratio = rsqrtf(a * (1.f / WG) + EPS) / rsqrtf(b * (1.f / WG) + EPS);
#pragma unroll
                for (int bj = 0; bj < 2; ++bj)
#pragma unroll
                    for (int n = 0; n < 2; ++n) acc[ai][bj][m][n] = acc[ai][bj][m][n] * ratio; }
    }
    __device__ __forceinline__ void operator()(const f32x4 (&acc)[2][2][4][2], const Unit& u, int wr, int wc, int fr, int fq) const {
        const int row0 = u.pm * BM + wr * 64 + fr, col0 = u.pn * BM + wc * 32 + 8 * fq;
        if (u.ks >= 0) {
            float* pb = part + (size_t)u.ks * ((size_t)MS * DM);
#pragma unroll
            for (int ai = 0; ai < 2; ++ai)
#pragma unroll
                for (int m = 0; m < 4; ++m) { float* op = pb + (size_t)(row0 + ai * HALF + m * 16 - MP) * DM + col0;
#pragma unroll
                    for (int bj = 0; bj < 2; ++bj) { *(f32x4*)(op + bj * HALF) = acc[ai][bj][m][0]; *(f32x4*)(op + bj * HALF + 4) = acc[ai][bj][m][1]; } }
            return;
        }
#pragma unroll
        for (int ai = 0; ai < 2; ++ai)
#pragma unroll
            for (int m = 0; m < 4; ++m) { const int row = row0 + ai * HALF + m * 16;
                bf16_t* op = X2 + (size_t)row * DM + col0;
                f32x4 rv[2][2];
#pragma unroll
                for (int bj = 0; bj < 2; ++bj) { const v4u x = *(const v4u*)(op + bj * HALF);
                    rv[bj][0] = (f32x4){__uint_as_float(x.x << 16), __uint_as_float(x.x & 0xffff0000u), __uint_as_float(x.y << 16), __uint_as_float(x.y & 0xffff0000u)};
                    rv[bj][1] = (f32x4){__uint_as_float(x.z << 16), __uint_as_float(x.z & 0xffff0000u), __uint_as_float(x.w << 16), __uint_as_float(x.w & 0xffff0000u)}; }
                const float rs2 = rsqrtf(osq[2 * row + 1] * (1.f / WG) + EPS);
                float s = 0.f, mx = 0.f;
#pragma unroll
                for (int bj = 0; bj < 2; ++bj) { const f32x4 v0 = acc[ai][bj][m][0] * rs2 + rv[bj][0], v1 = acc[ai][bj][m][1] * rs2 + rv[bj][1];
                    s += (v0[0] * v0[0] + v0[1] * v0[1]) + (v0[2] * v0[2] + v0[3] * v0[3]) + (v1[0] * v1[0] + v1[1] * v1[1]) + (v1[2] * v1[2] + v1[3] * v1[3]);
                    mx = fmaxf(fmaxf(fmaxf(mx, fmaxf(fabsf(v0[0]), fabsf(v0[1]))), fmaxf(fabsf(v0[2]), fabsf(v0[3]))), fmaxf(fmaxf(fabsf(v1[0]), fabsf(v1[1])), fmaxf(fabsf(v1[2]), fabsf(v1[3]))));
                    v4u w; w.x = cvt_pk_bf16(v0[0], v0[1]); w.y = cvt_pk_bf16(v0[2], v0[3]); w.z = cvt_pk_bf16(v1[0], v1[1]); w.w = cvt_pk_bf16(v1[2], v1[3]);
                    *(v4u*)(op + bj * HALF) = w; }
                s += __shfl_xor(s, 16); s += __shfl_xor(s, 32); mx = fmaxf(mx, __shfl_xor(mx, 16)); mx = fmaxf(mx, __shfl_xor(mx, 32));
                if (fq == 0) { __hip_atomic_fetch_add(ssq + row, s, __ATOMIC_RELAXED, __HIP_MEMORY_SCOPE_AGENT);
                               __hip_atomic_fetch_max(amax + row, __float_as_uint(mx), __ATOMIC_RELAXED, __HIP_MEMORY_SCOPE_AGENT); } }
    }
};
struct EpiDown {
    static constexpr bool PERM = true;
    const bf16_t* X2; float* out; float* part;
    __device__ __forceinline__ void operator()(const f32x4 (&acc)[2][2][4][2], const Unit& u, int wr, int wc, int fr, int fq) const {
        const int row0 = u.pm * BM + wr * 64 + fr, col0 = u.pn * BM + wc * 32 + 8 * fq;
        if (u.ks >= 0) {
            float* pb = part + (size_t)u.ks * ((size_t)MS * DM);
#pragma unroll
            for (int ai = 0; ai < 2; ++ai)
#pragma unroll
                for (int m = 0; m < 4; ++m) { float* op = pb + (size_t)(row0 + ai * HALF + m * 16 - MP) * DM + col0;
#pragma unroll
                    for (int bj = 0; bj < 2; ++bj) { *(f32x4*)(op + bj * HALF) = acc[ai][bj][m][0]; *(f32x4*)(op + bj * HALF + 4) = acc[ai][bj][m][1]; } }
            return;
        }
#pragma unroll
        for (int ai = 0; ai < 2; ++ai)
#pragma unroll
            for (int m = 0; m < 4; ++m) { const size_t off = (size_t)(row0 + ai * HALF + m * 16) * DM + col0;
                v4u xv[2];
#pragma unroll
                for (int bj = 0; bj < 2; ++bj) xv[bj] = *(const v4u*)(X2 + off + bj * HALF);
#pragma unroll
                for (int bj = 0; bj < 2; ++bj) { const v4u x = xv[bj];
                    const f32x4 r0 = {__uint_as_float(x.x << 16), __uint_as_float(x.x & 0xffff0000u), __uint_as_float(x.y << 16), __uint_as_float(x.y & 0xffff0000u)};
                    const f32x4 r1 = {__uint_as_float(x.z << 16), __uint_as_float(x.z & 0xffff0000u), __uint_as_float(x.w << 16), __uint_as_float(x.w & 0xffff0000u)};
                    *(f32x4*)(out + off + bj * HALF) = acc[ai][bj][m][0] + r0; *(f32x4*)(out + off + bj * HALF + 4) = acc[ai][bj][m][1] + r1; } }
    }
};
struct FusedDownOrder {
    int c, nkt_full;
    __device__ __forceinline__ bool next(int i, Unit& u) const {
        if (i > 4) return false;
        const bool spl = (i == 4); const int x = c & 7, j = c >> 3, tile = c >> 3, ks = c & 7;
        u.pm = spl ? MP / BM + (tile >> 4) : 16 * i + 4 * (x >> 1) + (j >> 3); u.pn = spl ? (tile & 15) : 8 * (x & 1) + (j & 7);
        u.ks = spl ? ks : -1; u.kt0 = spl ? (ks < 3 ? 12 * ks : 36 + 10 * (ks - 3)) : 0; u.nkt = spl ? (ks < 3 ? 12 : 10) : nkt_full;
        return true;
    }
    __device__ __forceinline__ void a_ready(const Unit&) const {}
    __device__ __forceinline__ void done(const Unit&) const {}
};
struct EpiDownFused {
    static constexpr bool PERM = true;
    const bf16_t* X2; float* out; float* part; float* ssq3; unsigned* cnt; const float* gfin; const unsigned* amax2; const unsigned* cmaxd;
    __device__ __forceinline__ void operator()(const i32x4 (&acc)[2][2][4][2], const Unit& u, int wr, int wc, int fr_, int fq_) const {
        int fr = fr_, fq = fq_; asm volatile("" : "+v"(fr), "+v"(fq));
        const int row0 = u.pm * BM + wr * 64 + fr, col0 = u.pn * BM + wc * 32 + 8 * fq;
#define ACCF(a) ((f32x4){(float)(a)[0], (float)(a)[1], (float)(a)[2], (float)(a)[3]})
#define LDSB(bj, n) ({ const v4u c_ = *(const v4u*)(cmaxd + col0 + (bj) * HALF + 4 * (n)); (f32x4){__uint_as_float(c_.x), __uint_as_float(c_.y), __uint_as_float(c_.z), __uint_as_float(c_.w)} * (1.f / 127.f); })
        if (u.ks >= 0) {
            float* pb = part + (size_t)u.ks * ((size_t)MS * DM);
            f32x4 sb[2][2];
#pragma unroll
            for (int bj = 0; bj < 2; ++bj)
#pragma unroll
                for (int n = 0; n < 2; ++n) sb[bj][n] = LDSB(bj, n);
#pragma unroll
            for (int ai = 0; ai < 2; ++ai)
#pragma unroll
                for (int m = 0; m < 4; ++m) { const int row = row0 + ai * HALF + m * 16; float* op = pb + (size_t)(row - MP) * DM + col0; const float sa = __uint_as_float(amax2[row]) * (1.f / (127.f * 32.f));
#pragma unroll
                    for (int bj = 0; bj < 2; ++bj) { *(f32x4*)(op + bj * HALF) = ACCF(acc[ai][bj][m][0]) * sa * sb[bj][0]; *(f32x4*)(op + bj * HALF + 4) = ACCF(acc[ai][bj][m][1]) * sa * sb[bj][1]; } }
            return;
        }
#define X2F(x, r0, r1) const f32x4 r0 = {__uint_as_float(x.x << 16), __uint_as_float(x.x & 0xffff0000u), __uint_as_float(x.y << 16), __uint_as_float(x.y & 0xffff0000u)}; \
                       const f32x4 r1 = {__uint_as_float(x.z << 16), __uint_as_float(x.z & 0xffff0000u), __uint_as_float(x.w << 16), __uint_as_float(x.w & 0xffff0000u)}
        {
#pragma unroll
          for (int ai = 0; ai < 2; ++ai)
#pragma unroll
            for (int m = 0; m < 4; ++m) { const int row = row0 + ai * HALF + m * 16; const size_t off = (size_t)row * DM + col0; float s = 0.f; const float sa = __uint_as_float(amax2[row]) * (1.f / (127.f * 32.f));
#pragma unroll
                for (int bj = 0; bj < 2; ++bj)
#pragma unroll
                    for (int n = 0; n < 2; ++n) { const v2u x = *(const v2u*)(X2 + off + bj * HALF + 4 * n);
                        const f32x4 r0 = {__uint_as_float(x.x << 16), __uint_as_float(x.x & 0xffff0000u), __uint_as_float(x.y << 16), __uint_as_float(x.y & 0xffff0000u)};
                        const f32x4 b0 = LDSB(bj, n);
                        const f32x4 v0 = ACCF(acc[ai][bj][m][n]) * sa * b0 + r0;
                        s += (v0[0] * v0[0] + v0[1] * v0[1]) + (v0[2] * v0[2] + v0[3] * v0[3]); }
                s += __shfl_xor(s, 16); s += __shfl_xor(s, 32);
                if (fq == 0) __hip_atomic_fetch_add(ssq3 + row, s, __ATOMIC_RELAXED, __HIP_MEMORY_SCOPE_AGENT);
                asm volatile("" ::: "memory"); } }
        asm volatile("s_waitcnt vmcnt(0)" ::: "memory");
        unsigned* cw = cnt + 64 * u.pm;
        if (fr == 0 && fq == 0) __hip_atomic_fetch_add(cw, 1u, __ATOMIC_RELAXED, __HIP_MEMORY_SCOPE_AGENT);
        { unsigned sp = 0;
          while ((unsigned)__builtin_amdgcn_readfirstlane(__hip_atomic_load(cw, __ATOMIC_RELAXED, __HIP_MEMORY_SCOPE_AGENT)) < 128u) { __builtin_amdgcn_s_sleep(2); if (++sp > (1u << 16)) break; } }
#pragma unroll
        for (int ai = 0; ai < 2; ++ai)
#pragma unroll
            for (int m = 0; m < 4; ++m) { const int row = row0 + ai * HALF + m * 16; const size_t off = (size_t)row * DM + col0; const float sa = __uint_as_float(amax2[row]) * (1.f / (127.f * 32.f));
                const float rstd = rsqrtf(__hip_atomic_load(ssq3 + row, __ATOMIC_RELAXED, __HIP_MEMORY_SCOPE_AGENT) * (1.f / DM) + EPS);
#pragma unroll
                for (int bj = 0; bj < 2; ++bj)
#pragma unroll
                    for (int n = 0; n < 2; ++n) { const v2u x = *(const v2u*)(X2 + off + bj * HALF + 4 * n);
                        const f32x4 r0 = {__uint_as_float(x.x << 16), __uint_as_float(x.x & 0xffff0000u), __uint_as_float(x.y << 16), __uint_as_float(x.y & 0xffff0000u)};
                        i32x4 a0 = acc[ai][bj][m][n]; asm volatile("" : "+v"(a0));
                        const f32x4 g0 = *(const f32x4*)(gfin + col0 + bj * HALF + 4 * n), b0 = LDSB(bj, n);
                        *(f32x4*)(out + off + bj * HALF + 4 * n) = (ACCF(a0) * sa * b0 + r0) * rstd * g0; }
                asm volatile("" ::: "memory"); }
#undef X2F
#undef LDSB
#undef ACCF
    }
};
struct EpiGluQ {
    static constexpr bool PERM = true;
    bf16_t* ACT; const float* ssq; const unsigned* amax; const unsigned* cmax;
    __device__ __forceinline__ void operator()(const i32x4 (&acc)[2][2][4][2], const Unit& u, int wr, int wc, int fr, int fq) const {
        const int row0 = u.pm * BM + wr * 64 + fr, col0 = u.pn * HALF + wc * 32 + 8 * fq;
        float sg[8], su[8];
#pragma unroll
        for (int j = 0; j < 8; ++j) { sg[j] = __uint_as_float(cmax[col0 + j]) * (1.f / 127.f); su[j] = __uint_as_float(cmax[DFF + col0 + j]) * (1.f / 127.f); }
#pragma unroll
        for (int ai = 0; ai < 2; ++ai)
#pragma unroll
            for (int m = 0; m < 4; ++m) { const int row = row0 + ai * HALF + m * 16; bf16_t* rowp = ACT + (size_t)row * DFF + col0; float r[8];
                const float sa = __uint_as_float(amax[row]) * (1.f / 127.f) * rsqrtf(ssq[row] * (1.f / DM) + EPS);
#pragma unroll
                for (int n = 0; n < 2; ++n)
#pragma unroll
                    for (int j = 0; j < 4; ++j) { const float g = (float)acc[ai][0][m][n][j] * (sa * sg[n * 4 + j]), up = (float)acc[ai][1][m][n][j] * (sa * su[n * 4 + j]);
                        r[n * 4 + j] = g * __builtin_amdgcn_rcpf(1.0f + __builtin_amdgcn_exp2f(-g * LOG2E)) * up; }
                v4u w; w.x = cvt_pk_bf16(r[0], r[1]); w.y = cvt_pk_bf16(r[2], r[3]); w.z = cvt_pk_bf16(r[4], r[5]); w.w = cvt_pk_bf16(r[6], r[7]);
                *(v4u*)rowp = w; }
    }
};
}


struct BgJob {
    const float *w_out, *w_gate, *w_up, *w_down, *g_ffn, *g_of, *g_os; bf16 *Wout_t, *Wgu_t, *Wdn_t; const unsigned* cmax; const unsigned* cmaxd; LAS unsigned char* scr;
    int next, have, stride, end;
};
constexpr int BG_I_OUT = (DM / 64) * (DM / 32), BG_I_G = (DM / 64) * (DFF / 32), BG_I_D = (DFF / 64) * (DM / 32), BG_N = BG_I_OUT + 2 * BG_I_G + BG_I_D;
#define BG_DECODE(it_, W_, ldw_, K_, k0_, n0_, WT_, dr_, ksc_, cm_) do { int r_ = (it_); ksc_ = nullptr; cm_ = nullptr; \
        if (r_ < BG_I_OUT) { const int kb = r_ / 128, nb = r_ % 128; W_ = B.w_out; ldw_ = DM; K_ = DM; WT_ = B.Wout_t; k0_ = 64 * kb; n0_ = 32 * nb; dr_ = 32 * nb; ksc_ = k0_ < WG ? B.g_of : B.g_os - WG; } \
        else if ((r_ -= BG_I_OUT) < BG_I_G) { const int kb = r_ / 344, nb = r_ % 344; W_ = B.w_gate; ldw_ = DFF; K_ = DM; WT_ = B.Wgu_t; ksc_ = B.g_ffn; k0_ = 64 * kb; n0_ = 32 * nb; dr_ = (n0_ >> 7) * 256 + (n0_ & 127); cm_ = B.cmax + n0_; } \
        else if ((r_ -= BG_I_G) < BG_I_G) { const int kb = r_ / 344, nb = r_ % 344; W_ = B.w_up; ldw_ = DFF; K_ = DM; WT_ = B.Wgu_t; ksc_ = B.g_ffn; k0_ = 64 * kb; n0_ = 32 * nb; dr_ = (n0_ >> 7) * 256 + 128 + (n0_ & 127); cm_ = B.cmax + DFF + n0_; } \
        else { r_ -= BG_I_G; const int kb = r_ / 128, nb = r_ % 128; W_ = B.w_down; ldw_ = DM; K_ = DFF; WT_ = B.Wdn_t; k0_ = 64 * kb; n0_ = 32 * nb; dr_ = 32 * nb; cm_ = B.cmaxd + n0_; } } while (0)
__device__ __forceinline__ void bg_step(BgJob& B, int lane) {
    const float* W; const float* ksc; const unsigned* cm; bf16* WT; int ldw, K, k0, n0, dr;
    if (B.have >= 0) {
        BG_DECODE(B.have, W, ldw, K, k0, n0, WT, dr, ksc, cm);
        const int c8 = lane & 7, nsub = lane >> 3; LAS const float* s = (LAS const float*)B.scr + (8 * c8) * 32;
        f32x4 s0 = {1.f, 1.f, 1.f, 1.f}, s1 = s0;
        if (ksc) { s0 = *(const f32x4*)(ksc + k0 + 8 * c8); s1 = *(const f32x4*)(ksc + k0 + 8 * c8 + 4); }
        if (cm) {
#pragma unroll
            for (int jn = 0; jn < 4; ++jn) { const int n = nsub + 8 * jn, o = (((n >> 2) ^ c8) << 2) + (n & 3);
                const float cmv = __uint_as_float(cm[n]), qs = cmv > 0.f ? 127.f / cmv : 0.f; int q[8];
                float v[8] = {s[o] * s0.x, s[o + 32] * s0.y, s[o + 64] * s0.z, s[o + 96] * s0.w, s[o + 128] * s1.x, s[o + 160] * s1.y, s[o + 192] * s1.z, s[o + 224] * s1.w};
                if (K == DFF) {
#define HB(a, b) { const float t_ = a; a = t_ + b; b = t_ - b; }
                    HB(v[0], v[1]) HB(v[2], v[3]) HB(v[4], v[5]) HB(v[6], v[7]) HB(v[0], v[2]) HB(v[1], v[3]) HB(v[4], v[6]) HB(v[5], v[7]) HB(v[0], v[4]) HB(v[1], v[5]) HB(v[2], v[6]) HB(v[3], v[7])
#undef HB
#pragma unroll
                    for (int i = 0; i < 8; ++i) { const float p = __shfl_xor(v[i], 1); v[i] = (c8 & 1) ? p - v[i] : v[i] + p; }
#pragma unroll
                    for (int i = 0; i < 8; ++i) { const float p = __shfl_xor(v[i], 2); v[i] = (c8 & 2) ? p - v[i] : v[i] + p; }
                }
#pragma unroll
                for (int i = 0; i < 8; ++i) q[i] = (int)__builtin_rintf(fminf(fmaxf(v[i] * qs, -127.f), 127.f)) & 0xff;
                v2u w; w.x = (unsigned)q[0] | ((unsigned)q[1] << 8) | ((unsigned)q[2] << 16) | ((unsigned)q[3] << 24); w.y = (unsigned)q[4] | ((unsigned)q[5] << 8) | ((unsigned)q[6] << 16) | ((unsigned)q[7] << 24);
                *(GAS v2u*)((unsigned char*)WT + (size_t)(dr + n) * K + k0 + 8 * c8) = w; }
        } else {
#pragma unroll
        for (int jn = 0; jn < 4; ++jn) { const int n = nsub + 8 * jn, o = (((n >> 2) ^ c8) << 2) + (n & 3);
            v4u w; w.x = cvt_pk_bf16(s[o] * s0.x, s[o + 32] * s0.y); w.y = cvt_pk_bf16(s[o + 64] * s0.z, s[o + 96] * s0.w);
            w.z = cvt_pk_bf16(s[o + 128] * s1.x, s[o + 160] * s1.y); w.w = cvt_pk_bf16(s[o + 192] * s1.z, s[o + 224] * s1.w);
            *(GAS v4u*)(WT + (size_t)(dr + n) * K + k0 + 8 * c8) = w; }
        }
        LDS_WAIT(); asm volatile("" ::: "memory");
        B.have = -1;
    }
    if (B.next < B.end) {
        BG_DECODE(B.next, W, ldw, K, k0, n0, WT, dr, ksc, cm);
        const float* p = W + (size_t)(k0 + (lane >> 3)) * ldw + n0;
#pragma unroll
        for (int j = 0; j < 8; ++j) __builtin_amdgcn_global_load_lds((const unsigned*)(p + (size_t)(8 * j) * ldw + 4 * ((lane & 7) ^ j)), (LAS unsigned*)(B.scr + j * 1024), 16, 0, 0);
        B.have = B.next; B.next += B.stride;
    }
}
#undef BG_DECODE

namespace att {
constexpr int SHM_V = 16384, SHM_K = 16384;
constexpr int OFF_V = 0, OFF_K = 2 * SHM_V, OFF_WS = 4 * 16384, OFF_U = OFF_WS + NWAVES * 256, OFF_SCAN = OFF_U + (2048 + 64) * 4, OFF_FLAG = OFF_SCAN + 64, ATT_LDS = OFF_FLAG + 64;
static_assert(ATT_LDS <= BG_OFF, "attention LDS");
#define KSWZ(row, colB) ((row) * 256 + ((colB) ^ (((row) & 7) << 4)))
#define SBAR() __builtin_amdgcn_sched_barrier(0)
__device__ __forceinline__ int slot32(int k) { return (k & 3) | (((k >> 2) & 3) << 3) | (((k >> 4) & 1) << 2); }
__device__ __forceinline__ int v_st(int k, int c) { const int kk = (k & ~0xC) | ((k & 4) << 1) | ((k & 8) >> 1); return ((kk >> 3) * 4 + (c >> 5)) * 512 + ((kk & 7) * 32 + (c & 31)) * 2; }
__device__ __forceinline__ int v_rd_base(int lane) { return ((lane & 3) << 3) | (((lane >> 2) & 3) << 6) | (((lane >> 4) & 1) << 5) | (((lane >> 5) & 1) << 8); }
constexpr int v_rd_off(int d0, int ks, int half) { return d0 * 512 + ks * 4096 + half * 2048; }
__device__ __forceinline__ int crow(int r, int hi) { return (r & 3) + 8 * (r >> 2) + 4 * hi; }
__device__ __forceinline__ float partner(float x, int hi) { auto rr = __builtin_amdgcn_permlane32_swap(__float_as_uint(x), __float_as_uint(x), false, false); return __uint_as_float(hi ? rr[0] : rr[1]); }

__device__ __forceinline__ void qkt(f32x16& p0, f32x16& p1, LAS const unsigned char* Kt, int r32, int hi, const bf16x8* qr) {
    LAS const unsigned char* kb[4];
#pragma unroll
    for (int dd = 0; dd < 4; ++dd) kb[dd] = Kt + KSWZ(r32, (dd * 16 + hi * 8) * 2);
#pragma unroll
    for (int d0 = 0; d0 < 8; ++d0) { LAS const unsigned char* a = kb[d0 & 3] + (d0 >> 2) * 128;
        const bf16x8 b0 = *(LAS const bf16x8*)a;
        const bf16x8 b1 = *(LAS const bf16x8*)(a + 32 * 256);
        p0 = __builtin_amdgcn_mfma_f32_32x32x16_bf16(b0, qr[d0], p0, 0, 0, 0);
        p1 = __builtin_amdgcn_mfma_f32_32x32x16_bf16(b1, qr[d0], p1, 0, 0, 0); }
}
__device__ __forceinline__ void pv_tile(f32x16* o, int vb0, bf16x8 pa0, bf16x8 pa1, bf16x8 pa2, bf16x8 pa3) {
#define TRRD(dst, off) asm volatile("ds_read_b64_tr_b16 %0, %1 offset:%2" : "=&v"(dst) : "v"(vb0), "i"(off) : "memory")
#define PV_D0(d0) do { s16x4 l0, l1, l2, l3, h0, h1, h2, h3; constexpr int b_ = v_rd_off(d0, 0, 0); \
        TRRD(l0, b_); TRRD(h0, b_ + 2048); TRRD(l1, b_ + 4096); TRRD(h1, b_ + 6144); TRRD(l2, b_ + 8192); TRRD(h2, b_ + 10240); TRRD(l3, b_ + 12288); TRRD(h3, b_ + 14336); \
        asm volatile("s_waitcnt lgkmcnt(0)" ::: "memory"); SBAR(); \
        o[d0] = __builtin_amdgcn_mfma_f32_32x32x16_bf16(pa0, (bf16x8){l0[0], l0[1], l0[2], l0[3], h0[0], h0[1], h0[2], h0[3]}, o[d0], 0, 0, 0); \
        o[d0] = __builtin_amdgcn_mfma_f32_32x32x16_bf16(pa1, (bf16x8){l1[0], l1[1], l1[2], l1[3], h1[0], h1[1], h1[2], h1[3]}, o[d0], 0, 0, 0); \
        o[d0] = __builtin_amdgcn_mfma_f32_32x32x16_bf16(pa2, (bf16x8){l2[0], l2[1], l2[2], l2[3], h2[0], h2[1], h2[2], h2[3]}, o[d0], 0, 0, 0); \
        o[d0] = __builtin_amdgcn_mfma_f32_32x32x16_bf16(pa3, (bf16x8){l3[0], l3[1], l3[2], l3[3], h3[0], h3[1], h3[2], h3[3]}, o[d0], 0, 0, 0); } while (0)
    PV_D0(0); PV_D0(1); PV_D0(2); PV_D0(3);
#undef PV_D0
#undef TRRD
}
#define PK4(P, B_, OUT) do { unsigned a0 = cvt_pk_bf16(P[B_+0], P[B_+1]), a1 = cvt_pk_bf16(P[B_+2], P[B_+3]); \
        unsigned b0 = cvt_pk_bf16(P[B_+4], P[B_+5]), b1 = cvt_pk_bf16(P[B_+6], P[B_+7]); \
        auto r0 = __builtin_amdgcn_permlane32_swap(a0, b0, false, false); auto r1 = __builtin_amdgcn_permlane32_swap(a1, b1, false, false); \
        v4u w = {r0[0], r1[0], r0[1], r1[1]}; OUT = __builtin_bit_cast(bf16x8, w); } while (0)

template <class F> __device__ __forceinline__ void scan_u(LAS float* U, LAS float* scan, int n, F lf) {
    const int tid = threadIdx.x, lane = tid & 63, wid = tid >> 6, t0 = 4 * tid;
    float v0 = t0 < n ? lf(t0) : 0.f, v1 = t0 + 1 < n ? lf(t0 + 1) : 0.f, v2 = t0 + 2 < n ? lf(t0 + 2) : 0.f, v3 = t0 + 3 < n ? lf(t0 + 3) : 0.f;
    v1 += v0; v2 += v1; v3 += v2;
    float x = v3;
#pragma unroll
    for (int o = 1; o < 64; o <<= 1) { const float y = __shfl_up(x, o); if (lane >= o) x += y; }
    if (lane == 63) scan[wid] = x;
    __syncthreads();
    float pre = x - v3;
    for (int w = 0; w < wid; ++w) pre += scan[w];
    f32x4 r = {-(v0 + pre) * LOG2E, -(v1 + pre) * LOG2E, -(v2 + pre) * LOG2E, -(v3 + pre) * LOG2E};
    *(LAS f32x4*)(U + t0) = r;
    __syncthreads();
}

__device__ __forceinline__ int islot(int rho) { return (rho & 0x23) | (((rho >> 3) & 3) << 2) | (((rho >> 2) & 1) << 4); }
template <int MODE, bool SAMPLE>
__device__ __forceinline__ void attn_unit(LAS unsigned char* lds, const bf16* Q, const bf16* K, const bf16* V, bf16* O, int P0, const float* Kc, const float* Vc, const float* Kn, const float* Vn, BgJob& B, float* osq) {
    int tid_ = threadIdx.x; asm volatile("" : "+v"(tid_));
    const int tid = tid_, wid = __builtin_amdgcn_readfirstlane(tid >> 6), lane = tid & 63, r32 = lane & 31, hi = lane >> 5;
    constexpr int nact = SAMPLE ? 1 : NWAVES, Tk = SAMPLE ? TKS : SEQ;
    const bool active = wid < nact;
    const int NT = (P0 + 32 * nact + 63) >> 6;
    LAS unsigned char* V_lds = lds + OFF_V; LAS unsigned char* K_lds = lds + OFF_K;
    LAS float* wsf = (LAS float*)(lds + OFF_WS) + wid * 64; LAS float* li_l = wsf; LAS float* al_l = wsf + 32;
    LAS const float* U = (LAS const float*)(lds + OFF_U);
    LAS unsigned* flg = (LAS unsigned*)(lds + OFF_FLAG);
    int kkey[2], kcol[2], vkey[2], vcol[2];
#pragma unroll
    for (int i = 0; i < 2; ++i) {
        const int q = wid * 2 + i;
        { const int rho = q * 4 + (lane >> 4), cpos = lane & 15; kkey[i] = islot(rho); kcol[i] = (cpos ^ (rho & 7)) * 8; }
        { const int sub = q * 2 + (lane >> 5), kk = (sub >> 2) * 8 + ((lane & 31) >> 2), ks = (kk & ~0xC) | ((kk & 4) << 1) | ((kk & 8) >> 1); vkey[i] = islot(ks); vcol[i] = (sub & 3) * 32 + (lane & 3) * 8; }
    }
    if (MODE == 1 && lane == 0) { flg[wid] = active ? 0u : 1u; flg[8 + wid] = active ? 0u : 1u; }
#define TILE_OF(t) (NT - 1 - (t))
#define STAGE_DMA(j, bf) do { _Pragma("unroll") for (int _i = 0; _i < 2; ++_i) { \
        int kk_ = (j) * 64 + kkey[_i]; kk_ = kk_ < Tk ? kk_ : Tk - 1; int vk_ = (j) * 64 + vkey[_i]; vk_ = vk_ < Tk ? vk_ : Tk - 1; \
        __builtin_amdgcn_global_load_lds((const unsigned*)(K + (size_t)kk_ * WG + kcol[_i]), (LAS unsigned*)(K_lds + (bf) * SHM_K + (wid * 2 + _i) * 1024), 16, 0, 0); \
        __builtin_amdgcn_global_load_lds((const unsigned*)(V + (size_t)vk_ * WG + vcol[_i]), (LAS unsigned*)(V_lds + (bf) * SHM_V + (wid * 2 + _i) * 1024), 16, 0, 0); } } while (0)
#define STAGE_F32(j, bf) do { const int lt_ = tid - 64; f32x4 fa_[5], fb_[5]; int dst_[5]; \
        _Pragma("unroll") for (int jj_ = 0; jj_ < 5; ++jj_) { const int i_ = lt_ + 448 * jj_; int key_, col_; const bool isv_ = i_ >= 1024; \
            if (!isv_) { const int rho = i_ >> 4, cpos = i_ & 15; key_ = islot(rho); col_ = (cpos ^ (rho & 7)) * 8; dst_[jj_] = OFF_K + (bf) * SHM_K + i_ * 16; } \
            else { const int iv = i_ - 1024, sub = iv >> 5, kk = (sub >> 2) * 8 + ((iv & 31) >> 2), ks = (kk & ~0xC) | ((kk & 4) << 1) | ((kk & 8) >> 1); key_ = islot(ks); col_ = (sub & 3) * 32 + (iv & 3) * 8; dst_[jj_] = OFF_V + (bf) * SHM_V + iv * 16; } \
            int ka_ = (j) * 64 + key_; ka_ = ka_ < Tk ? ka_ : Tk - 1; \
            const float* src_ = (ka_ < PAST ? (isv_ ? Vc : Kc) + (size_t)ka_ * WG : (isv_ ? Vn : Kn) + (size_t)(ka_ - PAST) * WG) + col_; \
            if (i_ < 2048) { fa_[jj_] = *(const f32x4*)src_; fb_[jj_] = *(const f32x4*)(src_ + 4); } } \
        _Pragma("unroll") for (int jj_ = 0; jj_ < 5; ++jj_) { const int i_ = lt_ + 448 * jj_; \
            if (i_ < 2048) { v4u w_; w_.x = cvt_pk_bf16(fa_[jj_].x, fa_[jj_].y); w_.y = cvt_pk_bf16(fa_[jj_].z, fa_[jj_].w); w_.z = cvt_pk_bf16(fb_[jj_].x, fb_[jj_].y); w_.w = cvt_pk_bf16(fb_[jj_].z, fb_[jj_].w); \
                *(LAS v4u*)(lds + dst_[jj_]) = w_; } } } while (0)
    if (SAMPLE && wid >= 1) {
        STAGE_F32(TILE_OF(0), 0); LDS_WAIT();
        __syncthreads();
        for (int t = 0; t < NT; ++t) {
            if (t + 1 < NT) STAGE_F32(TILE_OF(t + 1), (t + 1) & 1);
            LDS_WAIT();
            __syncthreads();
            if (MODE == 1) { const v4u fa = *(LAS const v4u*)(flg + (t & 1) * 8), fb = *(LAS const v4u*)(flg + (t & 1) * 8 + 4);
                if ((fa.x & fa.y & fa.z & fa.w & fb.x & fb.y & fb.z & fb.w) != 0u) break; }
        }
        __syncthreads();
        return;
    }
    const int vb0 = (int)(size_t)V_lds + v_rd_base(lane);
    const int qlo = P0 + wid * 32, tq = qlo + r32;
    bf16x8 qr[8];
#pragma unroll
    for (int d0 = 0; d0 < 8; ++d0) qr[d0] = *(const bf16x8*)(Q + (size_t)(wid * 32 + r32) * DM + d0 * 16 + hi * 8);
    if (!SAMPLE) { STAGE_DMA(TILE_OF(0), 0); VM_WAIT(); }
    __syncthreads();
    float m_reg = -1e30f, l_reg = 0.f, carry = 1.f;
    f32x16 o[4] = {};
    for (int t = 0; t < NT; ++t) {
        const int j = TILE_OF(t), kb = j * 64, bufo = (t & 1) * SHM_K;
        if (!SAMPLE && t + 1 < NT) STAGE_DMA(TILE_OF(t + 1), (t + 1) & 1);
        if (!SAMPLE) bg_step(B, lane);
        if (kb <= qlo + 31) {
            f32x16 p0, p1;
            if (MODE == 0) {
                LAS const f32x4* up0 = (LAS const f32x4*)(U + kb + 16 * hi); LAS const f32x4* up1 = (LAS const f32x4*)(U + kb + 32 + 16 * hi);
#pragma unroll
                for (int g = 0; g < 4; ++g) { const f32x4 a = up0[g], b = up1[g];
#pragma unroll
                    for (int jj = 0; jj < 4; ++jj) { p0[4 * g + jj] = a[jj]; p1[4 * g + jj] = b[jj]; } }
            } else { p0 = f32x16{}; p1 = f32x16{}; }
            qkt(p0, p1, K_lds + bufo, r32, hi, qr);
            bf16x8 pa0, pa1, pa2, pa3;
            const int dq = tq - kb - 16 * hi;
            const bool need_mask = kb + 63 >= qlo;
            if (MODE == 0) {
                if (need_mask) { const float NEG = -__builtin_inff();
#pragma unroll
                    for (int r = 0; r < 16; ++r) { if (r > dq) p0[r] = NEG; if (r + 32 > dq) p1[r] = NEG; } }
                float pmax = p0[0];
#pragma unroll
                for (int r = 1; r < 16; ++r) pmax = fmaxf(pmax, p0[r]);
#pragma unroll
                for (int r = 0; r < 16; ++r) pmax = fmaxf(pmax, p1[r]);
                pmax = fmaxf(pmax, partner(pmax, hi));
                const float mn = fmaxf(m_reg, pmax);
                const bool grew = __any(mn > m_reg);
                float ps = 0.f;
#pragma unroll
                for (int r = 0; r < 16; ++r) { p0[r] = __builtin_amdgcn_exp2f(p0[r] - mn); p1[r] = __builtin_amdgcn_exp2f(p1[r] - mn); ps += p0[r] + p1[r]; }
                ps += partner(ps, hi);
                if (grew) {
                    const float alpha = __builtin_amdgcn_exp2f(m_reg - mn);
                    l_reg = l_reg * alpha + ps;
                    if (hi == 0) al_l[r32] = alpha;
                    LDS_WAIT();
#pragma unroll
                    for (int g = 0; g < 4; ++g) { const f32x4 a = *(LAS const f32x4*)(al_l + 8 * g + 4 * hi);
#pragma unroll
                        for (int jj = 0; jj < 4; ++jj)
#pragma unroll
                            for (int d_ = 0; d_ < 4; ++d_) o[d_][4 * g + jj] *= a[jj]; }
                } else l_reg += ps;
                m_reg = mn;
            } else {
                f32x16 w1;
#pragma unroll
                for (int r = 0; r < 16; ++r) { p1[r] = __builtin_amdgcn_exp2f(fminf(p1[r], 80.f)); w1[r] = __builtin_amdgcn_rcpf(1.0f + p1[r]); }
                if (need_mask) {
#pragma unroll
                    for (int r = 0; r < 16; ++r) if (r + 32 >= dq) { p1[r] = 0.f; w1[r] = 1.f; } }
#pragma unroll
                for (int r = 14; r >= 0; --r) w1[r] *= w1[r + 1];
                const float T1 = w1[0], oT1 = partner(T1, hi);
                const float f1 = hi ? carry : carry * oT1;
#pragma unroll
                for (int r = 0; r < 16; ++r) p1[r] = p1[r] * (w1[r] * f1);
                f32x16 w0;
#pragma unroll
                for (int r = 0; r < 16; ++r) { p0[r] = __builtin_amdgcn_exp2f(fminf(p0[r], 80.f)); w0[r] = __builtin_amdgcn_rcpf(1.0f + p0[r]); }
                if (need_mask) {
#pragma unroll
                    for (int r = 0; r < 16; ++r) if (r >= dq) { p0[r] = 0.f; w0[r] = 1.f; } }
#pragma unroll
                for (int r = 14; r >= 0; --r) w0[r] *= w0[r + 1];
                const float T0 = w0[0], oT0 = partner(T0, hi);
                const float f0 = (carry * (T1 * oT1)) * (hi ? 1.f : oT0);
#pragma unroll
                for (int r = 0; r < 16; ++r) p0[r] = p0[r] * (w0[r] * f0);
                carry = carry * ((T0 * oT0) * (T1 * oT1));
            }
            PK4(p0, 0, pa0); PK4(p0, 8, pa1); PK4(p1, 0, pa2); PK4(p1, 8, pa3);
            pv_tile(o, vb0 + bufo, pa0, pa1, pa2, pa3);
        }
        if (MODE == 1) { const bool dead = __all(carry == 0.f) != 0; if (lane == 0) flg[(t & 1) * 8 + wid] = dead ? 1u : 0u; }
        if (!SAMPLE) VM_WAIT();
        LDS_WAIT();
        __syncthreads();
        if (MODE == 1) {
            const v4u fa = *(LAS const v4u*)(flg + (t & 1) * 8), fb = *(LAS const v4u*)(flg + (t & 1) * 8 + 4);
            if ((fa.x & fa.y & fa.z & fa.w & fb.x & fb.y & fb.z & fb.w) != 0u) break;
        }
    }
    {
        if (MODE == 0) {
            if (hi == 0) li_l[r32] = 1.0f / l_reg;
            LDS_WAIT();
#pragma unroll
            for (int g = 0; g < 4; ++g) { const f32x4 a = *(LAS const f32x4*)(li_l + 8 * g + 4 * hi);
#pragma unroll
                for (int jj = 0; jj < 4; ++jj)
#pragma unroll
                    for (int d_ = 0; d_ < 4; ++d_) o[d_][4 * g + jj] *= a[jj]; }
        }
#pragma unroll
        for (int r = 0; r < 16; ++r) { float s = (o[0][r] * o[0][r] + o[1][r] * o[1][r]) + (o[2][r] * o[2][r] + o[3][r] * o[3][r]);
            s += __shfl_xor(s, 1); s += __shfl_xor(s, 2); s += __shfl_xor(s, 4); s += __shfl_xor(s, 8); s += __shfl_xor(s, 16);
            if (r32 == 0) __hip_atomic_fetch_add(osq + 2 * (wid * 32 + crow(r, hi)), s, __ATOMIC_RELAXED, __HIP_MEMORY_SCOPE_AGENT); }
        bf16* Ow = O + (size_t)(wid * 32) * DM;
#pragma unroll
        for (int r = 0; r < 16; ++r) { const int orow = crow(r, hi);
#pragma unroll
            for (int d0 = 0; d0 < 4; ++d0) { const float v = o[d0][r]; const float vn = __shfl_xor(v, 1);
                if ((r32 & 1) == 0) *(unsigned*)(Ow + (size_t)orow * DM + d0 * 32 + r32) = cvt_pk_bf16(v, vn); } }
    }
    __syncthreads();
#undef TILE_OF
#undef STAGE_DMA
#undef STAGE_F32
}
#undef PK4
}

#define XB_TMO      128
#define XB_XCNT(j)  (256  + 64 * (j))
#define XB_XSUB(j)  (1280 + 64 * (j))
#define XB_XGEN(j)  (2304 + 64 * (j))
#define XB_TOP      3328
#define XB_TOPGEN   3392
#define XCD_BAR_WORDS 3456
#define XB_SPIN_CAP (1u << 18)
__device__ __forceinline__ unsigned xb_ld(unsigned* p)              { return __hip_atomic_load(p, __ATOMIC_RELAXED, __HIP_MEMORY_SCOPE_AGENT); }
__device__ __forceinline__ unsigned xb_add(unsigned* p, unsigned v) { return __hip_atomic_fetch_add(p, v, __ATOMIC_RELAXED, __HIP_MEMORY_SCOPE_AGENT); }
__device__ __forceinline__ unsigned xb_xcc_id() { return (unsigned)__builtin_amdgcn_s_getreg((3 << 11) | 20) & 0xFu; }
#define XB_SPIN(cond, bar) do { unsigned _sp = 0; while (cond) { __builtin_amdgcn_s_sleep(1); \
    if ((++_sp & 255u) == 0u) { if (xb_ld(&(bar)[XB_TMO])) break; if (_sp > XB_SPIN_CAP) { atomicAdd(&(bar)[XB_TMO], 1u); break; } } } } while (0)
struct XcdBarrier { unsigned* bar; unsigned x; volatile LAS unsigned* st; };
__device__ __forceinline__ XcdBarrier xcd_barrier_post(unsigned* bar, volatile LAS unsigned* st) {
    XcdBarrier b; b.bar = bar; b.x = xb_xcc_id(); b.st = st;
    if (threadIdx.x == 0) (void)xb_add(&bar[XB_XCNT(b.x)], 1u);
    return b;
}
__device__ __forceinline__ void xcd_barrier_complete(unsigned* bar, unsigned x, unsigned& nloc, unsigned& nx) {
    const unsigned G = gridDim.x * gridDim.y * gridDim.z;
    unsigned sum, cnt, mine, sp = 0u;
    for (;;) {
        sum = 0u; cnt = 0u; mine = 0u;
#pragma unroll
        for (unsigned j = 0; j < 16; ++j) { const unsigned c = xb_ld(&bar[XB_XCNT(j)]); sum += c; cnt += (c > 0u) ? 1u : 0u; mine = (j == x) ? c : mine; }
        if (sum == G) break;
        __builtin_amdgcn_s_sleep(1);
        if ((++sp & 255u) == 0u) { if (xb_ld(&bar[XB_TMO])) break; if (sp > XB_SPIN_CAP) { atomicAdd(&bar[XB_TMO], 1u); break; } }
    }
    nloc = mine > 0u ? mine : 1u; nx = cnt > 0u ? cnt : 1u;
}
__device__ __forceinline__ void xcd_barrier(const XcdBarrier& b) {
    asm volatile("s_waitcnt vmcnt(0)" ::: "memory");
    __syncthreads();
    if (threadIdx.x == 0) {
        unsigned* bar = b.bar;
        __builtin_amdgcn_s_waitcnt(0);
        unsigned nloc = b.st[0], nx = b.st[1];
        if (nloc == 0u) { xcd_barrier_complete(bar, b.x, nloc, nx); b.st[0] = nloc; b.st[1] = nx; }
        const unsigned old = xb_add(&bar[XB_XSUB(b.x)], 1u);
        const unsigned gen = old / nloc;
        if (old + 1u == (gen + 1u) * nloc) {
            __builtin_amdgcn_fence(__ATOMIC_RELEASE, "agent");
            asm volatile("s_waitcnt vmcnt(0)" ::: "memory");
            const unsigned og = xb_add(&bar[XB_TOP], 1u);
            const unsigned tg = og / nx;
            if (og + 1u == (tg + 1u) * nx) xb_add(&bar[XB_TOPGEN], 1u);
            else XB_SPIN(xb_ld(&bar[XB_TOPGEN]) == tg, bar);
            __builtin_amdgcn_fence(__ATOMIC_ACQUIRE, "agent");
            xb_add(&bar[XB_XGEN(b.x)], 1u);
            asm volatile("s_waitcnt vmcnt(0)" ::: "memory");
        } else {
            XB_SPIN(xb_ld(&bar[XB_XGEN(b.x)]) == gen, bar);
            __builtin_amdgcn_fence(__ATOMIC_ACQUIRE, "agent");
            asm volatile("s_waitcnt vmcnt(0)" ::: "memory");
        }
    }
    __syncthreads();
}

struct Args { const float* in[18]; float* out; unsigned char* ws; int ph_lo, ph_hi; };

__device__ __forceinline__ float wave_sum(float v) {
#pragma unroll
    for (int o = 1; o < 64; o <<= 1) v += __shfl_xor(v, o);
    return v;
}
__device__ __forceinline__ void tr_load(f32x4 (&r)[8], const float* W, int ldw, int k0, int n0, int lane) {
    const float* p = W + (size_t)(k0 + (lane >> 3)) * ldw + n0 + 4 * (lane & 7);
#pragma unroll
    for (int j = 0; j < 8; ++j) r[j] = *(const f32x4*)(p + (size_t)(8 * j) * ldw);
}
__device__ __forceinline__ void tr_proc(const f32x4 (&r)[8], const float* ksc, int K, int k0, int ncols, bf16* WT, int drow0, LAS float* scr, int lane) {
    const int c = 4 * (lane & 7);
#pragma unroll
    for (int j = 0; j < 8; ++j) { const int kk = 8 * j + (lane >> 3); const float sc = ksc ? ksc[k0 + kk] : 1.f; LAS float* d = scr + kk * 33 + c;
        d[0] = r[j].x * sc; d[1] = r[j].y * sc; d[2] = r[j].z * sc; d[3] = r[j].w * sc; }
    LDS_WAIT(); asm volatile("" ::: "memory");
    const int c8 = lane & 7;
#pragma unroll
    for (int j = 0; j < 4; ++j) { const int n = (lane >> 3) + 8 * j; const LAS float* s = scr + (8 * c8) * 33 + n;
        v4u o; o.x = cvt_pk_bf16(s[0 * 33], s[1 * 33]); o.y = cvt_pk_bf16(s[2 * 33], s[3 * 33]); o.z = cvt_pk_bf16(s[4 * 33], s[5 * 33]); o.w = cvt_pk_bf16(s[6 * 33], s[7 * 33]);
        if (n < ncols) *(GAS v4u*)(WT + (size_t)(drow0 + n) * K + k0 + 8 * c8) = o; }
    LDS_WAIT(); asm volatile("" ::: "memory");
}
__device__ __forceinline__ void row_to_bf16_ssq(const float* xrow, bf16* orow, float* ssq, int lane) {
    const f32x4* xr = (const f32x4*)xrow + lane;
    f32x4 v[16]; float s = 0.f;
#pragma unroll
    for (int j = 0; j < 16; ++j) { v[j] = xr[64 * j]; s += (v[j].x * v[j].x + v[j].y * v[j].y) + (v[j].z * v[j].z + v[j].w * v[j].w); }
    s = wave_sum(s);
    v2u* o8 = (v2u*)orow + lane;
#pragma unroll
    for (int j = 0; j < 16; ++j) { v2u w; w.x = cvt_pk_bf16(v[j].x, v[j].y); w.y = cvt_pk_bf16(v[j].z, v[j].w); o8[64 * j] = w; }
    if (lane == 0) *ssq = s;
}
__device__ __forceinline__ float bf_lo(unsigned w) { return __uint_as_float(w << 16); }
__device__ __forceinline__ float bf_hi(unsigned w) { return __uint_as_float(w & 0xffff0000u); }

__global__ void __launch_bounds__(NWAVES * 64, 2) fwd_kernel(Args args) {
    extern __shared__ __attribute__((aligned(16))) unsigned char lds_raw[];
    LAS unsigned char* lds = (LAS unsigned char*)lds_raw;
    volatile LAS unsigned* MISC = (volatile LAS unsigned*)(lds + MISC_OFF);
    const int tid = threadIdx.x, wave = __builtin_amdgcn_readfirstlane(tid >> 6);
#define lane ((int)(threadIdx.x & 63u))
    const int G = gridDim.x; const int bx = blockIdx.x; const int vcu = (G % 8 == 0) ? (bx % 8) * (G / 8) + bx / 8 : bx;
    unsigned char* ws = args.ws; float* out = args.out;
    gu32* ctl = (gu32*)(ws + WS_CTL);
    const float* x_prompt = args.in[0]; const float* x_sample = args.in[1];
    const float* cache_fk = args.in[2]; const float* cache_fv = args.in[3]; const float* cache_fl = args.in[4]; const float* cache_sk = args.in[5]; const float* cache_sv = args.in[6];
    const float* g_attn = args.in[7]; const float* w_in = args.in[8]; const float* b_forget = args.in[9]; const float* g_of = args.in[10]; const float* g_os = args.in[11];
    const float* w_out = args.in[12]; const float* g_ffn = args.in[13]; const float* w_gate = args.in[14]; const float* w_up = args.in[15]; const float* w_down = args.in[16]; const float* g_final = args.in[17];
    bf16* Win_t = (bf16*)(ws + WS_WIN); bf16* Wout_t = (bf16*)(ws + WS_WOUT); bf16* Wgu_t = (bf16*)(ws + WS_WGU); bf16* Wdn_t = (bf16*)(ws + WS_WDN);
    bf16* XN = (bf16*)(ws + WS_XN); bf16* QO = (bf16*)(ws + WS_QO); bf16* KVB = (bf16*)(ws + WS_KV); bf16* ACT = (bf16*)(ws + WS_ACT); float* PART = (float*)(ws + WS_PART);

    for (int u = tid; u < (LDS_BYTES - LDSCTL_OFF) / 4; u += NWAVES * 64) ((LAS unsigned*)(lds + LDSCTL_OFF))[u] = 0u;
    __syncthreads();
    XcdBarrier bar; bar.bar = (unsigned*)(ctl + CW_BAR); bar.x = 0; bar.st = nullptr;
    if (MK_N_LAUNCHES == 1) bar = xcd_barrier_post((unsigned*)(ctl + CW_BAR), MISC + 8);
    const int lo = args.ph_lo, hi_ph = args.ph_hi;
#ifndef PH_MASK
#define PH_MASK 0x1ff
#endif
#define IN(k) (((PH_MASK >> (k)) & 1) && lo <= (k) && (k) < hi_ph)
#define BOTH(k) (IN(k) && IN((k) + 1))
#define GRID_BAR() do { if (MK_N_LAUNCHES == 1) xcd_barrier(bar); } while (0)
#ifndef PROBE_PHASE
#define PROBE_PHASE (-1)
#endif
    unsigned long long probe_t0 = 0ull;
#define PROBE_T0(k) do { if (PROBE_PHASE == (k)) probe_t0 = __builtin_amdgcn_s_memrealtime(); } while (0)
#define PROBE_T1(k) do { if (PROBE_PHASE == (k)) { const unsigned long long t1_ = __builtin_amdgcn_s_memrealtime(); const unsigned long long d_ = t1_ - probe_t0; \
        while (__builtin_amdgcn_s_memrealtime() - t1_ < d_) __builtin_amdgcn_s_sleep(8); } } while (0)
    const int gw = vcu * NWAVES + wave, NGW = G * NWAVES;

    if (IN(0)) {
        PROBE_T0(0);
        LAS float* scr = (LAS float*)(lds + RING_OFF + wave * 16384);
        constexpr int KB4 = DM / 64;
        constexpr int I_INA = KB4 * (3 * WG / 32), I_INB = I_INA, I_FL = KB4;
        constexpr int NITEMS = I_INA + I_INB + I_FL;
#define TR_DECODE(it_, W_, ksc_, WT_, ldw_, K_, k0_, n0_, nc_, dr_) do { int r_ = (it_); ksc_ = g_attn; nc_ = 32; ldw_ = DIN; K_ = DM; W_ = w_in; WT_ = Win_t; \
            if (r_ < I_INA) { const int kb = r_ / 192, nb = r_ % 192; k0_ = 64 * kb; n0_ = 32 * nb; dr_ = 32 * nb; } \
            else if ((r_ -= I_INA) < I_INB) { const int kb = r_ / 192, nb = r_ % 192; k0_ = 64 * kb; n0_ = 3 * WG + NHG + 32 * nb; dr_ = 3 * WG + 32 * nb; } \
            else { r_ -= I_INB; k0_ = 64 * r_; n0_ = 3 * WG; nc_ = 16; dr_ = 6 * WG; } } while (0)
        if (gw < NITEMS) {
            const float* W; const float* ksc; bf16* WT; int ldw, K, k0, n0, nc, dr;
            f32x4 ra[8], rb[8];
            int it = gw;
            TR_DECODE(it, W, ksc, WT, ldw, K, k0, n0, nc, dr);
            tr_load(ra, W, ldw, k0, n0, lane);
            for (;;) {
                const int itn = it + NGW; const bool more = itn < NITEMS;
                const float* W2 = W; const float* ksc2 = ksc; bf16* WT2 = WT; int ldw2 = ldw, K2 = K, k02 = k0, n02 = n0, nc2 = nc, dr2 = dr;
                if (more) { TR_DECODE(itn, W2, ksc2, WT2, ldw2, K2, k02, n02, nc2, dr2); tr_load(rb, W2, ldw2, k02, n02, lane); }
                tr_proc(ra, ksc, K, k0, nc, WT, dr, scr, lane);
                if (!more) break;
#pragma unroll
                for (int j = 0; j < 8; ++j) ra[j] = rb[j];
                W = W2; ksc = ksc2; WT = WT2; ldw = ldw2; K = K2; k0 = k02; n0 = n02; nc = nc2; dr = dr2; it = itn;
            }
        }
#undef TR_DECODE
        for (int i = gw * 64 + lane; i < 240 * DM / 8; i += NGW * 64) *(v4u*)(Win_t + (size_t)(6 * WG + 16) * DM + (size_t)i * 8) = (v4u){0u, 0u, 0u, 0u};
        for (int m = gw; m < MT; m += NGW) row_to_bf16_ssq(m < MP ? x_prompt + (size_t)m * DM : x_sample + (size_t)(m - MP) * DM, XN + (size_t)m * DM, (float*)(ctl + CW_SSQ0) + m, lane);
        PROBE_T1(0);
        if (BOTH(0)) GRID_BAR();
    }

    if (IN(1)) {
        PROBE_T0(1);
        pg8::Gemm g{XN, Win_t, MT, NIN, DM}; pg8::StaticOrder S; S.init(MT, NIN, DM, G, bx);
        pg8::EpiIn E{QO, KVB, out, b_forget, (const float*)(ctl + CW_SSQ0)};
#ifndef PROBE_REP1
#define PROBE_REP1 1
#endif
#pragma unroll 1
        for (int rep = 0; rep < PROBE_REP1; ++rep) { if (rep) GRID_BAR();
        pg8::gemm_phase<pg8::EpiIn, pg8::StaticOrder, true, true>(lds + RING_OFF, g, S, E); }
        { const int nwg1 = (MT / 256) * (NIN / 256), rem1 = nwg1 % G;
          if (rem1 == 0 || bx >= rem1) { const int cgw = (rem1 ? bx - rem1 : bx) * NWAVES + wave, cngw = (rem1 ? G - rem1 : G) * NWAVES;
        { constexpr int CI_N = 2 * (DM / 64) * (DFF / 32);
          unsigned* CMAX = (unsigned*)(ctl + CW_CMAX);
          if (cgw < CI_N) {
            f32x4 ra[8], rb[8]; int it = cgw;
#define CM_DECODE(it_, W_, k0_, n0_, wh_) do { const int wh2_ = (it_) / ((DM / 64) * (DFF / 32)), r_ = (it_) % ((DM / 64) * (DFF / 32)); wh_ = wh2_; W_ = wh2_ ? w_up : w_gate; k0_ = 64 * (r_ / 344); n0_ = 32 * (r_ % 344); } while (0)
            const float* W; int k0, n0, wh;
            CM_DECODE(it, W, k0, n0, wh);
            tr_load(ra, W, DFF, k0, n0, lane);
            for (;;) {
                const int itn = it + cngw; const bool more = itn < CI_N;
                const float* W2 = W; int k02 = k0, n02 = n0, wh2 = wh;
                if (more) { CM_DECODE(itn, W2, k02, n02, wh2); tr_load(rb, W2, DFF, k02, n02, lane); }
                f32x4 mx = {0.f, 0.f, 0.f, 0.f};
#pragma unroll
                for (int j = 0; j < 8; ++j) { const float gk = g_ffn[k0 + 8 * j + (lane >> 3)];
                    mx.x = fmaxf(mx.x, fabsf(ra[j].x * gk)); mx.y = fmaxf(mx.y, fabsf(ra[j].y * gk)); mx.z = fmaxf(mx.z, fabsf(ra[j].z * gk)); mx.w = fmaxf(mx.w, fabsf(ra[j].w * gk)); }
#pragma unroll
                for (int o = 8; o < 64; o <<= 1) { mx.x = fmaxf(mx.x, __shfl_xor(mx.x, o)); mx.y = fmaxf(mx.y, __shfl_xor(mx.y, o)); mx.z = fmaxf(mx.z, __shfl_xor(mx.z, o)); mx.w = fmaxf(mx.w, __shfl_xor(mx.w, o)); }
                if (lane < 8) { unsigned* d = CMAX + wh * DFF + n0 + 4 * lane;
                    __hip_atomic_fetch_max(d + 0, __float_as_uint(mx.x), __ATOMIC_RELAXED, __HIP_MEMORY_SCOPE_AGENT); __hip_atomic_fetch_max(d + 1, __float_as_uint(mx.y), __ATOMIC_RELAXED, __HIP_MEMORY_SCOPE_AGENT);
                    __hip_atomic_fetch_max(d + 2, __float_as_uint(mx.z), __ATOMIC_RELAXED, __HIP_MEMORY_SCOPE_AGENT); __hip_atomic_fetch_max(d + 3, __float_as_uint(mx.w), __ATOMIC_RELAXED, __HIP_MEMORY_SCOPE_AGENT); }
                if (!more) break;
#pragma unroll
                for (int j = 0; j < 8; ++j) ra[j] = rb[j];
                W = W2; k0 = k02; n0 = n02; wh = wh2; it = itn;
            }
#undef CM_DECODE
            { BgJob bo{w_out, w_gate, w_up, w_down, g_ffn, g_of, g_os, Wout_t, Wgu_t, Wdn_t, (const unsigned*)(ctl + CW_CMAX), (const unsigned*)(ctl + CW_CMAXD), lds + BG_OFF + wave * BG_BYTES, cgw, -1, cngw, BG_I_OUT};
              while (bo.have >= 0 || bo.next < bo.end) { bg_step(bo, lane); VM_WAIT(); } }
          } }
        { unsigned* CMAXD = (unsigned*)(ctl + CW_CMAXD);
          for (int it = cgw; it < (DFF / 64) * (DM / 32); it += NGW) { const int kb = it / 128, nb = it % 128; f32x4 r[8];
            tr_load(r, w_down, DM, 64 * kb, 32 * nb, lane);
#define HB4(a, b) { const f32x4 t_ = a; a = t_ + b; b = t_ - b; }
            HB4(r[0], r[1]) HB4(r[2], r[3]) HB4(r[4], r[5]) HB4(r[6], r[7]) HB4(r[0], r[2]) HB4(r[1], r[3]) HB4(r[4], r[6]) HB4(r[5], r[7])
#undef HB4
            const int l3 = lane >> 3; f32x4 mx = {0.f, 0.f, 0.f, 0.f};
#pragma unroll
            for (int b = 0; b < 3; ++b) { const int o = 8 << b; const bool up = (l3 >> b) & 1;
#pragma unroll
                for (int j = 0; j < 8; ++j) { f32x4 p; p.x = __shfl_xor(r[j].x, o); p.y = __shfl_xor(r[j].y, o); p.z = __shfl_xor(r[j].z, o); p.w = __shfl_xor(r[j].w, o); r[j] = up ? p - r[j] : r[j] + p; } }
#pragma unroll
            for (int j = 0; j < 8; ++j) { mx.x = fmaxf(mx.x, fabsf(r[j].x)); mx.y = fmaxf(mx.y, fabsf(r[j].y)); mx.z = fmaxf(mx.z, fabsf(r[j].z)); mx.w = fmaxf(mx.w, fabsf(r[j].w)); }
#pragma unroll
            for (int o = 8; o < 64; o <<= 1) { mx.x = fmaxf(mx.x, __shfl_xor(mx.x, o)); mx.y = fmaxf(mx.y, __shfl_xor(mx.y, o)); mx.z = fmaxf(mx.z, __shfl_xor(mx.z, o)); mx.w = fmaxf(mx.w, __shfl_xor(mx.w, o)); }
            if (lane < 8) { unsigned* d = CMAXD + 32 * nb + 4 * lane;
                __hip_atomic_fetch_max(d + 0, __float_as_uint(mx.x), __ATOMIC_RELAXED, __HIP_MEMORY_SCOPE_AGENT); __hip_atomic_fetch_max(d + 1, __float_as_uint(mx.y), __ATOMIC_RELAXED, __HIP_MEMORY_SCOPE_AGENT);
                __hip_atomic_fetch_max(d + 2, __float_as_uint(mx.z), __ATOMIC_RELAXED, __HIP_MEMORY_SCOPE_AGENT); __hip_atomic_fetch_max(d + 3, __float_as_uint(mx.w), __ATOMIC_RELAXED, __HIP_MEMORY_SCOPE_AGENT); } } }
          } }
        PROBE_T1(1);
        if (BOTH(1)) GRID_BAR();
    }

    if (IN(2)) {
        PROBE_T0(2);
        LAS float* U = (LAS float*)(lds + att::OFF_U); LAS float* scn = (LAS float*)(lds + att::OFF_SCAN);
        constexpr int N_ITEMS = 512 + 512 + 256 + 256;
        float* OSQ = (float*)(ctl + CW_OSQ);
        BgJob bg{w_out, w_gate, w_up, w_down, g_ffn, g_of, g_os, Wout_t, Wgu_t, Wdn_t, (const unsigned*)(ctl + CW_CMAX), (const unsigned*)(ctl + CW_CMAXD), lds + BG_OFF + wave * BG_BYTES, BG_I_OUT + gw, -1, NGW, BG_N - BG_I_D};
#ifndef PROBE_REP2
#define PROBE_REP2 1
#endif
#pragma unroll 1
        for (int prep = 0; prep < PROBE_REP2; ++prep) {
        const long odelta = (prep + 1 < PROBE_REP2) ? (long)((char*)XN - (char*)QO) / 2 : 0l;
        if (prep) GRID_BAR();
        for (int it = vcu; it < N_ITEMS; it += G) {
            if (it < 1024) {
                const int mode = it >> 9, r = it & 511, bh = r >> 2, pi = r & 3, b = bh >> 4, h = bh & 15;
                const bf16* Kp = KVB + (size_t)(mode * 2) * (KV_STRIDE / 2) + (size_t)(b * SEQ) * WG + h * HD;
                const bf16* Vp = Kp + (KV_STRIDE / 2);
                bf16* Qp = QO + (size_t)(b * SEQ) * DM + mode * WG + h * HD;
                if (mode == 0) {
                    const float* lf = out + O_PFL + (size_t)(b * SEQ) * NHG + h;
                    att::scan_u(U, scn, SEQ, [&](int t) { return lf[(size_t)t * NHG]; });
                }
#pragma unroll 1
                for (int pass = 0; pass < 2; ++pass) { const int qb = pass ? 7 - pi : pi; bf16* Qb = Qp + (size_t)(qb * 256) * DM;
                    if (mode == 0) att::attn_unit<0, false>(lds + RING_OFF, Qb, Kp, Vp, Qb + odelta, qb * 256, nullptr, nullptr, nullptr, nullptr, bg, OSQ + 2 * (size_t)(b * SEQ + qb * 256) + mode);
                    if (mode == 1) att::attn_unit<1, false>(lds + RING_OFF, Qb, Kp, Vp, Qb + odelta, qb * 256, nullptr, nullptr, nullptr, nullptr, bg, OSQ + 2 * (size_t)(b * SEQ + qb * 256) + mode);
                }
            } else {
                const int r = it - 1024, mode = r >> 8, bh = r & 255, b = bh >> 4, h = bh & 15;
                bf16* Qb = QO + (size_t)(MP + b * DS) * DM + mode * WG + h * HD;
                const float* Kc = (mode ? cache_sk : cache_fk) + (size_t)(b * PAST) * WG + h * HD; const float* Vc = (mode ? cache_sv : cache_fv) + (size_t)(b * PAST) * WG + h * HD;
                const float* Kn = out + (mode ? O_SSK : O_SFK) + (size_t)(b * DS) * WG + h * HD; const float* Vn = out + (mode ? O_SSV : O_SFV) + (size_t)(b * DS) * WG + h * HD;
                if (mode == 0) {
                    const float* lfc = cache_fl + (size_t)(b * PAST) * NHG + h; const float* lfn = out + O_SFL + (size_t)(b * DS) * NHG + h;
                    att::scan_u(U, scn, TKS, [&](int t) { return t < PAST ? lfc[(size_t)t * NHG] : lfn[(size_t)(t - PAST) * NHG]; });
                    att::attn_unit<0, true>(lds + RING_OFF, Qb, nullptr, nullptr, Qb + odelta, PAST, Kc, Vc, Kn, Vn, bg, OSQ + 2 * (size_t)(MP + b * DS) + mode);
                } else {
                    att::attn_unit<1, true>(lds + RING_OFF, Qb, nullptr, nullptr, Qb + odelta, PAST, Kc, Vc, Kn, Vn, bg, OSQ + 2 * (size_t)(MP + b * DS) + mode);
                }
            }
        }
        while (bg.have >= 0 || bg.next < bg.end) { bg_step(bg, lane); VM_WAIT(); }
        }
        PROBE_T1(2);
        if (BOTH(2)) GRID_BAR();
    }


    float* SSQ = (float*)(ctl + CW_SSQ);
    if (IN(4)) {
        PROBE_T0(4);
        pg8::Gemm g{QO, Wout_t, MT, DM, DM}; pg8::OutOrder S; S.init(MP, DM, DM, G, bx);
#ifndef PROBE_REP4
#define PROBE_REP4 1
#endif
#pragma unroll 1
        for (int rep = 0; rep < PROBE_REP4; ++rep) { if (rep) GRID_BAR();
        pg8::EpiX2 E{XN, (rep + 1 < PROBE_REP4) ? (float*)(ctl + CW_SSQ_DUMMY) : SSQ, PART, (const float*)(ctl + CW_OSQ), (unsigned*)(ctl + CW_AMAX)};
        pg8::gemm_phase<pg8::EpiX2, pg8::OutOrder, true, true, true>(lds + RING_OFF, g, S, E); }
        PROBE_T1(4);
        if (BOTH(4)) GRID_BAR();
    }

    if (IN(5)) {
        unsigned* AMAX = (unsigned*)(ctl + CW_AMAX); unsigned char* XQ = ws + WS_XQ;
        for (int m = gw; m < MT; m += NGW) {
            f32x4 v[16]; float amax;
            if (m >= MP && G == 256) {
                const int ms = m - MP; const f32x4* xr = (const f32x4*)(x_sample + (size_t)ms * DM) + lane; float s = 0.f, mx = 0.f;
#pragma unroll
                for (int j = 0; j < 16; ++j) v[j] = xr[64 * j];
                const float* oq = (const float*)(ctl + CW_OSQ) + 2 * (size_t)m;
                const float rf = rsqrtf(oq[0] * (1.f / WG) + EPS), rs2 = rsqrtf(oq[1] * (1.f / WG) + EPS);
#pragma unroll 1
                for (int ks = 0; ks < 8; ++ks) { const f32x4* pr = (const f32x4*)(PART + (size_t)ks * ((size_t)MS * DM) + (size_t)ms * DM) + lane; const float sc = ks < 4 ? rf : rs2;
#pragma unroll
                    for (int j = 0; j < 16; ++j) v[j] += pr[64 * j] * sc; }
                v2u* o8 = (v2u*)(XN + (size_t)m * DM) + lane;
#pragma unroll
                for (int j = 0; j < 16; ++j) { s += (v[j].x * v[j].x + v[j].y * v[j].y) + (v[j].z * v[j].z + v[j].w * v[j].w);
                    mx = fmaxf(fmaxf(mx, fmaxf(fabsf(v[j].x), fabsf(v[j].y))), fmaxf(fabsf(v[j].z), fabsf(v[j].w)));
                    v2u w; w.x = cvt_pk_bf16(v[j].x, v[j].y); w.y = cvt_pk_bf16(v[j].z, v[j].w); o8[64 * j] = w; }
                s = wave_sum(s);
#pragma unroll
                for (int o = 1; o < 64; o <<= 1) mx = fmaxf(mx, __shfl_xor(mx, o));
                if (lane == 0) { SSQ[m] = s; AMAX[m] = __float_as_uint(mx); }
                amax = mx;
            } else {
                const v2u* x2r = (const v2u*)(XN + (size_t)m * DM) + lane;
#pragma unroll
                for (int j = 0; j < 16; ++j) { const v2u x = x2r[64 * j]; v[j] = (f32x4){bf_lo(x.x), bf_hi(x.x), bf_lo(x.y), bf_hi(x.y)}; }
                amax = __uint_as_float(AMAX[m]);
            }
            const float qs = amax > 0.f ? 127.f / amax : 0.f;
            unsigned* q4 = (unsigned*)(XQ + (size_t)m * DM) + lane;
#pragma unroll
            for (int j = 0; j < 16; ++j) {
                const int a = (int)__builtin_rintf(fminf(fmaxf(v[j].x * qs, -127.f), 127.f)) & 0xff, b = (int)__builtin_rintf(fminf(fmaxf(v[j].y * qs, -127.f), 127.f)) & 0xff;
                const int c = (int)__builtin_rintf(fminf(fmaxf(v[j].z * qs, -127.f), 127.f)) & 0xff, d = (int)__builtin_rintf(fminf(fmaxf(v[j].w * qs, -127.f), 127.f)) & 0xff;
                q4[64 * j] = (unsigned)a | ((unsigned)b << 8) | ((unsigned)c << 16) | ((unsigned)d << 24); }
        }
        if (BOTH(5)) GRID_BAR();
    }

    if (IN(6)) {
        PROBE_T0(6);
#ifndef PROBE_REP6
#define PROBE_REP6 1
#endif
#pragma unroll 1
        for (int rep = 0; rep < PROBE_REP6; ++rep) {
        pg8::Gemm g{(const bf16*)(ws + WS_XQ), Wgu_t, MT, 2 * DFF, DM / 2}; pg8::StaticOrder S; S.init(MT, 2 * DFF, DM / 2, G, bx);
        pg8::EpiGluQ E{ACT, SSQ, (const unsigned*)(ctl + CW_AMAX), (const unsigned*)(ctl + CW_CMAX)};
        pg8::gemm_phase<pg8::EpiGluQ, pg8::StaticOrder, true, true, false, true>(lds + RING_OFF, g, S, E);
        if (rep + 1 == PROBE_REP6) { const int nwg6 = (MT / 256) * (2 * DFF / 256), rem6 = nwg6 % G;
          if (rem6 == 0 || bx >= rem6) { const int cgw = (rem6 ? bx - rem6 : bx) * NWAVES + wave, cngw = (rem6 ? G - rem6 : G) * NWAVES;
            BgJob bd{w_out, w_gate, w_up, w_down, g_ffn, g_of, g_os, Wout_t, Wgu_t, Wdn_t, (const unsigned*)(ctl + CW_CMAX), (const unsigned*)(ctl + CW_CMAXD), lds + BG_OFF + wave * BG_BYTES, BG_N - BG_I_D + cgw, -1, cngw, BG_N};
            while (bd.have >= 0 || bd.next < bd.end) { bg_step(bd, lane); VM_WAIT(); } } }
        PROBE_T1(6);
        if (BOTH(6)) GRID_BAR();
        }
    }

    if (IN(7)) {
        PROBE_T0(7);
        { unsigned* AMAX2 = (unsigned*)(ctl + CW_AMAX2); unsigned char* ACTQ = ws + WS_ACTQ;
#define HB(a, b) { const float t_ = a; a = t_ + b; b = t_ - b; }
#define ROT32(x_, f_) do { f_[0] = bf_lo(x_.x); f_[1] = bf_hi(x_.x); f_[2] = bf_lo(x_.y); f_[3] = bf_hi(x_.y); f_[4] = bf_lo(x_.z); f_[5] = bf_hi(x_.z); f_[6] = bf_lo(x_.w); f_[7] = bf_hi(x_.w); \
            HB(f_[0], f_[1]) HB(f_[2], f_[3]) HB(f_[4], f_[5]) HB(f_[6], f_[7]) HB(f_[0], f_[2]) HB(f_[1], f_[3]) HB(f_[4], f_[6]) HB(f_[5], f_[7]) HB(f_[0], f_[4]) HB(f_[1], f_[5]) HB(f_[2], f_[6]) HB(f_[3], f_[7]) \
            _Pragma("unroll") for (int i_ = 0; i_ < 8; ++i_) { const float p_ = __shfl_xor(f_[i_], 1); f_[i_] = (lane & 1) ? p_ - f_[i_] : f_[i_] + p_; } \
            _Pragma("unroll") for (int i_ = 0; i_ < 8; ++i_) { const float p_ = __shfl_xor(f_[i_], 2); f_[i_] = (lane & 2) ? p_ - f_[i_] : f_[i_] + p_; } } while (0)
          constexpr int NCH = DFF / 8, NIT = (NCH + 63) / 64;
          for (int m = gw; m < MT; m += NGW) {
              const v4u* src_ = (const v4u*)(ACT + (size_t)m * DFF); v2u* dst_ = (v2u*)(ACTQ + (size_t)m * DFF);
              v4u x[NIT];
#pragma unroll
              for (int it = 0; it < NIT; ++it) { const int c = lane + 64 * it; x[it] = src_[c < NCH ? c : NCH - 1]; }
              float mx = 0.f;
#pragma unroll
              for (int it = 0; it < NIT; ++it) { float f[8]; ROT32(x[it], f); float m8 = 0.f;
#pragma unroll
                  for (int i = 0; i < 8; ++i) m8 = fmaxf(m8, fabsf(f[i]));
                  if (lane + 64 * it < NCH) mx = fmaxf(mx, m8); }
#pragma unroll
              for (int o = 1; o < 64; o <<= 1) mx = fmaxf(mx, __shfl_xor(mx, o));
              const float qs = mx > 0.f ? 127.f / mx : 0.f;
#pragma unroll
              for (int it = 0; it < NIT; ++it) { float f[8]; ROT32(x[it], f); int q[8];
#pragma unroll
                  for (int i = 0; i < 8; ++i) q[i] = (int)__builtin_rintf(fminf(fmaxf(f[i] * qs, -127.f), 127.f)) & 0xff;
                  v2u w; w.x = (unsigned)q[0] | ((unsigned)q[1] << 8) | ((unsigned)q[2] << 16) | ((unsigned)q[3] << 24); w.y = (unsigned)q[4] | ((unsigned)q[5] << 8) | ((unsigned)q[6] << 16) | ((unsigned)q[7] << 24);
                  if (lane + 64 * it < NCH) dst_[lane + 64 * it] = w; }
              if (lane == 0) AMAX2[m] = __float_as_uint(mx); }
#undef ROT32
#undef HB
          GRID_BAR(); }
        if (G == 256) {
            pg8::Gemm g{(const bf16*)(ws + WS_ACTQ), Wdn_t, MT, DM, DFF / 2};
            pg8::FusedDownOrder S; S.c = bx; S.nkt_full = DFF / 128;
            pg8::EpiDownFused E{XN, out, PART, (float*)(ctl + CW_SSQ3), (unsigned*)(ctl + CW_CNT7), g_final, (const unsigned*)(ctl + CW_AMAX2), (const unsigned*)(ctl + CW_CMAXD)};
            pg8::gemm_phase<pg8::EpiDownFused, pg8::FusedDownOrder, true, true, false, true>(lds + RING_OFF, g, S, E);
        }
        PROBE_T1(7);
        if (BOTH(7)) GRID_BAR();
    }

    if (IN(8)) {
        PROBE_T0(8);
        for (int m = (G == 256 ? MP : 0) + gw; m < MT; m += NGW) { f32x4* xr = (f32x4*)(out + (size_t)m * DM) + lane; const f32x4* gr = (const f32x4*)g_final + lane;
            f32x4 v[16]; float s = 0.f;
            if (m >= MP && G == 256) {
                const v2u* x2r = (const v2u*)(XN + (size_t)m * DM) + lane;
#pragma unroll
                for (int j = 0; j < 16; ++j) { const v2u x = x2r[64 * j]; v[j] = (f32x4){bf_lo(x.x), bf_hi(x.x), bf_lo(x.y), bf_hi(x.y)}; }
#pragma unroll 1
                for (int ks = 0; ks < 8; ++ks) { const f32x4* pr = (const f32x4*)(PART + (size_t)ks * ((size_t)MS * DM) + (size_t)(m - MP) * DM) + lane;
#pragma unroll
                    for (int j = 0; j < 16; ++j) v[j] += pr[64 * j]; }
            } else {
#pragma unroll
                for (int j = 0; j < 16; ++j) v[j] = xr[64 * j];
            }
#pragma unroll
            for (int j = 0; j < 16; ++j) s += (v[j].x * v[j].x + v[j].y * v[j].y) + (v[j].z * v[j].z + v[j].w * v[j].w);
            const float rstd = rsqrtf(wave_sum(s) * (1.f / DM) + EPS);
#pragma unroll
            for (int j = 0; j < 16; ++j) { const f32x4 gg = gr[64 * j]; xr[64 * j] = v[j] * rstd * gg; } }
        PROBE_T1(8);
    }
#undef IN
#undef BOTH
#undef GRID_BAR
#undef lane
}

extern "C" void kernel_launch(void* const* d_in, const int* in_sizes, int n_in, void* d_out, int out_size, void* d_ws, size_t ws_size, hipStream_t stream) {
    static int grid = 0;
    if (grid == 0) {
        if (n_in != 18 || (size_t)out_size != O_END || ws_size < WS_END) { fprintf(stderr, "kernel_launch: unexpected shapes (n_in %d, out %d, ws %zu)\n", n_in, out_size, ws_size); grid = -1; return; }
        int dev = 0, cus = 0;
        if (hipGetDevice(&dev) != hipSuccess || hipDeviceGetAttribute(&cus, hipDeviceAttributeMultiprocessorCount, dev) != hipSuccess) { grid = -1; return; }
        if (hipFuncSetAttribute((const void*)fwd_kernel, hipFuncAttributeMaxDynamicSharedMemorySize, LDS_BYTES) != hipSuccess) { fprintf(stderr, "kernel_launch: hipFuncSetAttribute failed\n"); grid = -1; return; }
        int per_cu = 0;
        if (hipOccupancyMaxActiveBlocksPerMultiprocessor(&per_cu, (const void*)fwd_kernel, NWAVES * 64, LDS_BYTES) != hipSuccess || per_cu < 1) fprintf(stderr, "kernel_launch: occupancy query says %d\n", per_cu);
        (void)hipGetLastError();
        grid = cus;
    }
    if (grid < 0) return;
    (void)hipMemsetAsync((char*)d_ws + WS_CTL, 0, CTL_ZERO_BYTES, stream);
    Args a{};
    for (int i = 0; i < 18; ++i) a.in[i] = (const float*)d_in[i];
    a.out = (float*)d_out; a.ws = (unsigned char*)d_ws;
#if MK_N_LAUNCHES == 1
    a.ph_lo = 0; a.ph_hi = 9;
    hipLaunchKernelGGL(fwd_kernel, dim3(grid), dim3(NWAVES * 64), LDS_BYTES, stream, a);
#else
    for (int p = 0; p < 9; ++p) { a.ph_lo = p; a.ph_hi = p + 1; hipLaunchKernelGGL(fwd_kernel, dim3(grid), dim3(NWAVES * 64), LDS_BYTES, stream, a); }
#endif
}
```

```cpp
#include <hip/hip_runtime.h>
#include <cstdio>
#include <cstdint>

#ifndef MK_N_LAUNCHES
#define MK_N_LAUNCHES 1
#endif

#define GAS __attribute__((address_space(1)))
#define LAS __attribute__((address_space(3)))
typedef unsigned short bf16;
typedef unsigned v4u __attribute__((ext_vector_type(4)));
typedef unsigned v2u __attribute__((ext_vector_type(2)));
typedef float f32x4 __attribute__((ext_vector_type(4)));
typedef float f32x16 __attribute__((ext_vector_type(16)));
typedef short bf16x8 __attribute__((ext_vector_type(8)));
typedef short s16x4 __attribute__((ext_vector_type(4)));
typedef int i32x4 __attribute__((ext_vector_type(4)));
typedef GAS unsigned gu32;

constexpr int DM = 4096, NB = 8, SEQ = 2048, DB = 16, DS = 32, PAST = 1024, HD = 128, NHG = 16;
constexpr int WG = NHG * HD;
constexpr int DFF = 11008;
constexpr int MP = NB * SEQ, MS = DB * DS, MT = MP + MS;
constexpr int DIN = 3 * WG + NHG + 3 * WG;
constexpr int NIN = 6 * WG + 256;
constexpr int TKS = PAST + DS;
constexpr int KVROWS = MP + DB * TKS;
constexpr float EPS = 1e-6f;
constexpr float LOG2E = 1.4426950408889634f;
constexpr float QSCALE = 0.08838834764831845f * LOG2E;

constexpr size_t O_YP = 0, O_YS = O_YP + (size_t)MP * DM;
constexpr size_t O_PFK = O_YS + (size_t)MS * DM, O_PFV = O_PFK + (size_t)MP * WG, O_PFL = O_PFV + (size_t)MP * WG;
constexpr size_t O_PSK = O_PFL + (size_t)MP * NHG, O_PSV = O_PSK + (size_t)MP * WG;
constexpr size_t O_SFK = O_PSV + (size_t)MP * WG, O_SFV = O_SFK + (size_t)MS * WG, O_SFL = O_SFV + (size_t)MS * WG;
constexpr size_t O_SSK = O_SFL + (size_t)MS * NHG, O_SSV = O_SSK + (size_t)MS * WG, O_END = O_SSV + (size_t)MS * WG;

constexpr size_t MiB = 1u << 20;
constexpr size_t WS_CTL = 0, CTL_ZERO_BYTES = 2 * MiB;
constexpr size_t WS_WIN = 2 * MiB;
constexpr size_t WS_WOUT = 100 * MiB;
constexpr size_t WS_WGU = 132 * MiB;
constexpr size_t WS_WDN = 304 * MiB;
constexpr size_t WS_XN = 390 * MiB;
constexpr size_t WS_QO = 522 * MiB;
constexpr size_t WS_KV = 654 * MiB, KV_STRIDE = 130 * MiB;
constexpr size_t WS_ACT = 654 * MiB;
constexpr size_t WS_PART = 1174 * MiB;
constexpr size_t WS_XQ = 1238 * MiB;
constexpr size_t WS_ACTQ = 1304 * MiB;
constexpr size_t WS_END = 1482 * MiB;
static_assert((size_t)NIN * DM * 2 == 98 * MiB && (size_t)2 * DFF * DM * 2 == 172 * MiB && (size_t)DM * DFF * 2 == 86 * MiB && (size_t)MT * DM * 2 == 132 * MiB && (size_t)KVROWS * WG * 2 == KV_STRIDE, "ws map");
static_assert(WS_ACT + (size_t)MT * DFF * 2 <= WS_PART && WS_KV + 4 * KV_STRIDE == WS_PART && WS_PART + (size_t)8 * MS * DM * 4 == WS_XQ && WS_XQ + (size_t)MT * DM == WS_ACTQ && WS_ACTQ + (size_t)MT * DFF <= WS_END, "ws map");
constexpr int CW_TMO = 0, CW_CODE = 1, CW_BAR = 4096, CW_SSQ = 16384, CW_SSQ_DUMMY = 40960, CW_SSQ3 = 65536, CW_CNT7 = 163840, CW_OSQ = 180224, CW_SSQ0 = 229376, CW_CMAX = 262144, CW_AMAX = 294912, CW_AMAX2 = 311808, CW_CMAXD = 328704;
static_assert(CW_SSQ0 + MT <= CW_CMAX && CW_CMAX + 2 * DFF <= CW_AMAX && CW_AMAX + MT <= CW_AMAX2 && CW_AMAX2 + MT <= CW_CMAXD && (size_t)(CW_CMAXD + DM) * 4 <= CTL_ZERO_BYTES, "ctl");
static_assert(CW_CNT7 + 64 * 64 <= CW_OSQ && CW_OSQ + 2 * MT <= CW_SSQ0 && (CW_SSQ0 + MT) * 4 <= (int)CTL_ZERO_BYTES, "ctl");
static_assert(CW_SSQ_DUMMY + MT <= CW_SSQ3 && CW_SSQ3 + MP <= CW_CNT7 && (CW_CNT7 + 64 * 64) * 4 <= (int)CTL_ZERO_BYTES, "ctl");
static_assert((CW_SSQ + MT) * 4 <= (int)CTL_ZERO_BYTES, "ctl");

constexpr int NWAVES = 8;
constexpr int RING_OFF = 0, RING_BYTES = 131072;
static_assert(78848 + 8 * 8192 >= RING_BYTES && 78848 + 8 * 8192 + 448 <= 147456, "LDS map");
constexpr int BG_OFF = 78848, BG_BYTES = 8192;
constexpr int LDSCTL_OFF = BG_OFF + NWAVES * BG_BYTES, MISC_OFF = LDSCTL_OFF + 320;
constexpr int LDS_BYTES = 147456;

#define RLX_AGENT __ATOMIC_RELAXED, __HIP_MEMORY_SCOPE_AGENT
#define LDS_WAIT() asm volatile("s_waitcnt lgkmcnt(0)" ::: "memory")
#define VM_WAIT() asm volatile("s_waitcnt vmcnt(0)" ::: "memory")

__device__ __forceinline__ unsigned cvt_pk_bf16(float lo, float hi) { unsigned r; asm volatile("v_cvt_pk_bf16_f32 %0, %1, %2" : "=v"(r) : "v"(lo), "v"(hi)); return r; }

namespace pg8 {
#define PG8_LAS __attribute__((address_space(3)))
typedef unsigned short bf16_t;
constexpr int BM = 256, BK = 64, HALF = 128, HTB = HALF * BK * 2, STAGE_BYTES = 8 * HTB, NXCD = 8, WGM = 8;
__host__ __device__ __forceinline__ int lds_byte(int r, int c) { const int st = (r >> 4) * 2 + (c >> 5), rr = r & 15, cc = c & 31, ob = rr * 64 + cc * 2; return st * 1024 + (ob ^ (((ob >> 9) & 1) << 5)); }
__host__ __device__ __forceinline__ void stage_rc(int b, int& R, int& C) { const int st = b / 1024, sb = b % 1024, swz = sb ^ (((sb >> 9) & 1) << 5); R = (st >> 1) * 16 + swz / 64; C = (st & 1) * 32 + (swz % 64) / 2; }
__host__ __device__ __forceinline__ int perm32(int rho) { const int n = rho >> 4, i = rho & 15; return 8 * (i >> 2) + 4 * n + (i & 3); }
struct Unit { int pm, pn, kt0, nkt, ks; };
struct Gemm { const bf16_t* A; const bf16_t* Bt; int M, N, K; };
struct StaticOrder {
    int nM, nN, nwg, G, c, nkt_full;
    __host__ __device__ void init(int M, int N, int K, int G_, int c_) { nM = M / BM; nN = N / BM; nwg = nM * nN; G = G_; c = c_; nkt_full = K / BK; }
    __host__ __device__ __forceinline__ void decode(int L, int& pm, int& pn) const {
        int wgid = L; { const int q = nwg / NXCD, r = nwg % NXCD, xcd = wgid % NXCD, off = wgid / NXCD; wgid = (xcd < r ? xcd * (q + 1) : r * (q + 1) + (xcd - r) * q) + off; }
        const int nig = WGM * nN, gid = wgid / nig, fm = gid * WGM, gsz = (nM - fm) < WGM ? (nM - fm) : WGM;
        pm = fm + ((wgid % nig) % gsz); pn = (wgid % nig) / gsz;
    }
    __host__ __device__ __forceinline__ bool next(int i, Unit& u) const {
        const long L = (long)i * G + c; if (L >= nwg) return false;
        int pm, pn; decode((int)L, pm, pn);
        u.pm = pm; u.pn = pn; u.kt0 = 0; u.nkt = nkt_full; u.ks = -1; return true;
    }
    __device__ __forceinline__ void a_ready(const Unit&) const {}
    __device__ __forceinline__ void done(const Unit&) const {}
};
template <int A, int B, int C> struct TailSplitOrder : StaticOrder {
    __device__ __forceinline__ bool next(int i, Unit& u) const {
        const long L = (long)i * G + c; const bool g256 = (G == 256);
        if (g256 ? (i > 4) : (L >= nwg + 32)) return false;
        const bool stat = g256 ? (i < 4) : (L < nwg), spl = g256 && i == 4;
        const int tile = g256 ? (c >> 3) : (int)(L - nwg), ks = c & 7;
        int pm, pn; decode(stat ? (int)L : 0, pm, pn);
        u.pm = stat ? pm : MP / BM + (tile >> 4); u.pn = stat ? pn : (tile & 15);
        u.ks = spl ? ks : -1; u.kt0 = spl ? (ks < C ? A * ks : A * C + B * (ks - C)) : 0; u.nkt = spl ? (ks < C ? A : B) : nkt_full;
        return true;
    }
};
typedef TailSplitOrder<22, 20, 6> DownOrder;
typedef TailSplitOrder<8, 8, 8> OutOrder;
static_assert(6 * 22 + 2 * 20 == DFF / 64 && 8 * 8 == DM / 64, "K splits");
template <bool I8> struct AccSel { typedef f32x4 T; }; template <> struct AccSel<true> { typedef i32x4 T; };
template <class Epi, class Sched, bool ALIGN_EPI = false, bool SP2 = false, bool MIDK = false, bool I8 = false>
__device__ __forceinline__ void gemm_phase(PG8_LAS unsigned char* lds, const Gemm g, const Sched& S, const Epi& E) {
    const int tid = threadIdx.x, wid = __builtin_amdgcn_readfirstlane(tid >> 6), lane = tid & 63, wr = wid >> 2, wc = wid & 3, fr = lane & 15, fq = lane >> 4;
    const int K = g.K;
    unsigned voffA[2], voffB[2];
#pragma unroll
    for (int i = 0; i < 2; ++i) { int R, C; stage_rc(tid * 16 + i * 8192, R, C); const int Rb = Epi::PERM ? ((R & ~31) + perm32(R & 31)) : R;
        voffA[i] = (unsigned)(R * K + C) * 2u; voffB[i] = (unsigned)(Rb * K + C) * 2u; }
    const size_t kstep = (size_t)(BK * 2);
    const size_t hstep = (size_t)HALF * K * 2;
    const size_t tstep = 2 * hstep;
    const unsigned ldsw = (unsigned)wid * 1024u;
    const int aoff = lds_byte(wr * 64 + fr, fq * 8), boff = lds_byte(wc * 32 + fr, fq * 8);
#define PG8_SA(b, h) (((b) * 2 + (h)) * HTB)
#define PG8_SB(b, h) ((4 + (b) * 2 + (h)) * HTB)
#define PG8_STAGE(bufoff, gbase, voff) do { _Pragma("unroll") for (int _i = 0; _i < 2; ++_i) \
        __builtin_amdgcn_global_load_lds((const unsigned*)((const char*)(gbase) + (voff)[_i]), (PG8_LAS unsigned*)(lds + (bufoff) + ldsw + _i * 8192), 16, 0, 0); } while (0)
#define PG8_LDA(dst, b, h) do { _Pragma("unroll") for (int m = 0; m < 4; ++m) _Pragma("unroll") for (int k = 0; k < 2; ++k) dst[m][k] = *(const PG8_LAS bf16x8*)(lds + PG8_SA(b, h) + aoff + m * 2048 + k * 1024); } while (0)
#define PG8_LDB(dst, b, h) do { _Pragma("unroll") for (int n = 0; n < 2; ++n) _Pragma("unroll") for (int k = 0; k < 2; ++k) dst[n][k] = *(const PG8_LAS bf16x8*)(lds + PG8_SB(b, h) + boff + n * 2048 + k * 1024); } while (0)
#define PG8_MMA(ai, bj, At, Bt) do { __builtin_amdgcn_s_setprio(1); _Pragma("unroll") for (int m = 0; m < 4; ++m) _Pragma("unroll") for (int n = 0; n < 2; ++n) _Pragma("unroll") for (int k = 0; k < 2; ++k) \
        { if constexpr (I8) acc[ai][bj][m][n] = __builtin_amdgcn_mfma_i32_16x16x64_i8(__builtin_bit_cast(i32x4, Bt[n][k]), __builtin_bit_cast(i32x4, At[m][k]), acc[ai][bj][m][n], 0, 0, 0); \
          else acc[ai][bj][m][n] = __builtin_amdgcn_mfma_f32_16x16x32_bf16(Bt[n][k], At[m][k], acc[ai][bj][m][n], 0, 0, 0); } __builtin_amdgcn_s_setprio(0); } while (0)
#define PG8_WAIT_V(n) asm volatile("s_waitcnt vmcnt(" #n ")" ::: "memory")
#define PG8_WAIT_L(n) asm volatile("s_waitcnt lgkmcnt(" #n ")" ::: "memory")
#define PG8_BAR __builtin_amdgcn_s_barrier()
#define PG8_SCHED __builtin_amdgcn_sched_barrier(0)
    Unit cur, nxt; int ui = 0;
    if (!S.next(0, cur)) return;
    typedef typename AccSel<I8>::T acc_t; const acc_t acc_zero = {};
    acc_t acc[2][2][4][2];
#pragma unroll
    for (int a = 0; a < 2; ++a)
#pragma unroll
        for (int b = 0; b < 2; ++b)
#pragma unroll
            for (int m = 0; m < 4; ++m)
#pragma unroll
                for (int n = 0; n < 2; ++n) acc[a][b][m][n] = acc_zero;
    bf16x8 At[4][2], B0[2][2], B1[2][2];
    const char* cA = (const char*)g.A + (size_t)cur.pm * tstep + (size_t)cur.kt0 * kstep; const char* cB = (const char*)g.Bt + (size_t)cur.pn * tstep + (size_t)cur.kt0 * kstep;
    S.a_ready(cur);
    if constexpr (SP2) {
        PG8_STAGE(PG8_SB(0, 0), cB, voffB); PG8_STAGE(PG8_SB(0, 1), cB + hstep, voffB); PG8_STAGE(PG8_SA(0, 0), cA, voffA); PG8_STAGE(PG8_SA(0, 1), cA + hstep, voffA);
        if (wr == 1) PG8_BAR;
        PG8_WAIT_V(2); PG8_BAR;
        PG8_STAGE(PG8_SB(1, 0), cB + kstep, voffB); PG8_STAGE(PG8_SA(1, 0), cA + kstep, voffA); PG8_STAGE(PG8_SB(1, 1), cB + hstep + kstep, voffB);
        PG8_WAIT_V(6); PG8_BAR;
    } else {
        PG8_STAGE(PG8_SB(0, 0), cB, voffB); PG8_STAGE(PG8_SA(0, 0), cA, voffA); PG8_STAGE(PG8_SB(0, 1), cB + hstep, voffB); PG8_STAGE(PG8_SA(0, 1), cA + hstep, voffA);
        if (wr == 1) PG8_BAR;
        PG8_WAIT_V(4); PG8_BAR;
        PG8_STAGE(PG8_SB(1, 0), cB + kstep, voffB); PG8_STAGE(PG8_SA(1, 0), cA + kstep, voffA); PG8_STAGE(PG8_SB(1, 1), cB + hstep + kstep, voffB);
        PG8_WAIT_V(6); PG8_BAR;
    }
    for (;;) {
        const bool has_next = S.next(ui + 1, nxt);
        const char* nA = has_next ? (const char*)g.A + (size_t)nxt.pm * tstep + (size_t)nxt.kt0 * kstep : cA; const char* nB = has_next ? (const char*)g.Bt + (size_t)nxt.pn * tstep + (size_t)nxt.kt0 * kstep : cB;
        const int nt = cur.nkt;
        for (int t = 0; t < nt; t += 2) {
            const bool last = (t == nt - 2);
            const char* a1 = cA + (size_t)(t + 1) * kstep;
            const char* a2 = last ? nA : cA + (size_t)(t + 2) * kstep; const char* b2 = last ? nB : cB + (size_t)(t + 2) * kstep;
            const char* a3 = a2 + kstep; const char* b3 = b2 + kstep;
            if (last && has_next) S.a_ready(nxt);
            if constexpr (MIDK) { if (t == (nt >> 1) && cur.ks < 0) E.midk(acc, cur, wr, wc, fr, fq); }
            if constexpr (SP2) {
            PG8_LDB(B0, 0, 0); PG8_LDB(B1, 0, 1); PG8_SCHED; PG8_LDA(At, 0, 0); PG8_STAGE(PG8_SA(1, 1), a1 + hstep, voffA);
            PG8_WAIT_V(8); PG8_WAIT_L(0); PG8_BAR; PG8_MMA(0, 0, At, B0); PG8_MMA(0, 1, At, B1); PG8_BAR; PG8_SCHED;
            PG8_LDA(At, 0, 1); PG8_STAGE(PG8_SB(0, 0), b2, voffB); PG8_STAGE(PG8_SB(0, 1), b2 + hstep, voffB); PG8_STAGE(PG8_SA(0, 0), a2, voffA);
            PG8_WAIT_V(8); PG8_WAIT_L(0); PG8_BAR; PG8_MMA(1, 0, At, B0); PG8_MMA(1, 1, At, B1); PG8_BAR; PG8_SCHED;
            PG8_LDB(B0, 1, 0); PG8_LDB(B1, 1, 1); PG8_SCHED; PG8_LDA(At, 1, 0); PG8_STAGE(PG8_SA(0, 1), a2 + hstep, voffA);
            PG8_WAIT_V(8); PG8_WAIT_L(0); PG8_BAR; PG8_MMA(0, 0, At, B0); PG8_MMA(0, 1, At, B1); PG8_BAR; PG8_SCHED;
            PG8_LDA(At, 1, 1); PG8_STAGE(PG8_SB(1, 0), b3, voffB); PG8_STAGE(PG8_SB(1, 1), b3 + hstep, voffB); PG8_STAGE(PG8_SA(1, 0), a3, voffA);
            PG8_WAIT_V(8); PG8_WAIT_L(0); PG8_BAR; PG8_MMA(1, 0, At, B0); PG8_MMA(1, 1, At, B1); PG8_BAR; PG8_SCHED;
            } else {
            PG8_LDB(B0, 0, 0); PG8_SCHED; PG8_LDA(At, 0, 0); PG8_STAGE(PG8_SA(1, 1), a1 + hstep, voffA);
            PG8_WAIT_L(8); PG8_BAR; PG8_WAIT_L(0); PG8_MMA(0, 0, At, B0); PG8_BAR; PG8_SCHED;
            PG8_LDB(B1, 0, 1); PG8_STAGE(PG8_SB(0, 0), b2, voffB);
            PG8_BAR; PG8_WAIT_L(0); PG8_MMA(0, 1, At, B1); PG8_BAR;
            PG8_LDA(At, 0, 1); PG8_STAGE(PG8_SA(0, 0), a2, voffA);
            PG8_BAR; PG8_WAIT_L(0); PG8_MMA(1, 0, At, B0); PG8_BAR; PG8_SCHED;
            PG8_STAGE(PG8_SB(0, 1), b2 + hstep, voffB);
            PG8_WAIT_V(6); PG8_BAR; PG8_MMA(1, 1, At, B1); PG8_BAR;
            PG8_LDB(B0, 1, 0); PG8_SCHED; PG8_LDA(At, 1, 0); PG8_STAGE(PG8_SA(0, 1), a2 + hstep, voffA);
            PG8_WAIT_L(8); PG8_BAR; PG8_WAIT_L(0); PG8_MMA(0, 0, At, B0); PG8_BAR; PG8_SCHED;
            PG8_LDB(B1, 1, 1); PG8_STAGE(PG8_SB(1, 0), b3, voffB);
            PG8_BAR; PG8_WAIT_L(0); PG8_MMA(0, 1, At, B1); PG8_BAR;
            PG8_LDA(At, 1, 1); PG8_STAGE(PG8_SA(1, 0), a3, voffA);
            PG8_BAR; PG8_WAIT_L(0); PG8_MMA(1, 0, At, B0); PG8_BAR; PG8_SCHED;
            PG8_STAGE(PG8_SB(1, 1), b3 + hstep, voffB);
            PG8_WAIT_V(6); PG8_BAR; PG8_MMA(1, 1, At, B1); PG8_BAR;
            }
        }
        if constexpr (ALIGN_EPI) { if (wr == 0) PG8_BAR; }
        E(acc, cur, wr, wc, fr, fq); S.done(cur);
        if (!has_next) break;
#pragma unroll
        for (int a = 0; a < 2; ++a)
#pragma unroll
            for (int b = 0; b < 2; ++b)
#pragma unroll
                for (int m = 0; m < 4; ++m)
#pragma unroll
                    for (int n = 0; n < 2; ++n) acc[a][b][m][n] = acc_zero;
        cur = nxt; cA = nA; cB = nB; ++ui;
        if constexpr (ALIGN_EPI) { if (wr == 1) PG8_BAR; }
    }
    PG8_WAIT_V(0);
    if constexpr (!ALIGN_EPI) { if (wr == 0) PG8_BAR; }
    PG8_BAR;
#undef PG8_SA
#undef PG8_SB
#undef PG8_STAGE
#undef PG8_LDA
#undef PG8_LDB
#undef PG8_MMA
#undef PG8_WAIT_V
#undef PG8_WAIT_L
#undef PG8_BAR
#undef PG8_SCHED
}

__device__ __forceinline__ float log_sigmoid_f(float x) { return -(fmaxf(-x, 0.f) + log1pf(expf(-fabsf(x)))); }
struct EpiIn {
    static constexpr bool PERM = true;
    bf16_t* QO; bf16_t* KV; float* out; const float* bfg; const float* ssq0;
    __device__ __forceinline__ void operator()(const f32x4 (&acc)[2][2][4][2], const Unit& u, int wr, int wc, int fr, int fq) const {
        const int seg = u.pn >> 3;
        const int row0 = u.pm * BM + wr * 64 + fr;
        const int cseg = (u.pn & 7) * BM + wc * 32 + 8 * fq;
        const bool prompt = u.pm < (MP / BM);
        if (seg == 6) {
            if (wc == 0 && fq < 2) {
                const f32x4 b0 = *(const f32x4*)(bfg + 8 * fq), b1 = *(const f32x4*)(bfg + 8 * fq + 4);
#pragma unroll
                for (int ai = 0; ai < 2; ++ai)
#pragma unroll
                    for (int m = 0; m < 4; ++m) { const int row = row0 + ai * HALF + m * 16; const float rstd = rsqrtf(ssq0[row] * (1.f / DM) + EPS);
                        float* dst = prompt ? out + O_PFL + (size_t)row * NHG + 8 * fq : out + O_SFL + (size_t)(row - MP) * NHG + 8 * fq;
                        const f32x4 v0 = acc[ai][0][m][0] * rstd + b0, v1 = acc[ai][0][m][1] * rstd + b1; f32x4 r0, r1;
#pragma unroll
                        for (int j = 0; j < 4; ++j) { r0[j] = log_sigmoid_f(v0[j]); r1[j] = log_sigmoid_f(v1[j]); }
                        *(f32x4*)dst = r0; *(f32x4*)(dst + 4) = r1; }
            }
        } else if (seg == 0 || seg == 3) {
            bf16_t* base = QO + (seg == 3 ? WG : 0) + cseg;
#pragma unroll
            for (int ai = 0; ai < 2; ++ai)
#pragma unroll
                for (int m = 0; m < 4; ++m) { const int row = row0 + ai * HALF + m * 16; bf16_t* rowp = base + (size_t)row * DM; const float qs = rsqrtf(ssq0[row] * (1.f / DM) + EPS) * QSCALE;
#pragma unroll
                    for (int bj = 0; bj < 2; ++bj) { const f32x4 v0 = acc[ai][bj][m][0] * qs, v1 = acc[ai][bj][m][1] * qs;
                        v4u w; w.x = cvt_pk_bf16(v0[0], v0[1]); w.y = cvt_pk_bf16(v0[2], v0[3]); w.z = cvt_pk_bf16(v1[0], v1[1]); w.w = cvt_pk_bf16(v1[2], v1[3]);
                        *(v4u*)(rowp + bj * HALF) = w; } }
        } else {
            const int kvi = (seg == 1) ? 0 : (seg == 2) ? 1 : (seg == 4) ? 2 : 3;
            bf16_t* kvb = KV + (size_t)kvi * (KV_STRIDE / 2) + cseg;
            float* ob = out + (prompt ? O_PFK + (size_t)kvi * ((size_t)MP * WG) + (kvi >= 2 ? (size_t)MP * NHG : 0)
                                      : O_SFK + (size_t)kvi * ((size_t)MS * WG) + (kvi >= 2 ? (size_t)MS * NHG : 0)) + cseg;
#pragma unroll
            for (int ai = 0; ai < 2; ++ai)
#pragma unroll
                for (int m = 0; m < 4; ++m) { const int row = row0 + ai * HALF + m * 16; const int rs = row - MP;
                    const int kvrow = prompt ? row : MP + (rs >> 5) * TKS + PAST + (rs & 31);
                    const int orow = prompt ? row : rs;
                    bf16_t* rowp = kvb + (size_t)kvrow * WG; float* op = ob + (size_t)orow * WG; const float rstd = rsqrtf(ssq0[row] * (1.f / DM) + EPS);
#pragma unroll
                    for (int bj = 0; bj < 2; ++bj) { const f32x4 v0 = acc[ai][bj][m][0] * rstd, v1 = acc[ai][bj][m][1] * rstd;
                        v4u w; w.x = cvt_pk_bf16(v0[0], v0[1]); w.y = cvt_pk_bf16(v0[2], v0[3]); w.z = cvt_pk_bf16(v1[0], v1[1]); w.w = cvt_pk_bf16(v1[2], v1[3]);
                        if (prompt) *(v4u*)(rowp + bj * HALF) = w;
                        *(f32x4*)(op + bj * HALF) = v0; *(f32x4*)(op + bj * HALF + 4) = v1; } }
        }
    }
};
struct EpiX2 {
    static constexpr bool PERM = true;
    bf16_t* X2; float* ssq; float* part; const float* osq; unsigned* amax;
    __device__ __forceinline__ void midk(f32x4 (&acc)[2][2][4][2], const Unit& u, int wr, int wc, int fr, int fq) const {
        const int row0 = u.pm * BM + wr * 64 + fr;
#pragma unroll
        for (int ai = 0; ai < 2; ++ai)
#pragma unroll
            for (int m = 0; m < 4; ++m) { const int row = row0 + ai * HALF + m * 16;
                const float a = osq[2 * row], b = osq[2 * row + 1];
                const float ratio = rsqrtf(a * (1.f / WG) + EPS) / rsqrtf(b * (1.f / WG) + EPS);
#pragma unroll
                for (int bj = 0; bj < 2; ++bj)
#pragma unroll
                    for (int n = 0; n < 2; ++n) acc[ai][bj][m][n] = acc[ai][bj][m][n] * ratio; }
    }
    __device__ __forceinline__ void operator()(const f32x4 (&acc)[2][2][4][2], const Unit& u, int wr, int wc, int fr, int fq) const {
        const int row0 = u.pm * BM + wr * 64 + fr, col0 = u.pn * BM + wc * 32 + 8 * fq;
        if (u.ks >= 0) {
            float* pb = part + (size_t)u.ks * ((size_t)MS * DM);
#pragma unroll
            for (int ai = 0; ai < 2; ++ai)
#pragma unroll
                for (int m = 0; m < 4; ++m) { float* op = pb + (size_t)(row0 + ai * HALF + m * 16 - MP) * DM + col0;
#pragma unroll
                    for (int bj = 0; bj < 2; ++bj) { *(f32x4*)(op + bj * HALF) = acc[ai][bj][m][0]; *(f32x4*)(op + bj * HALF + 4) = acc[ai][bj][m][1]; } }
            return;
        }
#pragma unroll
        for (int ai = 0; ai < 2; ++ai)
#pragma unroll
            for (int m = 0; m < 4; ++m) { const int row = row0 + ai * HALF + m * 16;
                bf16_t* op = X2 + (size_t)row * DM + col0;
                f32x4 rv[2][2];
#pragma unroll
                for (int bj = 0; bj < 2; ++bj) { const v4u x = *(const v4u*)(op + bj * HALF);
                    rv[bj][0] = (f32x4){__uint_as_float(x.x << 16), __uint_as_float(x.x & 0xffff0000u), __uint_as_float(x.y << 16), __uint_as_float(x.y & 0xffff0000u)};
                    rv[bj][1] = (f32x4){__uint_as_float(x.z << 16), __uint_as_float(x.z & 0xffff0000u), __uint_as_float(x.w << 16), __uint_as_float(x.w & 0xffff0000u)}; }
                const float rs2 = rsqrtf(osq[2 * row + 1] * (1.f / WG) + EPS);
                float s = 0.f, mx = 0.f;
#pragma unroll
                for (int bj = 0; bj < 2; ++bj) { const f32x4 v0 = acc[ai][bj][m][0] * rs2 + rv[bj][0], v1 = acc[ai][bj][m][1] * rs2 + rv[bj][1];
                    s += (v0[0] * v0[0] + v0[1] * v0[1]) + (v0[2] * v0[2] + v0[3] * v0[3]) + (v1[0] * v1[0] + v1[1] * v1[1]) + (v1[2] * v1[2] + v1[3] * v1[3]);
                    mx = fmaxf(fmaxf(fmaxf(mx, fmaxf(fabsf(v0[0]), fabsf(v0[1]))), fmaxf(fabsf(v0[2]), fabsf(v0[3]))), fmaxf(fmaxf(fabsf(v1[0]), fabsf(v1[1])), fmaxf(fabsf(v1[2]), fabsf(v1[3]))));
                    v4u w; w.x = cvt_pk_bf16(v0[0], v0[1]); w.y = cvt_pk_bf16(v0[2], v0[3]); w.z = cvt_pk_bf16(v1[0], v1[1]); w.w = cvt_pk_bf16(v1[2], v1[3]);
                    *(v4u*)(op + bj * HALF) = w; }
                s += __shfl_xor(s, 16); s += __shfl_xor(s, 32); mx = fmaxf(mx, __shfl_xor(mx, 16)); mx = fmaxf(mx, __shfl_xor(mx, 32));
                if (fq == 0) { __hip_atomic_fetch_add(ssq + row, s, __ATOMIC_RELAXED, __HIP_MEMORY_SCOPE_AGENT);
                               __hip_atomic_fetch_max(amax + row, __float_as_uint(mx), __ATOMIC_RELAXED, __HIP_MEMORY_SCOPE_AGENT); } }
    }
};
struct EpiDown {
    static constexpr bool PERM = true;
    const bf16_t* X2; float* out; float* part;
    __device__ __forceinline__ void operator()(const f32x4 (&acc)[2][2][4][2], const Unit& u, int wr, int wc, int fr, int fq) const {
        const int row0 = u.pm * BM + wr * 64 + fr, col0 = u.pn * BM + wc * 32 + 8 * fq;
        if (u.ks >= 0) {
            float* pb = part + (size_t)u.ks * ((size_t)MS * DM);
#pragma unroll
            for (int ai = 0; ai < 2; ++ai)
#pragma unroll
                for (int m = 0; m < 4; ++m) { float* op = pb + (size_t)(row0 + ai * HALF + m * 16 - MP) * DM + col0;
#pragma unroll
                    for (int bj = 0; bj < 2; ++bj) { *(f32x4*)(op + bj * HALF) = acc[ai][bj][m][0]; *(f32x4*)(op + bj * HALF + 4) = acc[ai][bj][m][1]; } }
            return;
        }
#pragma unroll
        for (int ai = 0; ai < 2; ++ai)
#pragma unroll
            for (int m = 0; m < 4; ++m) { const size_t off = (size_t)(row0 + ai * HALF + m * 16) * DM + col0;
                v4u xv[2];
#pragma unroll
                for (int bj = 0; bj < 2; ++bj) xv[bj] = *(const v4u*)(X2 + off + bj * HALF);
#pragma unroll
                for (int bj = 0; bj < 2; ++bj) { const v4u x = xv[bj];
                    const f32x4 r0 = {__uint_as_float(x.x << 16), __uint_as_float(x.x & 0xffff0000u), __uint_as_float(x.y << 16), __uint_as_float(x.y & 0xffff0000u)};
                    const f32x4 r1 = {__uint_as_float(x.z << 16), __uint_as_float(x.z & 0xffff0000u), __uint_as_float(x.w << 16), __uint_as_float(x.w & 0xffff0000u)};
                    *(f32x4*)(out + off + bj * HALF) = acc[ai][bj][m][0] + r0; *(f32x4*)(out + off + bj * HALF + 4) = acc[ai][bj][m][1] + r1; } }
    }
};
struct FusedDownOrder {
    int c, nkt_full;
    __device__ __forceinline__ bool next(int i, Unit& u) const {
        if (i > 4) return false;
        const bool spl = (i == 4); const int x = c & 7, j = c >> 3, tile = c >> 3, ks = c & 7;
        u.pm = spl ? MP / BM + (tile >> 4) : 16 * i + 4 * (x >> 1) + (j >> 3); u.pn = spl ? (tile & 15) : 8 * (x & 1) + (j & 7);
        u.ks = spl ? ks : -1; u.kt0 = spl ? (ks < 3 ? 12 * ks : 36 + 10 * (ks - 3)) : 0; u.nkt = spl ? (ks < 3 ? 12 : 10) : nkt_full;
        return true;
    }
    __device__ __forceinline__ void a_ready(const Unit&) const {}
    __device__ __forceinline__ void done(const Unit&) const {}
};
struct EpiDownFused {
    static constexpr bool PERM = true;
    const bf16_t* X2; float* out; float* part; float* ssq3; unsigned* cnt; const float* gfin; const unsigned* amax2; const unsigned* cmaxd;
    __device__ __forceinline__ void operator()(const i32x4 (&acc)[2][2][4][2], const Unit& u, int wr, int wc, int fr, int fq) const {
        const int row0 = u.pm * BM + wr * 64 + fr, col0 = u.pn * BM + wc * 32 + 8 * fq;
#define ACCF(a) ((f32x4){(float)(a)[0], (float)(a)[1], (float)(a)[2], (float)(a)[3]})
#define LDSB(bj, n) ({ const v4u c_ = *(const v4u*)(cmaxd + col0 + (bj) * HALF + 4 * (n)); (f32x4){__uint_as_float(c_.x), __uint_as_float(c_.y), __uint_as_float(c_.z), __uint_as_float(c_.w)} * (1.f / 127.f); })
        if (u.ks >= 0) {
            float* pb = part + (size_t)u.ks * ((size_t)MS * DM);
            f32x4 sb[2][2];
#pragma unroll
            for (int bj = 0; bj < 2; ++bj)
#pragma unroll
                for (int n = 0; n < 2; ++n) sb[bj][n] = LDSB(bj, n);
#pragma unroll
            for (int ai = 0; ai < 2; ++ai)
#pragma unroll
                for (int m = 0; m < 4; ++m) { const int row = row0 + ai * HALF + m * 16; float* op = pb + (size_t)(row - MP) * DM + col0; const float sa = __uint_as_float(amax2[row]) * (1.f / (127.f * 32.f));
#pragma unroll
                    for (int bj = 0; bj < 2; ++bj) { *(f32x4*)(op + bj * HALF) = ACCF(acc[ai][bj][m][0]) * sa * sb[bj][0]; *(f32x4*)(op + bj * HALF + 4) = ACCF(acc[ai][bj][m][1]) * sa * sb[bj][1]; } }
            return;
        }
#define X2F(x, r0, r1) const f32x4 r0 = {__uint_as_float(x.x << 16), __uint_as_float(x.x & 0xffff0000u), __uint_as_float(x.y << 16), __uint_as_float(x.y & 0xffff0000u)}; \
                       const f32x4 r1 = {__uint_as_float(x.z << 16), __uint_as_float(x.z & 0xffff0000u), __uint_as_float(x.w << 16), __uint_as_float(x.w & 0xffff0000u)}
        { f32x4 sb[2][2];
#pragma unroll
          for (int bj = 0; bj < 2; ++bj)
#pragma unroll
              for (int n = 0; n < 2; ++n) sb[bj][n] = LDSB(bj, n);
#pragma unroll
          for (int ai = 0; ai < 2; ++ai)
#pragma unroll
            for (int m = 0; m < 4; ++m) { const int row = row0 + ai * HALF + m * 16; const size_t off = (size_t)row * DM + col0; float s = 0.f; const float sa = __uint_as_float(amax2[row]) * (1.f / (127.f * 32.f));
#pragma unroll
                for (int bj = 0; bj < 2; ++bj) { const v4u x = *(const v4u*)(X2 + off + bj * HALF); X2F(x, r0, r1);
                    const f32x4 v0 = ACCF(acc[ai][bj][m][0]) * sa * sb[bj][0] + r0, v1 = ACCF(acc[ai][bj][m][1]) * sa * sb[bj][1] + r1;
                    s += (v0[0] * v0[0] + v0[1] * v0[1]) + (v0[2] * v0[2] + v0[3] * v0[3]) + (v1[0] * v1[0] + v1[1] * v1[1]) + (v1[2] * v1[2] + v1[3] * v1[3]); }
                s += __shfl_xor(s, 16); s += __shfl_xor(s, 32);
                if (fq == 0) __hip_atomic_fetch_add(ssq3 + row, s, __ATOMIC_RELAXED, __HIP_MEMORY_SCOPE_AGENT);
                asm volatile("" ::: "memory"); } }
        asm volatile("s_waitcnt vmcnt(0)" ::: "memory");
        unsigned* cw = cnt + 64 * u.pm;
        if (fr == 0 && fq == 0) __hip_atomic_fetch_add(cw, 1u, __ATOMIC_RELAXED, __HIP_MEMORY_SCOPE_AGENT);
        { unsigned sp = 0;
          while ((unsigned)__builtin_amdgcn_readfirstlane(__hip_atomic_load(cw, __ATOMIC_RELAXED, __HIP_MEMORY_SCOPE_AGENT)) < 128u) { __builtin_amdgcn_s_sleep(2); if (++sp > (1u << 16)) break; } }
#pragma unroll
        for (int ai = 0; ai < 2; ++ai)
#pragma unroll
            for (int m = 0; m < 4; ++m) { const int row = row0 + ai * HALF + m * 16; const size_t off = (size_t)row * DM + col0; const float sa = __uint_as_float(amax2[row]) * (1.f / (127.f * 32.f));
                const float rstd = rsqrtf(__hip_atomic_load(ssq3 + row, __ATOMIC_RELAXED, __HIP_MEMORY_SCOPE_AGENT) * (1.f / DM) + EPS);
#pragma unroll
                for (int bj = 0; bj < 2; ++bj) { const v4u x = *(const v4u*)(X2 + off + bj * HALF); X2F(x, r0, r1);
                    i32x4 a0 = acc[ai][bj][m][0], a1 = acc[ai][bj][m][1]; asm volatile("" : "+v"(a0), "+v"(a1));
                    const f32x4 g0 = *(const f32x4*)(gfin + col0 + bj * HALF), g1 = *(const f32x4*)(gfin + col0 + bj * HALF + 4), b0 = LDSB(bj, 0), b1 = LDSB(bj, 1);
                    *(f32x4*)(out + off + bj * HALF) = (ACCF(a0) * sa * b0 + r0) * rstd * g0; *(f32x4*)(out + off + bj * HALF + 4) = (ACCF(a1) * sa * b1 + r1) * rstd * g1; }
                asm volatile("" ::: "memory"); }
#undef X2F
#undef LDSB
#undef ACCF
    }
};
struct EpiGluQ {
    static constexpr bool PERM = true;
    bf16_t* ACT; const float* ssq; const unsigned* amax; const unsigned* cmax;
    __device__ __forceinline__ void operator()(const i32x4 (&acc)[2][2][4][2], const Unit& u, int wr, int wc, int fr, int fq) const {
        const int row0 = u.pm * BM + wr * 64 + fr, col0 = u.pn * HALF + wc * 32 + 8 * fq;
        float sg[8], su[8];
#pragma unroll
        for (int j = 0; j < 8; ++j) { sg[j] = __uint_as_float(cmax[col0 + j]) * (1.f / 127.f); su[j] = __uint_as_float(cmax[DFF + col0 + j]) * (1.f / 127.f); }
#pragma unroll
        for (int ai = 0; ai < 2; ++ai)
#pragma unroll
            for (int m = 0; m < 4; ++m) { const int row = row0 + ai * HALF + m * 16; bf16_t* rowp = ACT + (size_t)row * DFF + col0; float r[8];
                const float sa = __uint_as_float(amax[row]) * (1.f / 127.f) * rsqrtf(ssq[row] * (1.f / DM) + EPS);
#pragma unroll
                for (int n = 0; n < 2; ++n)
#pragma unroll
                    for (int j = 0; j < 4; ++j) { const float g = (float)acc[ai][0][m][n][j] * (sa * sg[n * 4 + j]), up = (float)acc[ai][1][m][n][j] * (sa * su[n * 4 + j]);
                        r[n * 4 + j] = g * __builtin_amdgcn_rcpf(1.0f + __builtin_amdgcn_exp2f(-g * LOG2E)) * up; }
                v4u w; w.x = cvt_pk_bf16(r[0], r[1]); w.y = cvt_pk_bf16(r[2], r[3]); w.z = cvt_pk_bf16(r[4], r[5]); w.w = cvt_pk_bf16(r[6], r[7]);
                *(v4u*)rowp = w; }
    }
};
}


struct BgJob {
    const float *w_out, *w_gate, *w_up, *w_down, *g_ffn, *g_of, *g_os; bf16 *Wout_t, *Wgu_t, *Wdn_t; const unsigned* cmax; const unsigned* cmaxd; LAS unsigned char* scr;
    int next, have, stride, end;
};
constexpr int BG_I_OUT = (DM / 64) * (DM / 32), BG_I_G = (DM / 64) * (DFF / 32), BG_I_D = (DFF / 64) * (DM / 32), BG_N = BG_I_OUT + 2 * BG_I_G + BG_I_D;
#define BG_DECODE(it_, W_, ldw_, K_, k0_, n0_, WT_, dr_, ksc_, cm_) do { int r_ = (it_); ksc_ = nullptr; cm_ = nullptr; \
        if (r_ < BG_I_OUT) { const int kb = r_ / 128, nb = r_ % 128; W_ = B.w_out; ldw_ = DM; K_ = DM; WT_ = B.Wout_t; k0_ = 64 * kb; n0_ = 32 * nb; dr_ = 32 * nb; ksc_ = k0_ < WG ? B.g_of : B.g_os - WG; } \
        else if ((r_ -= BG_I_OUT) < BG_I_G) { const int kb = r_ / 344, nb = r_ % 344; W_ = B.w_gate; ldw_ = DFF; K_ = DM; WT_ = B.Wgu_t; ksc_ = B.g_ffn; k0_ = 64 * kb; n0_ = 32 * nb; dr_ = (n0_ >> 7) * 256 + (n0_ & 127); cm_ = B.cmax + n0_; } \
        else if ((r_ -= BG_I_G) < BG_I_G) { const int kb = r_ / 344, nb = r_ % 344; W_ = B.w_up; ldw_ = DFF; K_ = DM; WT_ = B.Wgu_t; ksc_ = B.g_ffn; k0_ = 64 * kb; n0_ = 32 * nb; dr_ = (n0_ >> 7) * 256 + 128 + (n0_ & 127); cm_ = B.cmax + DFF + n0_; } \
        else { r_ -= BG_I_G; const int kb = r_ / 128, nb = r_ % 128; W_ = B.w_down; ldw_ = DM; K_ = DFF; WT_ = B.Wdn_t; k0_ = 64 * kb; n0_ = 32 * nb; dr_ = 32 * nb; cm_ = B.cmaxd + n0_; } } while (0)
__device__ __forceinline__ void bg_step(BgJob& B, int lane) {
    const float* W; const float* ksc; const unsigned* cm; bf16* WT; int ldw, K, k0, n0, dr;
    if (B.have >= 0) {
        BG_DECODE(B.have, W, ldw, K, k0, n0, WT, dr, ksc, cm);
        const int c8 = lane & 7, nsub = lane >> 3; LAS const float* s = (LAS const float*)B.scr + (8 * c8) * 32;
        f32x4 s0 = {1.f, 1.f, 1.f, 1.f}, s1 = s0;
        if (ksc) { s0 = *(const f32x4*)(ksc + k0 + 8 * c8); s1 = *(const f32x4*)(ksc + k0 + 8 * c8 + 4); }
        if (cm) {
#pragma unroll
            for (int jn = 0; jn < 4; ++jn) { const int n = nsub + 8 * jn, o = (((n >> 2) ^ c8) << 2) + (n & 3);
                const float cmv = __uint_as_float(cm[n]), qs = cmv > 0.f ? 127.f / cmv : 0.f; int q[8];
                float v[8] = {s[o] * s0.x, s[o + 32] * s0.y, s[o + 64] * s0.z, s[o + 96] * s0.w, s[o + 128] * s1.x, s[o + 160] * s1.y, s[o + 192] * s1.z, s[o + 224] * s1.w};
                if (K == DFF) {
#define HB(a, b) { const float t_ = a; a = t_ + b; b = t_ - b; }
                    HB(v[0], v[1]) HB(v[2], v[3]) HB(v[4], v[5]) HB(v[6], v[7]) HB(v[0], v[2]) HB(v[1], v[3]) HB(v[4], v[6]) HB(v[5], v[7]) HB(v[0], v[4]) HB(v[1], v[5]) HB(v[2], v[6]) HB(v[3], v[7])
#undef HB
#pragma unroll
                    for (int i = 0; i < 8; ++i) { const float p = __shfl_xor(v[i], 1); v[i] = (c8 & 1) ? p - v[i] : v[i] + p; }
#pragma unroll
                    for (int i = 0; i < 8; ++i) { const float p = __shfl_xor(v[i], 2); v[i] = (c8 & 2) ? p - v[i] : v[i] + p; }
                }
#pragma unroll
                for (int i = 0; i < 8; ++i) q[i] = (int)__builtin_rintf(fminf(fmaxf(v[i] * qs, -127.f), 127.f)) & 0xff;
                v2u w; w.x = (unsigned)q[0] | ((unsigned)q[1] << 8) | ((unsigned)q[2] << 16) | ((unsigned)q[3] << 24); w.y = (unsigned)q[4] | ((unsigned)q[5] << 8) | ((unsigned)q[6] << 16) | ((unsigned)q[7] << 24);
                *(GAS v2u*)((unsigned char*)WT + (size_t)(dr + n) * K + k0 + 8 * c8) = w; }
        } else {
#pragma unroll
        for (int jn = 0; jn < 4; ++jn) { const int n = nsub + 8 * jn, o = (((n >> 2) ^ c8) << 2) + (n & 3);
            v4u w; w.x = cvt_pk_bf16(s[o] * s0.x, s[o + 32] * s0.y); w.y = cvt_pk_bf16(s[o + 64] * s0.z, s[o + 96] * s0.w);
            w.z = cvt_pk_bf16(s[o + 128] * s1.x, s[o + 160] * s1.y); w.w = cvt_pk_bf16(s[o + 192] * s1.z, s[o + 224] * s1.w);
            *(GAS v4u*)(WT + (size_t)(dr + n) * K + k0 + 8 * c8) = w; }
        }
        LDS_WAIT(); asm volatile("" ::: "memory");
        B.have = -1;
    }
    if (B.next < B.end) {
        BG_DECODE(B.next, W, ldw, K, k0, n0, WT, dr, ksc, cm);
        const float* p = W + (size_t)(k0 + (lane >> 3)) * ldw + n0;
#pragma unroll
        for (int j = 0; j < 8; ++j) __builtin_amdgcn_global_load_lds((const unsigned*)(p + (size_t)(8 * j) * ldw + 4 * ((lane & 7) ^ j)), (LAS unsigned*)(B.scr + j * 1024), 16, 0, 0);
        B.have = B.next; B.next += B.stride;
    }
}
#undef BG_DECODE

namespace att {
constexpr int SHM_V = 16384, SHM_K = 16384;
constexpr int OFF_V = 0, OFF_K = 2 * SHM_V, OFF_WS = 4 * 16384, OFF_U = OFF_WS + NWAVES * 256, OFF_SCAN = OFF_U + (2048 + 64) * 4, OFF_FLAG = OFF_SCAN + 64, ATT_LDS = OFF_FLAG + 64;
static_assert(ATT_LDS <= BG_OFF, "attention LDS");
#define KSWZ(row, colB) ((row) * 256 + ((colB) ^ (((row) & 7) << 4)))
#define SBAR() __builtin_amdgcn_sched_barrier(0)
__device__ __forceinline__ int slot32(int k) { return (k & 3) | (((k >> 2) & 3) << 3) | (((k >> 4) & 1) << 2); }
__device__ __forceinline__ int v_st(int k, int c) { const int kk = (k & ~0xC) | ((k & 4) << 1) | ((k & 8) >> 1); return ((kk >> 3) * 4 + (c >> 5)) * 512 + ((kk & 7) * 32 + (c & 31)) * 2; }
__device__ __forceinline__ int v_rd_base(int lane) { return ((lane & 3) << 3) | (((lane >> 2) & 3) << 6) | (((lane >> 4) & 1) << 5) | (((lane >> 5) & 1) << 8); }
constexpr int v_rd_off(int d0, int ks, int half) { return d0 * 512 + ks * 4096 + half * 2048; }
__device__ __forceinline__ int crow(int r, int hi) { return (r & 3) + 8 * (r >> 2) + 4 * hi; }
__device__ __forceinline__ float partner(float x, int hi) { auto rr = __builtin_amdgcn_permlane32_swap(__float_as_uint(x), __float_as_uint(x), false, false); return __uint_as_float(hi ? rr[0] : rr[1]); }

__device__ __forceinline__ void qkt(f32x16& p0, f32x16& p1, LAS const unsigned char* Kt, int r32, int hi, const bf16x8* qr) {
    LAS const unsigned char* kb[4];
#pragma unroll
    for (int dd = 0; dd < 4; ++dd) kb[dd] = Kt + KSWZ(r32, (dd * 16 + hi * 8) * 2);
#pragma unroll
    for (int d0 = 0; d0 < 8; ++d0) { LAS const unsigned char* a = kb[d0 & 3] + (d0 >> 2) * 128;
        const bf16x8 b0 = *(LAS const bf16x8*)a;
        const bf16x8 b1 = *(LAS const bf16x8*)(a + 32 * 256);
        p0 = __builtin_amdgcn_mfma_f32_32x32x16_bf16(b0, qr[d0], p0, 0, 0, 0);
        p1 = __builtin_amdgcn_mfma_f32_32x32x16_bf16(b1, qr[d0], p1, 0, 0, 0); }
}
__device__ __forceinline__ void pv_tile(f32x16* o, int vb0, bf16x8 pa0, bf16x8 pa1, bf16x8 pa2, bf16x8 pa3) {
#define TRRD(dst, off) asm volatile("ds_read_b64_tr_b16 %0, %1 offset:%2" : "=&v"(dst) : "v"(vb0), "i"(off) : "memory")
#define PV_D0(d0) do { s16x4 l0, l1, l2, l3, h0, h1, h2, h3; constexpr int b_ = v_rd_off(d0, 0, 0); \
        TRRD(l0, b_); TRRD(h0, b_ + 2048); TRRD(l1, b_ + 4096); TRRD(h1, b_ + 6144); TRRD(l2, b_ + 8192); TRRD(h2, b_ + 10240); TRRD(l3, b_ + 12288); TRRD(h3, b_ + 14336); \
        asm volatile("s_waitcnt lgkmcnt(0)" ::: "memory"); SBAR(); \
        o[d0] = __builtin_amdgcn_mfma_f32_32x32x16_bf16(pa0, (bf16x8){l0[0], l0[1], l0[2], l0[3], h0[0], h0[1], h0[2], h0[3]}, o[d0], 0, 0, 0); \
        o[d0] = __builtin_amdgcn_mfma_f32_32x32x16_bf16(pa1, (bf16x8){l1[0], l1[1], l1[2], l1[3], h1[0], h1[1], h1[2], h1[3]}, o[d0], 0, 0, 0); \
        o[d0] = __builtin_amdgcn_mfma_f32_32x32x16_bf16(pa2, (bf16x8){l2[0], l2[1], l2[2], l2[3], h2[0], h2[1], h2[2], h2[3]}, o[d0], 0, 0, 0); \
        o[d0] = __builtin_amdgcn_mfma_f32_32x32x16_bf16(pa3, (bf16x8){l3[0], l3[1], l3[2], l3[3], h3[0], h3[1], h3[2], h3[3]}, o[d0], 0, 0, 0); } while (0)
    PV_D0(0); PV_D0(1); PV_D0(2); PV_D0(3);
#undef PV_D0
#undef TRRD
}
#define PK4(P, B_, OUT) do { unsigned a0 = cvt_pk_bf16(P[B_+0], P[B_+1]), a1 = cvt_pk_bf16(P[B_+2], P[B_+3]); \
        unsigned b0 = cvt_pk_bf16(P[B_+4], P[B_+5]), b1 = cvt_pk_bf16(P[B_+6], P[B_+7]); \
        auto r0 = __builtin_amdgcn_permlane32_swap(a0, b0, false, false); auto r1 = __builtin_amdgcn_permlane32_swap(a1, b1, false, false); \
        v4u w = {r0[0], r1[0], r0[1], r1[1]}; OUT = __builtin_bit_cast(bf16x8, w); } while (0)

template <class F> __device__ __forceinline__ void scan_u(LAS float* U, LAS float* scan, int n, F lf) {
    const int tid = threadIdx.x, lane = tid & 63, wid = tid >> 6, t0 = 4 * tid;
    float v0 = t0 < n ? lf(t0) : 0.f, v1 = t0 + 1 < n ? lf(t0 + 1) : 0.f, v2 = t0 + 2 < n ? lf(t0 + 2) : 0.f, v3 = t0 + 3 < n ? lf(t0 + 3) : 0.f;
    v1 += v0; v2 += v1; v3 += v2;
    float x = v3;
#pragma unroll
    for (int o = 1; o < 64; o <<= 1) { const float y = __shfl_up(x, o); if (lane >= o) x += y; }
    if (lane == 63) scan[wid] = x;
    __syncthreads();
    float pre = x - v3;
    for (int w = 0; w < wid; ++w) pre += scan[w];
    f32x4 r = {-(v0 + pre) * LOG2E, -(v1 + pre) * LOG2E, -(v2 + pre) * LOG2E, -(v3 + pre) * LOG2E};
    *(LAS f32x4*)(U + t0) = r;
    __syncthreads();
}

__device__ __forceinline__ int islot(int rho) { return (rho & 0x23) | (((rho >> 3) & 3) << 2) | (((rho >> 2) & 1) << 4); }
template <int MODE, bool SAMPLE>
__device__ __forceinline__ void attn_unit(LAS unsigned char* lds, const bf16* Q, const bf16* K, const bf16* V, bf16* O, int P0, const float* Kc, const float* Vc, const float* Kn, const float* Vn, BgJob& B, float* osq) {
    int tid_ = threadIdx.x; asm volatile("" : "+v"(tid_));
    const int tid = tid_, wid = __builtin_amdgcn_readfirstlane(tid >> 6), lane = tid & 63, r32 = lane & 31, hi = lane >> 5;
    constexpr int nact = SAMPLE ? 1 : NWAVES, Tk = SAMPLE ? TKS : SEQ;
    const bool active = wid < nact;
    const int NT = (P0 + 32 * nact + 63) >> 6;
    LAS unsigned char* V_lds = lds + OFF_V; LAS unsigned char* K_lds = lds + OFF_K;
    LAS float* wsf = (LAS float*)(lds + OFF_WS) + wid * 64; LAS float* li_l = wsf; LAS float* al_l = wsf + 32;
    LAS const float* U = (LAS const float*)(lds + OFF_U);
    LAS unsigned* flg = (LAS unsigned*)(lds + OFF_FLAG);
    int kkey[2], kcol[2], vkey[2], vcol[2];
#pragma unroll
    for (int i = 0; i < 2; ++i) {
        const int q = wid * 2 + i;
        { const int rho = q * 4 + (lane >> 4), cpos = lane & 15; kkey[i] = islot(rho); kcol[i] = (cpos ^ (rho & 7)) * 8; }
        { const int sub = q * 2 + (lane >> 5), kk = (sub >> 2) * 8 + ((lane & 31) >> 2), ks = (kk & ~0xC) | ((kk & 4) << 1) | ((kk & 8) >> 1); vkey[i] = islot(ks); vcol[i] = (sub & 3) * 32 + (lane & 3) * 8; }
    }
    if (MODE == 1 && lane == 0) { flg[wid] = active ? 0u : 1u; flg[8 + wid] = active ? 0u : 1u; }
#define TILE_OF(t) (NT - 1 - (t))
#define STAGE_DMA(j, bf) do { _Pragma("unroll") for (int _i = 0; _i < 2; ++_i) { \
        int kk_ = (j) * 64 + kkey[_i]; kk_ = kk_ < Tk ? kk_ : Tk - 1; int vk_ = (j) * 64 + vkey[_i]; vk_ = vk_ < Tk ? vk_ : Tk - 1; \
        __builtin_amdgcn_global_load_lds((const unsigned*)(K + (size_t)kk_ * WG + kcol[_i]), (LAS unsigned*)(K_lds + (bf) * SHM_K + (wid * 2 + _i) * 1024), 16, 0, 0); \
        __builtin_amdgcn_global_load_lds((const unsigned*)(V + (size_t)vk_ * WG + vcol[_i]), (LAS unsigned*)(V_lds + (bf) * SHM_V + (wid * 2 + _i) * 1024), 16, 0, 0); } } while (0)
#define STAGE_F32(j, bf) do { const int lt_ = tid - 64; f32x4 fa_[5], fb_[5]; int dst_[5]; \
        _Pragma("unroll") for (int jj_ = 0; jj_ < 5; ++jj_) { const int i_ = lt_ + 448 * jj_; int key_, col_; const bool isv_ = i_ >= 1024; \
            if (!isv_) { const int rho = i_ >> 4, cpos = i_ & 15; key_ = islot(rho); col_ = (cpos ^ (rho & 7)) * 8; dst_[jj_] = OFF_K + (bf) * SHM_K + i_ * 16; } \
            else { const int iv = i_ - 1024, sub = iv >> 5, kk = (sub >> 2) * 8 + ((iv & 31) >> 2), ks = (kk & ~0xC) | ((kk & 4) << 1) | ((kk & 8) >> 1); key_ = islot(ks); col_ = (sub & 3) * 32 + (iv & 3) * 8; dst_[jj_] = OFF_V + (bf) * SHM_V + iv * 16; } \
            int ka_ = (j) * 64 + key_; ka_ = ka_ < Tk ? ka_ : Tk - 1; \
            const float* src_ = (ka_ < PAST ? (isv_ ? Vc : Kc) + (size_t)ka_ * WG : (isv_ ? Vn : Kn) + (size_t)(ka_ - PAST) * WG) + col_; \
            if (i_ < 2048) { fa_[jj_] = *(const f32x4*)src_; fb_[jj_] = *(const f32x4*)(src_ + 4); } } \
        _Pragma("unroll") for (int jj_ = 0; jj_ < 5; ++jj_) { const int i_ = lt_ + 448 * jj_; \
            if (i_ < 2048) { v4u w_; w_.x = cvt_pk_bf16(fa_[jj_].x, fa_[jj_].y); w_.y = cvt_pk_bf16(fa_[jj_].z, fa_[jj_].w); w_.z = cvt_pk_bf16(fb_[jj_].x, fb_[jj_].y); w_.w = cvt_pk_bf16(fb_[jj_].z, fb_[jj_].w); \
                *(LAS v4u*)(lds + dst_[jj_]) = w_; } } } while (0)
    if (SAMPLE && wid >= 1) {
        STAGE_F32(TILE_OF(0), 0); LDS_WAIT();
        __syncthreads();
        for (int t = 0; t < NT; ++t) {
            if (t + 1 < NT) STAGE_F32(TILE_OF(t + 1), (t + 1) & 1);
            LDS_WAIT();
            __syncthreads();
            if (MODE == 1) { const v4u fa = *(LAS const v4u*)(flg + (t & 1) * 8), fb = *(LAS const v4u*)(flg + (t & 1) * 8 + 4);
                if ((fa.x & fa.y & fa.z & fa.w & fb.x & fb.y & fb.z & fb.w) != 0u) break; }
        }
        __syncthreads();
        return;
    }
    const int vb0 = (int)(size_t)V_lds + v_rd_base(lane);
    const int qlo = P0 + wid * 32, tq = qlo + r32;
    bf16x8 qr[8];
#pragma unroll
    for (int d0 = 0; d0 < 8; ++d0) qr[d0] = *(const bf16x8*)(Q + (size_t)(wid * 32 + r32) * DM + d0 * 16 + hi * 8);
    if (!SAMPLE) { STAGE_DMA(TILE_OF(0), 0); VM_WAIT(); }
    __syncthreads();
    float m_reg = -1e30f, l_reg = 0.f, carry = 1.f;
    f32x16 o[4] = {};
    for (int t = 0; t < NT; ++t) {
        const int j = TILE_OF(t), kb = j * 64, bufo = (t & 1) * SHM_K;
        if (!SAMPLE && t + 1 < NT) STAGE_DMA(TILE_OF(t + 1), (t + 1) & 1);
        if (!SAMPLE) bg_step(B, lane);
        if (kb <= qlo + 31) {
            f32x16 p0, p1;
            if (MODE == 0) {
                LAS const f32x4* up0 = (LAS const f32x4*)(U + kb + 16 * hi); LAS const f32x4* up1 = (LAS const f32x4*)(U + kb + 32 + 16 * hi);
#pragma unroll
                for (int g = 0; g < 4; ++g) { const f32x4 a = up0[g], b = up1[g];
#pragma unroll
                    for (int jj = 0; jj < 4; ++jj) { p0[4 * g + jj] = a[jj]; p1[4 * g + jj] = b[jj]; } }
            } else { p0 = f32x16{}; p1 = f32x16{}; }
            qkt(p0, p1, K_lds + bufo, r32, hi, qr);
            bf16x8 pa0, pa1, pa2, pa3;
            const int dq = tq - kb - 16 * hi;
            const bool need_mask = kb + 63 >= qlo;
            if (MODE == 0) {
                if (need_mask) { const float NEG = -__builtin_inff();
#pragma unroll
                    for (int r = 0; r < 16; ++r) { if (r > dq) p0[r] = NEG; if (r + 32 > dq) p1[r] = NEG; } }
                float pmax = p0[0];
#pragma unroll
                for (int r = 1; r < 16; ++r) pmax = fmaxf(pmax, p0[r]);
#pragma unroll
                for (int r = 0; r < 16; ++r) pmax = fmaxf(pmax, p1[r]);
                pmax = fmaxf(pmax, partner(pmax, hi));
                const float mn = fmaxf(m_reg, pmax);
                const bool grew = __any(mn > m_reg);
                float ps = 0.f;
#pragma unroll
                for (int r = 0; r < 16; ++r) { p0[r] = __builtin_amdgcn_exp2f(p0[r] - mn); p1[r] = __builtin_amdgcn_exp2f(p1[r] - mn); ps += p0[r] + p1[r]; }
                ps += partner(ps, hi);
                if (grew) {
                    const float alpha = __builtin_amdgcn_exp2f(m_reg - mn);
                    l_reg = l_reg * alpha + ps;
                    if (hi == 0) al_l[r32] = alpha;
                    LDS_WAIT();
#pragma unroll
                    for (int g = 0; g < 4; ++g) { const f32x4 a = *(LAS const f32x4*)(al_l + 8 * g + 4 * hi);
#pragma unroll
                        for (int jj = 0; jj < 4; ++jj)
#pragma unroll
                            for (int d_ = 0; d_ < 4; ++d_) o[d_][4 * g + jj] *= a[jj]; }
                } else l_reg += ps;
                m_reg = mn;
            } else {
                f32x16 w1;
#pragma unroll
                for (int r = 0; r < 16; ++r) { p1[r] = __builtin_amdgcn_exp2f(fminf(p1[r], 80.f)); w1[r] = __builtin_amdgcn_rcpf(1.0f + p1[r]); }
                if (need_mask) {
#pragma unroll
                    for (int r = 0; r < 16; ++r) if (r + 32 >= dq) { p1[r] = 0.f; w1[r] = 1.f; } }
#pragma unroll
                for (int r = 14; r >= 0; --r) w1[r] *= w1[r + 1];
                const float T1 = w1[0], oT1 = partner(T1, hi);
                const float f1 = hi ? carry : carry * oT1;
#pragma unroll
                for (int r = 0; r < 16; ++r) p1[r] = p1[r] * (w1[r] * f1);
                f32x16 w0;
#pragma unroll
                for (int r = 0; r < 16; ++r) { p0[r] = __builtin_amdgcn_exp2f(fminf(p0[r], 80.f)); w0[r] = __builtin_amdgcn_rcpf(1.0f + p0[r]); }
                if (need_mask) {
#pragma unroll
                    for (int r = 0; r < 16; ++r) if (r >= dq) { p0[r] = 0.f; w0[r] = 1.f; } }
#pragma unroll
                for (int r = 14; r >= 0; --r) w0[r] *= w0[r + 1];
                const float T0 = w0[0], oT0 = partner(T0, hi);
                const float f0 = (carry * (T1 * oT1)) * (hi ? 1.f : oT0);
#pragma unroll
                for (int r = 0; r < 16; ++r) p0[r] = p0[r] * (w0[r] * f0);
                carry = carry * ((T0 * oT0) * (T1 * oT1));
            }
            PK4(p0, 0, pa0); PK4(p0, 8, pa1); PK4(p1, 0, pa2); PK4(p1, 8, pa3);
            pv_tile(o, vb0 + bufo, pa0, pa1, pa2, pa3);
        }
        if (MODE == 1) { const bool dead = __all(carry == 0.f) != 0; if (lane == 0) flg[(t & 1) * 8 + wid] = dead ? 1u : 0u; }
        if (!SAMPLE) VM_WAIT();
        LDS_WAIT();
        __syncthreads();
        if (MODE == 1) {
            const v4u fa = *(LAS const v4u*)(flg + (t & 1) * 8), fb = *(LAS const v4u*)(flg + (t & 1) * 8 + 4);
            if ((fa.x & fa.y & fa.z & fa.w & fb.x & fb.y & fb.z & fb.w) != 0u) break;
        }
    }
    {
        if (MODE == 0) {
            if (hi == 0) li_l[r32] = 1.0f / l_reg;
            LDS_WAIT();
#pragma unroll
            for (int g = 0; g < 4; ++g) { const f32x4 a = *(LAS const f32x4*)(li_l + 8 * g + 4 * hi);
#pragma unroll
                for (int jj = 0; jj < 4; ++jj)
#pragma unroll
                    for (int d_ = 0; d_ < 4; ++d_) o[d_][4 * g + jj] *= a[jj]; }
        }
#pragma unroll
        for (int r = 0; r < 16; ++r) { float s = (o[0][r] * o[0][r] + o[1][r] * o[1][r]) + (o[2][r] * o[2][r] + o[3][r] * o[3][r]);
            s += __shfl_xor(s, 1); s += __shfl_xor(s, 2); s += __shfl_xor(s, 4); s += __shfl_xor(s, 8); s += __shfl_xor(s, 16);
            if (r32 == 0) __hip_atomic_fetch_add(osq + 2 * (wid * 32 + crow(r, hi)), s, __ATOMIC_RELAXED, __HIP_MEMORY_SCOPE_AGENT); }
        bf16* Ow = O + (size_t)(wid * 32) * DM;
#pragma unroll
        for (int r = 0; r < 16; ++r) { const int orow = crow(r, hi);
#pragma unroll
            for (int d0 = 0; d0 < 4; ++d0) { const float v = o[d0][r]; const float vn = __shfl_xor(v, 1);
                if ((r32 & 1) == 0) *(unsigned*)(Ow + (size_t)orow * DM + d0 * 32 + r32) = cvt_pk_bf16(v, vn); } }
    }
    __syncthreads();
#undef TILE_OF
#undef STAGE_DMA
#undef STAGE_F32
}

template <int MODE>
__device__ __forceinline__ void attn_unit_pp(LAS unsigned char* lds, const bf16* Q, const bf16* K, const bf16* V, bf16* O, int P0, BgJob& B, float* osq) {
    int tid_ = threadIdx.x; asm volatile("" : "+v"(tid_));
    const int tid = tid_, wid = __builtin_amdgcn_readfirstlane(tid >> 6), lane = tid & 63, r32 = lane & 31, hi = lane >> 5;
    const int par = wid >> 2;
    constexpr int Tk = SEQ;
    const int NT = (P0 + 32 * NWAVES + 63) >> 6;
    LAS unsigned char* V_lds = lds + OFF_V; LAS unsigned char* K_lds = lds + OFF_K;
    LAS float* wsf = (LAS float*)(lds + OFF_WS) + wid * 64; LAS float* li_l = wsf; LAS float* al_l = wsf + 32;
    LAS const float* U = (LAS const float*)(lds + OFF_U);
    LAS unsigned* flg = (LAS unsigned*)(lds + OFF_FLAG);
    int kkey[2], kcol[2], vkey[2], vcol[2];
#pragma unroll
    for (int i = 0; i < 2; ++i) {
        const int q = wid * 2 + i;
        { const int rho = q * 4 + (lane >> 4), cpos = lane & 15; kkey[i] = islot(rho); kcol[i] = (cpos ^ (rho & 7)) * 8; }
        { const int sub = q * 2 + (lane >> 5), kk = (sub >> 2) * 8 + ((lane & 31) >> 2), ks = (kk & ~0xC) | ((kk & 4) << 1) | ((kk & 8) >> 1); vkey[i] = islot(ks); vcol[i] = (sub & 3) * 32 + (lane & 3) * 8; }
    }
    if (MODE == 1 && lane == 0) { flg[wid] = 0u; flg[8 + wid] = 0u; }
#define TILE_OF(t) (NT - 1 - (t))
#define DMA_K(j, bf) do { _Pragma("unroll") for (int _i = 0; _i < 2; ++_i) { int kk_ = (j) * 64 + kkey[_i]; kk_ = kk_ < Tk ? kk_ : Tk - 1; \
        __builtin_amdgcn_global_load_lds((const unsigned*)(K + (size_t)kk_ * WG + kcol[_i]), (LAS unsigned*)(K_lds + (bf) * SHM_K + (wid * 2 + _i) * 1024), 16, 0, 0); } } while (0)
#define DMA_V(j, bf) do { _Pragma("unroll") for (int _i = 0; _i < 2; ++_i) { int vk_ = (j) * 64 + vkey[_i]; vk_ = vk_ < Tk ? vk_ : Tk - 1; \
        __builtin_amdgcn_global_load_lds((const unsigned*)(V + (size_t)vk_ * WG + vcol[_i]), (LAS unsigned*)(V_lds + (bf) * SHM_V + (wid * 2 + _i) * 1024), 16, 0, 0); } } while (0)
    const int vb0 = (int)(size_t)V_lds + v_rd_base(lane);
    const int qlo = P0 + wid * 32, tq = qlo + r32;
    bf16x8 qr[8];
#pragma unroll
    for (int d0 = 0; d0 < 8; ++d0) qr[d0] = *(const bf16x8*)(Q + (size_t)(wid * 32 + r32) * DM + d0 * 16 + hi * 8);
    DMA_K(TILE_OF(0), 0); VM_WAIT();
    __syncthreads();
    float m_reg = -1e30f, l_reg = 0.f, carry = 1.f;
    f32x16 o[4] = {};
    auto stage_qk = [&](f32x16& p0, f32x16& p1, const int t) {
            {
                const int kb = TILE_OF(t) * 64;
                if (MODE == 0) {
                    LAS const f32x4* up0 = (LAS const f32x4*)(U + kb + 16 * hi); LAS const f32x4* up1 = (LAS const f32x4*)(U + kb + 32 + 16 * hi);
#pragma unroll
                    for (int g = 0; g < 4; ++g) { const f32x4 a = up0[g], b = up1[g];
#pragma unroll
                        for (int jj = 0; jj < 4; ++jj) { p0[4 * g + jj] = a[jj]; p1[4 * g + jj] = b[jj]; } }
                } else { p0 = f32x16{}; p1 = f32x16{}; }
                qkt(p0, p1, K_lds + (t & 1) * SHM_K, r32, hi, qr);
            }
    };
    auto stage_sm = [&](f32x16& p0, f32x16& p1, bf16x8& pa0, bf16x8& pa1, bf16x8& pa2, bf16x8& pa3, const int ts) {
            {
                const int kb = TILE_OF(ts) * 64;
                const int dq = tq - kb - 16 * hi;
                const bool need_mask = kb + 63 >= qlo;
                if (MODE == 0) {
                    if (need_mask) { const float NEG = -__builtin_inff();
#pragma unroll
                        for (int r = 0; r < 16; ++r) { if (r > dq) p0[r] = NEG; if (r + 32 > dq) p1[r] = NEG; } }
                    float pmax = p0[0];
#pragma unroll
                    for (int r = 1; r < 16; ++r) pmax = fmaxf(pmax, p0[r]);
#pragma unroll
                    for (int r = 0; r < 16; ++r) pmax = fmaxf(pmax, p1[r]);
                    pmax = fmaxf(pmax, partner(pmax, hi));
                    const float mn = fmaxf(m_reg, pmax);
                    const bool grew = __any(mn > m_reg);
                    float ps = 0.f;
#pragma unroll
                    for (int r = 0; r < 16; ++r) { p0[r] = __builtin_amdgcn_exp2f(p0[r] - mn); p1[r] = __builtin_amdgcn_exp2f(p1[r] - mn); ps += p0[r] + p1[r]; }
                    ps += partner(ps, hi);
                    if (grew) {
                        const float alpha = __builtin_amdgcn_exp2f(m_reg - mn);
                        l_reg = l_reg * alpha + ps;
                        if (hi == 0) al_l[r32] = alpha;
                        LDS_WAIT();
#pragma unroll
                        for (int g = 0; g < 4; ++g) { const f32x4 a = *(LAS const f32x4*)(al_l + 8 * g + 4 * hi);
#pragma unroll
                            for (int jj = 0; jj < 4; ++jj)
#pragma unroll
                                for (int d_ = 0; d_ < 4; ++d_) o[d_][4 * g + jj] *= a[jj]; }
                    } else l_reg += ps;
                    m_reg = mn;
                } else {
                    f32x16 w1;
#pragma unroll
                    for (int r = 0; r < 16; ++r) { p1[r] = __builtin_amdgcn_exp2f(fminf(p1[r], 80.f)); w1[r] = __builtin_amdgcn_rcpf(1.0f + p1[r]); }
                    if (need_mask) {
#pragma unroll
                        for (int r = 0; r < 16; ++r) if (r + 32 >= dq) { p1[r] = 0.f; w1[r] = 1.f; } }
#pragma unroll
                    for (int r = 14; r >= 0; --r) w1[r] *= w1[r + 1];
                    const float T1 = w1[0], oT1 = partner(T1, hi);
                    const float f1 = hi ? carry : carry * oT1;
#pragma unroll
                    for (int r = 0; r < 16; ++r) p1[r] = p1[r] * (w1[r] * f1);
                    f32x16 w0;
#pragma unroll
                    for (int r = 0; r < 16; ++r) { p0[r] = __builtin_amdgcn_exp2f(fminf(p0[r], 80.f)); w0[r] = __builtin_amdgcn_rcpf(1.0f + p0[r]); }
                    if (need_mask) {
#pragma unroll
                        for (int r = 0; r < 16; ++r) if (r >= dq) { p0[r] = 0.f; w0[r] = 1.f; } }
#pragma unroll
                    for (int r = 14; r >= 0; --r) w0[r] *= w0[r + 1];
                    const float T0 = w0[0], oT0 = partner(T0, hi);
                    const float f0 = (carry * (T1 * oT1)) * (hi ? 1.f : oT0);
#pragma unroll
                    for (int r = 0; r < 16; ++r) p0[r] = p0[r] * (w0[r] * f0);
                    carry = carry * ((T0 * oT0) * (T1 * oT1));
                }
                PK4(p0, 0, pa0); PK4(p0, 8, pa1); PK4(p1, 0, pa2); PK4(p1, 8, pa3);
            }
    };
#define PP_HEAD const bool fresh = !last; \
        if (fresh) { if (t + 1 < NT) DMA_K(TILE_OF(t + 1), (t + 1) & 1); DMA_V(TILE_OF(t), t & 1); } \
        bg_step(B, lane); \
        const bool visq = fresh && (TILE_OF(t) * 64 <= qlo + 31);             \
        const bool visp = t > 0 && (TILE_OF(t - 1) * 64 <= qlo + 31);
#define PP_TAIL if (MODE == 1) { const bool dead = __all(carry == 0.f) != 0; if (lane == 0) flg[(t & 1) * 8 + wid] = dead ? 1u : 0u; } \
        VM_WAIT(); \
        LDS_WAIT(); \
        __syncthreads(); \
        if (last) break; \
        last = (t + 1 == NT); \
        if (MODE == 1) { \
            const v4u fa = *(LAS const v4u*)(flg + (t & 1) * 8), fb = *(LAS const v4u*)(flg + (t & 1) * 8 + 4); \
            if ((fa.x & fa.y & fa.z & fa.w & fb.x & fb.y & fb.z & fb.w) != 0u) last = true; \
        }
    if (par == 0) {
        bf16x8 pa0 = {}, pa1 = {}, pa2 = {}, pa3 = {};
        bool last = false;
        for (int t = 0;; ++t) {
            PP_HEAD
            if (visp) pv_tile(o, vb0 + ((t - 1) & 1) * SHM_V, pa0, pa1, pa2, pa3);
            if (visq) { f32x16 p0, p1; stage_qk(p0, p1, t); stage_sm(p0, p1, pa0, pa1, pa2, pa3, t); }
            PP_TAIL
        }
    } else {
        f32x16 p0 = {}, p1 = {};
        bool last = false;
        for (int t = 0;; ++t) {
            PP_HEAD
            if (visp) { bf16x8 pa0, pa1, pa2, pa3; stage_sm(p0, p1, pa0, pa1, pa2, pa3, t - 1); pv_tile(o, vb0 + ((t - 1) & 1) * SHM_V, pa0, pa1, pa2, pa3); }
            if (visq) stage_qk(p0, p1, t);
            PP_TAIL
        }
    }
#undef PP_HEAD
#undef PP_TAIL
    {
        if (MODE == 0) {
            if (hi == 0) li_l[r32] = 1.0f / l_reg;
            LDS_WAIT();
#pragma unroll
            for (int g = 0; g < 4; ++g) { const f32x4 a = *(LAS const f32x4*)(li_l + 8 * g + 4 * hi);
#pragma unroll
                for (int jj = 0; jj < 4; ++jj)
#pragma unroll
                    for (int d_ = 0; d_ < 4; ++d_) o[d_][4 * g + jj] *= a[jj]; }
        }
#pragma unroll
        for (int r = 0; r < 16; ++r) { float s = (o[0][r] * o[0][r] + o[1][r] * o[1][r]) + (o[2][r] * o[2][r] + o[3][r] * o[3][r]);
            s += __shfl_xor(s, 1); s += __shfl_xor(s, 2); s += __shfl_xor(s, 4); s += __shfl_xor(s, 8); s += __shfl_xor(s, 16);
            if (r32 == 0) __hip_atomic_fetch_add(osq + 2 * (wid * 32 + crow(r, hi)), s, __ATOMIC_RELAXED, __HIP_MEMORY_SCOPE_AGENT); }
        bf16* Ow = O + (size_t)(wid * 32) * DM;
#pragma unroll
        for (int r = 0; r < 16; ++r) { const int orow = crow(r, hi);
#pragma unroll
            for (int d0 = 0; d0 < 4; ++d0) { const float v = o[d0][r]; const float vn = __shfl_xor(v, 1);
                if ((r32 & 1) == 0) *(unsigned*)(Ow + (size_t)orow * DM + d0 * 32 + r32) = cvt_pk_bf16(v, vn); } }
    }
    __syncthreads();
#undef TILE_OF
#undef DMA_K
#undef DMA_V
}
#undef PK4
}

#define XB_TMO      128
#define XB_XCNT(j)  (256  + 64 * (j))
#define XB_XSUB(j)  (1280 + 64 * (j))
#define XB_XGEN(j)  (2304 + 64 * (j))
#define XB_TOP      3328
#define XB_TOPGEN   3392
#define XCD_BAR_WORDS 3456
#define XB_SPIN_CAP (1u << 18)
__device__ __forceinline__ unsigned xb_ld(unsigned* p)              { return __hip_atomic_load(p, __ATOMIC_RELAXED, __HIP_MEMORY_SCOPE_AGENT); }
__device__ __forceinline__ unsigned xb_add(unsigned* p, unsigned v) { return __hip_atomic_fetch_add(p, v, __ATOMIC_RELAXED, __HIP_MEMORY_SCOPE_AGENT); }
__device__ __forceinline__ unsigned xb_xcc_id() { return (unsigned)__builtin_amdgcn_s_getreg((3 << 11) | 20) & 0xFu; }
#define XB_SPIN(cond, bar) do { unsigned _sp = 0; while (cond) { __builtin_amdgcn_s_sleep(1); \
    if ((++_sp & 255u) == 0u) { if (xb_ld(&(bar)[XB_TMO])) break; if (_sp > XB_SPIN_CAP) { atomicAdd(&(bar)[XB_TMO], 1u); break; } } } } while (0)
struct XcdBarrier { unsigned* bar; unsigned x; volatile LAS unsigned* st; };
__device__ __forceinline__ XcdBarrier xcd_barrier_post(unsigned* bar, volatile LAS unsigned* st) {
    XcdBarrier b; b.bar = bar; b.x = xb_xcc_id(); b.st = st;
    if (threadIdx.x == 0) (void)xb_add(&bar[XB_XCNT(b.x)], 1u);
    return b;
}
__device__ __forceinline__ void xcd_barrier_complete(unsigned* bar, unsigned x, unsigned& nloc, unsigned& nx) {
    const unsigned G = gridDim.x * gridDim.y * gridDim.z;
    unsigned sum, cnt, mine, sp = 0u;
    for (;;) {
        sum = 0u; cnt = 0u; mine = 0u;
#pragma unroll
        for (unsigned j = 0; j < 16; ++j) { const unsigned c = xb_ld(&bar[XB_XCNT(j)]); sum += c; cnt += (c > 0u) ? 1u : 0u; mine = (j == x) ? c : mine; }
        if (sum == G) break;
        __builtin_amdgcn_s_sleep(1);
        if ((++sp & 255u) == 0u) { if (xb_ld(&bar[XB_TMO])) break; if (sp > XB_SPIN_CAP) { atomicAdd(&bar[XB_TMO], 1u); break; } }
    }
    nloc = mine > 0u ? mine : 1u; nx = cnt > 0u ? cnt : 1u;
}
__device__ __forceinline__ void xcd_barrier(const XcdBarrier& b) {
    asm volatile("s_waitcnt vmcnt(0)" ::: "memory");
    __syncthreads();
    if (threadIdx.x == 0) {
        unsigned* bar = b.bar;
        __builtin_amdgcn_s_waitcnt(0);
        unsigned nloc = b.st[0], nx = b.st[1];
        if (nloc == 0u) { xcd_barrier_complete(bar, b.x, nloc, nx); b.st[0] = nloc; b.st[1] = nx; }
        const unsigned old = xb_add(&bar[XB_XSUB(b.x)], 1u);
        const unsigned gen = old / nloc;
        if (old + 1u == (gen + 1u) * nloc) {
            __builtin_amdgcn_fence(__ATOMIC_RELEASE, "agent");
            asm volatile("s_waitcnt vmcnt(0)" ::: "memory");
            const unsigned og = xb_add(&bar[XB_TOP], 1u);
            const unsigned tg = og / nx;
            if (og + 1u == (tg + 1u) * nx) xb_add(&bar[XB_TOPGEN], 1u);
            else XB_SPIN(xb_ld(&bar[XB_TOPGEN]) == tg, bar);
            __builtin_amdgcn_fence(__ATOMIC_ACQUIRE, "agent");
            xb_add(&bar[XB_XGEN(b.x)], 1u);
            asm volatile("s_waitcnt vmcnt(0)" ::: "memory");
        } else {
            XB_SPIN(xb_ld(&bar[XB_XGEN(b.x)]) == gen, bar);
            __builtin_amdgcn_fence(__ATOMIC_ACQUIRE, "agent");
            asm volatile("s_waitcnt vmcnt(0)" ::: "memory");
        }
    }
    __syncthreads();
}

struct Args { const float* in[18]; float* out; unsigned char* ws; int ph_lo, ph_hi; };

__device__ __forceinline__ float wave_sum(float v) {
#pragma unroll
    for (int o = 1; o < 64; o <<= 1) v += __shfl_xor(v, o);
    return v;
}
__device__ __forceinline__ void tr_load(f32x4 (&r)[8], const float* W, int ldw, int k0, int n0, int lane) {
    const float* p = W + (size_t)(k0 + (lane >> 3)) * ldw + n0 + 4 * (lane & 7);
#pragma unroll
    for (int j = 0; j < 8; ++j) r[j] = *(const f32x4*)(p + (size_t)(8 * j) * ldw);
}
__device__ __forceinline__ void tr_proc(const f32x4 (&r)[8], const float* ksc, int K, int k0, int ncols, bf16* WT, int drow0, LAS float* scr, int lane) {
    const int c = 4 * (lane & 7);
#pragma unroll
    for (int j = 0; j < 8; ++j) { const int kk = 8 * j + (lane >> 3); const float sc = ksc ? ksc[k0 + kk] : 1.f; LAS float* d = scr + kk * 33 + c;
        d[0] = r[j].x * sc; d[1] = r[j].y * sc; d[2] = r[j].z * sc; d[3] = r[j].w * sc; }
    LDS_WAIT(); asm volatile("" ::: "memory");
    const int c8 = lane & 7;
#pragma unroll
    for (int j = 0; j < 4; ++j) { const int n = (lane >> 3) + 8 * j; const LAS float* s = scr + (8 * c8) * 33 + n;
        v4u o; o.x = cvt_pk_bf16(s[0 * 33], s[1 * 33]); o.y = cvt_pk_bf16(s[2 * 33], s[3 * 33]); o.z = cvt_pk_bf16(s[4 * 33], s[5 * 33]); o.w = cvt_pk_bf16(s[6 * 33], s[7 * 33]);
        if (n < ncols) *(GAS v4u*)(WT + (size_t)(drow0 + n) * K + k0 + 8 * c8) = o; }
    LDS_WAIT(); asm volatile("" ::: "memory");
}
__device__ __forceinline__ void row_to_bf16_ssq(const float* xrow, bf16* orow, float* ssq, int lane) {
    const f32x4* xr = (const f32x4*)xrow + lane;
    f32x4 v[16]; float s = 0.f;
#pragma unroll
    for (int j = 0; j < 16; ++j) { v[j] = xr[64 * j]; s += (v[j].x * v[j].x + v[j].y * v[j].y) + (v[j].z * v[j].z + v[j].w * v[j].w); }
    s = wave_sum(s);
    v2u* o8 = (v2u*)orow + lane;
#pragma unroll
    for (int j = 0; j < 16; ++j) { v2u w; w.x = cvt_pk_bf16(v[j].x, v[j].y); w.y = cvt_pk_bf16(v[j].z, v[j].w); o8[64 * j] = w; }
    if (lane == 0) *ssq = s;
}
__device__ __forceinline__ float bf_lo(unsigned w) { return __uint_as_float(w << 16); }
__device__ __forceinline__ float bf_hi(unsigned w) { return __uint_as_float(w & 0xffff0000u); }

__global__ void __launch_bounds__(NWAVES * 64, 2) fwd_kernel(Args args) {
    extern __shared__ __attribute__((aligned(16))) unsigned char lds_raw[];
    LAS unsigned char* lds = (LAS unsigned char*)lds_raw;
    volatile LAS unsigned* MISC = (volatile LAS unsigned*)(lds + MISC_OFF);
    const int tid = threadIdx.x, lane = tid & 63, wave = __builtin_amdgcn_readfirstlane(tid >> 6);
    const int G = gridDim.x; const int bx = blockIdx.x; const int vcu = (G % 8 == 0) ? (bx % 8) * (G / 8) + bx / 8 : bx;
    unsigned char* ws = args.ws; float* out = args.out;
    gu32* ctl = (gu32*)(ws + WS_CTL);
    const float* x_prompt = args.in[0]; const float* x_sample = args.in[1];
    const float* cache_fk = args.in[2]; const float* cache_fv = args.in[3]; const float* cache_fl = args.in[4]; const float* cache_sk = args.in[5]; const float* cache_sv = args.in[6];
    const float* g_attn = args.in[7]; const float* w_in = args.in[8]; const float* b_forget = args.in[9]; const float* g_of = args.in[10]; const float* g_os = args.in[11];
    const float* w_out = args.in[12]; const float* g_ffn = args.in[13]; const float* w_gate = args.in[14]; const float* w_up = args.in[15]; const float* w_down = args.in[16]; const float* g_final = args.in[17];
    bf16* Win_t = (bf16*)(ws + WS_WIN); bf16* Wout_t = (bf16*)(ws + WS_WOUT); bf16* Wgu_t = (bf16*)(ws + WS_WGU); bf16* Wdn_t = (bf16*)(ws + WS_WDN);
    bf16* XN = (bf16*)(ws + WS_XN); bf16* QO = (bf16*)(ws + WS_QO); bf16* KVB = (bf16*)(ws + WS_KV); bf16* ACT = (bf16*)(ws + WS_ACT); float* PART = (float*)(ws + WS_PART);

    for (int u = tid; u < (LDS_BYTES - LDSCTL_OFF) / 4; u += NWAVES * 64) ((LAS unsigned*)(lds + LDSCTL_OFF))[u] = 0u;
    __syncthreads();
    XcdBarrier bar; bar.bar = (unsigned*)(ctl + CW_BAR); bar.x = 0; bar.st = nullptr;
    if (MK_N_LAUNCHES == 1) bar = xcd_barrier_post((unsigned*)(ctl + CW_BAR), MISC + 8);
    const int lo = args.ph_lo, hi_ph = args.ph_hi;
#ifndef PH_MASK
#define PH_MASK 0x1ff
#endif
#define IN(k) (((PH_MASK >> (k)) & 1) && lo <= (k) && (k) < hi_ph)
#define BOTH(k) (IN(k) && IN((k) + 1))
#define GRID_BAR() do { if (MK_N_LAUNCHES == 1) xcd_barrier(bar); } while (0)
#ifndef PROBE_PHASE
#define PROBE_PHASE (-1)
#endif
    unsigned long long probe_t0 = 0ull;
#define PROBE_T0(k) do { if (PROBE_PHASE == (k)) probe_t0 = __builtin_amdgcn_s_memrealtime(); } while (0)
#define PROBE_T1(k) do { if (PROBE_PHASE == (k)) { const unsigned long long t1_ = __builtin_amdgcn_s_memrealtime(); const unsigned long long d_ = t1_ - probe_t0; \
        while (__builtin_amdgcn_s_memrealtime() - t1_ < d_) __builtin_amdgcn_s_sleep(8); } } while (0)
    const int gw = vcu * NWAVES + wave, NGW = G * NWAVES;

    if (IN(0)) {
        PROBE_T0(0);
        LAS float* scr = (LAS float*)(lds + RING_OFF + wave * 16384);
        constexpr int KB4 = DM / 64;
        constexpr int I_INA = KB4 * (3 * WG / 32), I_INB = I_INA, I_FL = KB4;
        constexpr int NITEMS = I_INA + I_INB + I_FL;
#define TR_DECODE(it_, W_, ksc_, WT_, ldw_, K_, k0_, n0_, nc_, dr_) do { int r_ = (it_); ksc_ = g_attn; nc_ = 32; ldw_ = DIN; K_ = DM; W_ = w_in; WT_ = Win_t; \
            if (r_ < I_INA) { const int kb = r_ / 192, nb = r_ % 192; k0_ = 64 * kb; n0_ = 32 * nb; dr_ = 32 * nb; } \
            else if ((r_ -= I_INA) < I_INB) { const int kb = r_ / 192, nb = r_ % 192; k0_ = 64 * kb; n0_ = 3 * WG + NHG + 32 * nb; dr_ = 3 * WG + 32 * nb; } \
            else { r_ -= I_INB; k0_ = 64 * r_; n0_ = 3 * WG; nc_ = 16; dr_ = 6 * WG; } } while (0)
        if (gw < NITEMS) {
            const float* W; const float* ksc; bf16* WT; int ldw, K, k0, n0, nc, dr;
            f32x4 ra[8], rb[8];
            int it = gw;
            TR_DECODE(it, W, ksc, WT, ldw, K, k0, n0, nc, dr);
            tr_load(ra, W, ldw, k0, n0, lane);
            for (;;) {
                const int itn = it + NGW; const bool more = itn < NITEMS;
                const float* W2 = W; const float* ksc2 = ksc; bf16* WT2 = WT; int ldw2 = ldw, K2 = K, k02 = k0, n02 = n0, nc2 = nc, dr2 = dr;
                if (more) { TR_DECODE(itn, W2, ksc2, WT2, ldw2, K2, k02, n02, nc2, dr2); tr_load(rb, W2, ldw2, k02, n02, lane); }
                tr_proc(ra, ksc, K, k0, nc, WT, dr, scr, lane);
                if (!more) break;
#pragma unroll
                for (int j = 0; j < 8; ++j) ra[j] = rb[j];
                W = W2; ksc = ksc2; WT = WT2; ldw = ldw2; K = K2; k0 = k02; n0 = n02; nc = nc2; dr = dr2; it = itn;
            }
        }
#undef TR_DECODE
        for (int i = gw * 64 + lane; i < 240 * DM / 8; i += NGW * 64) *(v4u*)(Win_t + (size_t)(6 * WG + 16) * DM + (size_t)i * 8) = (v4u){0u, 0u, 0u, 0u};
        for (int m = gw; m < MT; m += NGW) row_to_bf16_ssq(m < MP ? x_prompt + (size_t)m * DM : x_sample + (size_t)(m - MP) * DM, XN + (size_t)m * DM, (float*)(ctl + CW_SSQ0) + m, lane);
        PROBE_T1(0);
        if (BOTH(0)) GRID_BAR();
    }

    if (IN(1)) {
        PROBE_T0(1);
        pg8::Gemm g{XN, Win_t, MT, NIN, DM}; pg8::StaticOrder S; S.init(MT, NIN, DM, G, bx);
        pg8::EpiIn E{QO, KVB, out, b_forget, (const float*)(ctl + CW_SSQ0)};
#ifndef PROBE_REP1
#define PROBE_REP1 1
#endif
#pragma unroll 1
        for (int rep = 0; rep < PROBE_REP1; ++rep) { if (rep) GRID_BAR();
        pg8::gemm_phase<pg8::EpiIn, pg8::StaticOrder, true, true>(lds + RING_OFF, g, S, E); }
        { const int nwg1 = (MT / 256) * (NIN / 256), rem1 = nwg1 % G;
          if (rem1 == 0 || bx >= rem1) { const int cgw = (rem1 ? bx - rem1 : bx) * NWAVES + wave, cngw = (rem1 ? G - rem1 : G) * NWAVES;
        { constexpr int CI_N = 2 * (DM / 64) * (DFF / 32);
          unsigned* CMAX = (unsigned*)(ctl + CW_CMAX);
          if (cgw < CI_N) {
            f32x4 ra[8], rb[8]; int it = cgw;
#define CM_DECODE(it_, W_, k0_, n0_, wh_) do { const int wh2_ = (it_) / ((DM / 64) * (DFF / 32)), r_ = (it_) % ((DM / 64) * (DFF / 32)); wh_ = wh2_; W_ = wh2_ ? w_up : w_gate; k0_ = 64 * (r_ / 344); n0_ = 32 * (r_ % 344); } while (0)
            const float* W; int k0, n0, wh;
            CM_DECODE(it, W, k0, n0, wh);
            tr_load(ra, W, DFF, k0, n0, lane);
            for (;;) {
                const int itn = it + cngw; const bool more = itn < CI_N;
                const float* W2 = W; int k02 = k0, n02 = n0, wh2 = wh;
                if (more) { CM_DECODE(itn, W2, k02, n02, wh2); tr_load(rb, W2, DFF, k02, n02, lane); }
                f32x4 mx = {0.f, 0.f, 0.f, 0.f};
#pragma unroll
                for (int j = 0; j < 8; ++j) { const float gk = g_ffn[k0 + 8 * j + (lane >> 3)];
                    mx.x = fmaxf(mx.x, fabsf(ra[j].x * gk)); mx.y = fmaxf(mx.y, fabsf(ra[j].y * gk)); mx.z = fmaxf(mx.z, fabsf(ra[j].z * gk)); mx.w = fmaxf(mx.w, fabsf(ra[j].w * gk)); }
#pragma unroll
                for (int o = 8; o < 64; o <<= 1) { mx.x = fmaxf(mx.x, __shfl_xor(mx.x, o)); mx.y = fmaxf(mx.y, __shfl_xor(mx.y, o)); mx.z = fmaxf(mx.z, __shfl_xor(mx.z, o)); mx.w = fmaxf(mx.w, __shfl_xor(mx.w, o)); }
                if (lane < 8) { unsigned* d = CMAX + wh * DFF + n0 + 4 * lane;
                    __hip_atomic_fetch_max(d + 0, __float_as_uint(mx.x), __ATOMIC_RELAXED, __HIP_MEMORY_SCOPE_AGENT); __hip_atomic_fetch_max(d + 1, __float_as_uint(mx.y), __ATOMIC_RELAXED, __HIP_MEMORY_SCOPE_AGENT);
                    __hip_atomic_fetch_max(d + 2, __float_as_uint(mx.z), __ATOMIC_RELAXED, __HIP_MEMORY_SCOPE_AGENT); __hip_atomic_fetch_max(d + 3, __float_as_uint(mx.w), __ATOMIC_RELAXED, __HIP_MEMORY_SCOPE_AGENT); }
                if (!more) break;
#pragma unroll
                for (int j = 0; j < 8; ++j) ra[j] = rb[j];
                W = W2; k0 = k02; n0 = n02; wh = wh2; it = itn;
            }
#undef CM_DECODE
          } }
        { unsigned* CMAXD = (unsigned*)(ctl + CW_CMAXD);
          for (int it = cgw; it < (DFF / 64) * (DM / 32); it += NGW) { const int kb = it / 128, nb = it % 128; f32x4 r[8];
            tr_load(r, w_down, DM, 64 * kb, 32 * nb, lane);
#define HB4(a, b) { const f32x4 t_ = a; a = t_ + b; b = t_ - b; }
            HB4(r[0], r[1]) HB4(r[2], r[3]) HB4(r[4], r[5]) HB4(r[6], r[7]) HB4(r[0], r[2]) HB4(r[1], r[3]) HB4(r[4], r[6]) HB4(r[5], r[7])
#undef HB4
            const int l3 = lane >> 3; f32x4 mx = {0.f, 0.f, 0.f, 0.f};
#pragma unroll
            for (int b = 0; b < 3; ++b) { const int o = 8 << b; const bool up = (l3 >> b) & 1;
#pragma unroll
                for (int j = 0; j < 8; ++j) { f32x4 p; p.x = __shfl_xor(r[j].x, o); p.y = __shfl_xor(r[j].y, o); p.z = __shfl_xor(r[j].z, o); p.w = __shfl_xor(r[j].w, o); r[j] = up ? p - r[j] : r[j] + p; } }
#pragma unroll
            for (int j = 0; j < 8; ++j) { mx.x = fmaxf(mx.x, fabsf(r[j].x)); mx.y = fmaxf(mx.y, fabsf(r[j].y)); mx.z = fmaxf(mx.z, fabsf(r[j].z)); mx.w = fmaxf(mx.w, fabsf(r[j].w)); }
#pragma unroll
            for (int o = 8; o < 64; o <<= 1) { mx.x = fmaxf(mx.x, __shfl_xor(mx.x, o)); mx.y = fmaxf(mx.y, __shfl_xor(mx.y, o)); mx.z = fmaxf(mx.z, __shfl_xor(mx.z, o)); mx.w = fmaxf(mx.w, __shfl_xor(mx.w, o)); }
            if (lane < 8) { unsigned* d = CMAXD + 32 * nb + 4 * lane;
                __hip_atomic_fetch_max(d + 0, __float_as_uint(mx.x), __ATOMIC_RELAXED, __HIP_MEMORY_SCOPE_AGENT); __hip_atomic_fetch_max(d + 1, __float_as_uint(mx.y), __ATOMIC_RELAXED, __HIP_MEMORY_SCOPE_AGENT);
                __hip_atomic_fetch_max(d + 2, __float_as_uint(mx.z), __ATOMIC_RELAXED, __HIP_MEMORY_SCOPE_AGENT); __hip_atomic_fetch_max(d + 3, __float_as_uint(mx.w), __ATOMIC_RELAXED, __HIP_MEMORY_SCOPE_AGENT); } } }
          } }
        PROBE_T1(1);
        if (BOTH(1)) GRID_BAR();
    }

    if (IN(2)) {
        PROBE_T0(2);
        LAS float* U = (LAS float*)(lds + att::OFF_U); LAS float* scn = (LAS float*)(lds + att::OFF_SCAN);
        constexpr int N_ITEMS = 512 + 512 + 256 + 256;
        float* OSQ = (float*)(ctl + CW_OSQ);
        BgJob bg{w_out, w_gate, w_up, w_down, g_ffn, g_of, g_os, Wout_t, Wgu_t, Wdn_t, (const unsigned*)(ctl + CW_CMAX), (const unsigned*)(ctl + CW_CMAXD), lds + BG_OFF + wave * BG_BYTES, gw, -1, NGW, BG_N - BG_I_D};
#ifndef PROBE_REP2
#define PROBE_REP2 1
#endif
#pragma unroll 1
        for (int prep = 0; prep < PROBE_REP2; ++prep) {
        const long odelta = (prep + 1 < PROBE_REP2) ? (long)((char*)XN - (char*)QO) / 2 : 0l;
        if (prep) GRID_BAR();
        for (int it = vcu; it < N_ITEMS; it += G) {
            if (it < 1024) {
                const int mode = it >> 9, r = it & 511, bh = r >> 2, pi = r & 3, b = bh >> 4, h = bh & 15;
                const bf16* Kp = KVB + (size_t)(mode * 2) * (KV_STRIDE / 2) + (size_t)(b * SEQ) * WG + h * HD;
                const bf16* Vp = Kp + (KV_STRIDE / 2);
                bf16* Qp = QO + (size_t)(b * SEQ) * DM + mode * WG + h * HD;
                if (mode == 0) {
                    const float* lf = out + O_PFL + (size_t)(b * SEQ) * NHG + h;
                    att::scan_u(U, scn, SEQ, [&](int t) { return lf[(size_t)t * NHG]; });
                }
#pragma unroll 1
                for (int pass = 0; pass < 2; ++pass) { const int qb = pass ? 7 - pi : pi; bf16* Qb = Qp + (size_t)(qb * 256) * DM;
                    if (mode == 0) att::attn_unit_pp<0>(lds + RING_OFF, Qb, Kp, Vp, Qb + odelta, qb * 256, bg, OSQ + 2 * (size_t)(b * SEQ + qb * 256) + mode);
                    if (mode == 1) att::attn_unit_pp<1>(lds + RING_OFF, Qb, Kp, Vp, Qb + odelta, qb * 256, bg, OSQ + 2 * (size_t)(b * SEQ + qb * 256) + mode);
                }
            } else {
                const int r = it - 1024, mode = r >> 8, bh = r & 255, b = bh >> 4, h = bh & 15;
                bf16* Qb = QO + (size_t)(MP + b * DS) * DM + mode * WG + h * HD;
                const float* Kc = (mode ? cache_sk : cache_fk) + (size_t)(b * PAST) * WG + h * HD; const float* Vc = (mode ? cache_sv : cache_fv) + (size_t)(b * PAST) * WG + h * HD;
                const float* Kn = out + (mode ? O_SSK : O_SFK) + (size_t)(b * DS) * WG + h * HD; const float* Vn = out + (mode ? O_SSV : O_SFV) + (size_t)(b * DS) * WG + h * HD;
                if (mode == 0) {
                    const float* lfc = cache_fl + (size_t)(b * PAST) * NHG + h; const float* lfn = out + O_SFL + (size_t)(b * DS) * NHG + h;
                    att::scan_u(U, scn, TKS, [&](int t) { return t < PAST ? lfc[(size_t)t * NHG] : lfn[(size_t)(t - PAST) * NHG]; });
                    att::attn_unit<0, true>(lds + RING_OFF, Qb, nullptr, nullptr, Qb + odelta, PAST, Kc, Vc, Kn, Vn, bg, OSQ + 2 * (size_t)(MP + b * DS) + mode);
                } else {
                    att::attn_unit<1, true>(lds + RING_OFF, Qb, nullptr, nullptr, Qb + odelta, PAST, Kc, Vc, Kn, Vn, bg, OSQ + 2 * (size_t)(MP + b * DS) + mode);
                }
            }
        }
        while (bg.have >= 0 || bg.next < bg.end) { bg_step(bg, lane); VM_WAIT(); }
        }
        PROBE_T1(2);
        if (BOTH(2)) GRID_BAR();
    }


    float* SSQ = (float*)(ctl + CW_SSQ);
    if (IN(4)) {
        PROBE_T0(4);
        pg8::Gemm g{QO, Wout_t, MT, DM, DM}; pg8::OutOrder S; S.init(MP, DM, DM, G, bx);
#ifndef PROBE_REP4
#define PROBE_REP4 1
#endif
#pragma unroll 1
        for (int rep = 0; rep < PROBE_REP4; ++rep) { if (rep) GRID_BAR();
        pg8::EpiX2 E{XN, (rep + 1 < PROBE_REP4) ? (float*)(ctl + CW_SSQ_DUMMY) : SSQ, PART, (const float*)(ctl + CW_OSQ), (unsigned*)(ctl + CW_AMAX)};
        pg8::gemm_phase<pg8::EpiX2, pg8::OutOrder, true, true, true>(lds + RING_OFF, g, S, E); }
        PROBE_T1(4);
        if (BOTH(4)) GRID_BAR();
    }

    if (IN(5)) {
        unsigned* AMAX = (unsigned*)(ctl + CW_AMAX); unsigned char* XQ = ws + WS_XQ;
        for (int m = gw; m < MT; m += NGW) {
            f32x4 v[16]; float amax;
            if (m >= MP && G == 256) {
                const int ms = m - MP; const f32x4* xr = (const f32x4*)(x_sample + (size_t)ms * DM) + lane; float s = 0.f, mx = 0.f;
#pragma unroll
                for (int j = 0; j < 16; ++j) v[j] = xr[64 * j];
                const float* oq = (const float*)(ctl + CW_OSQ) + 2 * (size_t)m;
                const float rf = rsqrtf(oq[0] * (1.f / WG) + EPS), rs2 = rsqrtf(oq[1] * (1.f / WG) + EPS);
#pragma unroll 1
                for (int ks = 0; ks < 8; ++ks) { const f32x4* pr = (const f32x4*)(PART + (size_t)ks * ((size_t)MS * DM) + (size_t)ms * DM) + lane; const float sc = ks < 4 ? rf : rs2;
#pragma unroll
                    for (int j = 0; j < 16; ++j) v[j] += pr[64 * j] * sc; }
                v2u* o8 = (v2u*)(XN + (size_t)m * DM) + lane;
#pragma unroll
                for (int j = 0; j < 16; ++j) { s += (v[j].x * v[j].x + v[j].y * v[j].y) + (v[j].z * v[j].z + v[j].w * v[j].w);
                    mx = fmaxf(fmaxf(mx, fmaxf(fabsf(v[j].x), fabsf(v[j].y))), fmaxf(fabsf(v[j].z), fabsf(v[j].w)));
                    v2u w; w.x = cvt_pk_bf16(v[j].x, v[j].y); w.y = cvt_pk_bf16(v[j].z, v[j].w); o8[64 * j] = w; }
                s = wave_sum(s);
#pragma unroll
                for (int o = 1; o < 64; o <<= 1) mx = fmaxf(mx, __shfl_xor(mx, o));
                if (lane == 0) { SSQ[m] = s; AMAX[m] = __float_as_uint(mx); }
                amax = mx;
            } else {
                const v2u* x2r = (const v2u*)(XN + (size_t)m * DM) + lane;
#pragma unroll
                for (int j = 0; j < 16; ++j) { const v2u x = x2r[64 * j]; v[j] = (f32x4){bf_lo(x.x), bf_hi(x.x), bf_lo(x.y), bf_hi(x.y)}; }
                amax = __uint_as_float(AMAX[m]);
            }
            const float qs = amax > 0.f ? 127.f / amax : 0.f;
            unsigned* q4 = (unsigned*)(XQ + (size_t)m * DM) + lane;
#pragma unroll
            for (int j = 0; j < 16; ++j) {
                const int a = (int)__builtin_rintf(fminf(fmaxf(v[j].x * qs, -127.f), 127.f)) & 0xff, b = (int)__builtin_rintf(fminf(fmaxf(v[j].y * qs, -127.f), 127.f)) & 0xff;
                const int c = (int)__builtin_rintf(fminf(fmaxf(v[j].z * qs, -127.f), 127.f)) & 0xff, d = (int)__builtin_rintf(fminf(fmaxf(v[j].w * qs, -127.f), 127.f)) & 0xff;
                q4[64 * j] = (unsigned)a | ((unsigned)b << 8) | ((unsigned)c << 16) | ((unsigned)d << 24); }
        }
        if (BOTH(5)) GRID_BAR();
    }

    if (IN(6)) {
        PROBE_T0(6);
#ifndef PROBE_REP6
#define PROBE_REP6 1
#endif
#pragma unroll 1
        for (int rep = 0; rep < PROBE_REP6; ++rep) {
        pg8::Gemm g{(const bf16*)(ws + WS_XQ), Wgu_t, MT, 2 * DFF, DM / 2}; pg8::StaticOrder S; S.init(MT, 2 * DFF, DM / 2, G, bx);
        pg8::EpiGluQ E{ACT, SSQ, (const unsigned*)(ctl + CW_AMAX), (const unsigned*)(ctl + CW_CMAX)};
        pg8::gemm_phase<pg8::EpiGluQ, pg8::StaticOrder, true, true, false, true>(lds + RING_OFF, g, S, E);
        if (rep + 1 == PROBE_REP6) { const int nwg6 = (MT / 256) * (2 * DFF / 256), rem6 = nwg6 % G;
          if (rem6 == 0 || bx >= rem6) { const int cgw = (rem6 ? bx - rem6 : bx) * NWAVES + wave, cngw = (rem6 ? G - rem6 : G) * NWAVES;
            BgJob bd{w_out, w_gate, w_up, w_down, g_ffn, g_of, g_os, Wout_t, Wgu_t, Wdn_t, (const unsigned*)(ctl + CW_CMAX), (const unsigned*)(ctl + CW_CMAXD), lds + BG_OFF + wave * BG_BYTES, BG_N - BG_I_D + cgw, -1, cngw, BG_N};
            while (bd.have >= 0 || bd.next < bd.end) { bg_step(bd, lane); VM_WAIT(); } } }
        PROBE_T1(6);
        if (BOTH(6)) GRID_BAR();
        }
    }

    if (IN(7)) {
        PROBE_T0(7);
        { unsigned* AMAX2 = (unsigned*)(ctl + CW_AMAX2); unsigned char* ACTQ = ws + WS_ACTQ;
#define HB(a, b) { const float t_ = a; a = t_ + b; b = t_ - b; }
#define ROT32(x_, f_) do { f_[0] = bf_lo(x_.x); f_[1] = bf_hi(x_.x); f_[2] = bf_lo(x_.y); f_[3] = bf_hi(x_.y); f_[4] = bf_lo(x_.z); f_[5] = bf_hi(x_.z); f_[6] = bf_lo(x_.w); f_[7] = bf_hi(x_.w); \
            HB(f_[0], f_[1]) HB(f_[2], f_[3]) HB(f_[4], f_[5]) HB(f_[6], f_[7]) HB(f_[0], f_[2]) HB(f_[1], f_[3]) HB(f_[4], f_[6]) HB(f_[5], f_[7]) HB(f_[0], f_[4]) HB(f_[1], f_[5]) HB(f_[2], f_[6]) HB(f_[3], f_[7]) \
            _Pragma("unroll") for (int i_ = 0; i_ < 8; ++i_) { const float p_ = __shfl_xor(f_[i_], 1); f_[i_] = (lane & 1) ? p_ - f_[i_] : f_[i_] + p_; } \
            _Pragma("unroll") for (int i_ = 0; i_ < 8; ++i_) { const float p_ = __shfl_xor(f_[i_], 2); f_[i_] = (lane & 2) ? p_ - f_[i_] : f_[i_] + p_; } } while (0)
          constexpr int NCH = DFF / 8, NIT = (NCH + 63) / 64;
          for (int m = gw; m < MT; m += NGW) {
              const v4u* src_ = (const v4u*)(ACT + (size_t)m * DFF); v2u* dst_ = (v2u*)(ACTQ + (size_t)m * DFF);
              v4u x[NIT];
#pragma unroll
              for (int it = 0; it < NIT; ++it) { const int c = lane + 64 * it; x[it] = src_[c < NCH ? c : NCH - 1]; }
              float mx = 0.f;
#pragma unroll
              for (int it = 0; it < NIT; ++it) { float f[8]; ROT32(x[it], f); float m8 = 0.f;
#pragma unroll
                  for (int i = 0; i < 8; ++i) m8 = fmaxf(m8, fabsf(f[i]));
                  if (lane + 64 * it < NCH) mx = fmaxf(mx, m8); }
#pragma unroll
              for (int o = 1; o < 64; o <<= 1) mx = fmaxf(mx, __shfl_xor(mx, o));
              const float qs = mx > 0.f ? 127.f / mx : 0.f;
#pragma unroll
              for (int it = 0; it < NIT; ++it) { float f[8]; ROT32(x[it], f); int q[8];
#pragma unroll
                  for (int i = 0; i < 8; ++i) q[i] = (int)__builtin_rintf(fminf(fmaxf(f[i] * qs, -127.f), 127.f)) & 0xff;
                  v2u w; w.x = (unsigned)q[0] | ((unsigned)q[1] << 8) | ((unsigned)q[2] << 16) | ((unsigned)q[3] << 24); w.y = (unsigned)q[4] | ((unsigned)q[5] << 8) | ((unsigned)q[6] << 16) | ((unsigned)q[7] << 24);
                  if (lane + 64 * it < NCH) dst_[lane + 64 * it] = w; }
              if (lane == 0) AMAX2[m] = __float_as_uint(mx); }
#undef ROT32
#undef HB
          GRID_BAR(); }
        if (G == 256) {
            pg8::Gemm g{(const bf16*)(ws + WS_ACTQ), Wdn_t, MT, DM, DFF / 2};
            pg8::FusedDownOrder S; S.c = bx; S.nkt_full = DFF / 128;
            pg8::EpiDownFused E{XN, out, PART, (float*)(ctl + CW_SSQ3), (unsigned*)(ctl + CW_CNT7), g_final, (const unsigned*)(ctl + CW_AMAX2), (const unsigned*)(ctl + CW_CMAXD)};
            pg8::gemm_phase<pg8::EpiDownFused, pg8::FusedDownOrder, true, true, false, true>(lds + RING_OFF, g, S, E);
        }
        PROBE_T1(7);
        if (BOTH(7)) GRID_BAR();
    }

    if (IN(8)) {
        PROBE_T0(8);
        for (int m = (G == 256 ? MP : 0) + gw; m < MT; m += NGW) { f32x4* xr = (f32x4*)(out + (size_t)m * DM) + lane; const f32x4* gr = (const f32x4*)g_final + lane;
            f32x4 v[16]; float s = 0.f;
            if (m >= MP && G == 256) {
                const v2u* x2r = (const v2u*)(XN + (size_t)m * DM) + lane;
#pragma unroll
                for (int j = 0; j < 16; ++j) { const v2u x = x2r[64 * j]; v[j] = (f32x4){bf_lo(x.x), bf_hi(x.x), bf_lo(x.y), bf_hi(x.y)}; }
#pragma unroll 1
                for (int ks = 0; ks < 8; ++ks) { const f32x4* pr = (const f32x4*)(PART + (size_t)ks * ((size_t)MS * DM) + (size_t)(m - MP) * DM) + lane;
#pragma unroll
                    for (int j = 0; j < 16; ++j) v[j] += pr[64 * j]; }
            } else {
#pragma unroll
                for (int j = 0; j < 16; ++j) v[j] = xr[64 * j];
            }
#pragma unroll
            for (int j = 0; j < 16; ++j) s += (v[j].x * v[j].x + v[j].y * v[j].y) + (v[j].z * v[j].z + v[j].w * v[j].w);
            const float rstd = rsqrtf(wave_sum(s) * (1.f / DM) + EPS);
#pragma unroll
            for (int j = 0; j < 16; ++j) { const f32x4 gg = gr[64 * j]; xr[64 * j] = v[j] * rstd * gg; } }
        PROBE_T1(8);
    }
#undef IN
#undef BOTH
#undef GRID_BAR
}

extern "C" void kernel_launch(void* const* d_in, const int* in_sizes, int n_in, void* d_out, int out_size, void* d_ws, size_t ws_size, hipStream_t stream) {
    static int grid = 0;
    if (grid == 0) {
        if (n_in != 18 || (size_t)out_size != O_END || ws_size < WS_END) { fprintf(stderr, "kernel_launch: unexpected shapes (n_in %d, out %d, ws %zu)\n", n_in, out_size, ws_size); grid = -1; return; }
        int dev = 0, cus = 0;
        if (hipGetDevice(&dev) != hipSuccess || hipDeviceGetAttribute(&cus, hipDeviceAttributeMultiprocessorCount, dev) != hipSuccess) { grid = -1; return; }
        if (hipFuncSetAttribute((const void*)fwd_kernel, hipFuncAttributeMaxDynamicSharedMemorySize, LDS_BYTES) != hipSuccess) { fprintf(stderr, "kernel_launch: hipFuncSetAttribute failed\n"); grid = -1; return; }
        int per_cu = 0;
        if (hipOccupancyMaxActiveBlocksPerMultiprocessor(&per_cu, (const void*)fwd_kernel, NWAVES * 64, LDS_BYTES) != hipSuccess || per_cu < 1) fprintf(stderr, "kernel_launch: occupancy query says %d\n", per_cu);
        (void)hipGetLastError();
        grid = cus;
    }
    if (grid < 0) return;
    (void)hipMemsetAsync((char*)d_ws + WS_CTL, 0, CTL_ZERO_BYTES, stream);
    Args a{};
    for (int i = 0; i < 18; ++i) a.in[i] = (const float*)d_in[i];
    a.out = (float*)d_out; a.ws = (unsigned char*)d_ws;
#if MK_N_LAUNCHES == 1
    a.ph_lo = 0; a.ph_hi = 9;
    hipLaunchKernelGGL(fwd_kernel, dim3(grid), dim3(NWAVES * 64), LDS_BYTES, stream, a);
#else
    for (int p = 0; p < 9; ++p) { a.ph_lo = p; a.ph_hi = p + 1; hipLaunchKernelGGL(fwd_kernel, dim3(grid), dim3(NWAVES * 64), LDS_BYTES, stream, a); }
#endif
}
```

```cpp
#include <hip/hip_runtime.h>
#include <cstdio>
#include <cstdint>

#ifndef MK_N_LAUNCHES
#define MK_N_LAUNCHES 1
#endif

#define GAS __attribute__((address_space(1)))
#define LAS __attribute__((address_space(3)))
typedef unsigned short bf16;
typedef unsigned v4u __attribute__((ext_vector_type(4)));
typedef unsigned v2u __attribute__((ext_vector_type(2)));
typedef float f32x4 __attribute__((ext_vector_type(4)));
typedef float f32x16 __attribute__((ext_vector_type(16)));
typedef short bf16x8 __attribute__((ext_vector_type(8)));
typedef short s16x4 __attribute__((ext_vector_type(4)));
typedef int i32x4 __attribute__((ext_vector_type(4)));
typedef GAS unsigned gu32;

constexpr int DM = 4096, NB = 8, SEQ = 2048, DB = 16, DS = 32, PAST = 1024, HD = 128, NHG = 16;
constexpr int WG = NHG * HD;
constexpr int DFF = 11008;
constexpr int MP = NB * SEQ, MS = DB * DS, MT = MP + MS;
constexpr int DIN = 3 * WG + NHG + 3 * WG;
constexpr int NIN = 6 * WG + 256;
constexpr int TKS = PAST + DS;
constexpr int KVROWS = MP + DB * TKS;
constexpr float EPS = 1e-6f;
constexpr float LOG2E = 1.4426950408889634f;
constexpr float QSCALE = 0.08838834764831845f * LOG2E;

constexpr size_t O_YP = 0, O_YS = O_YP + (size_t)MP * DM;
constexpr size_t O_PFK = O_YS + (size_t)MS * DM, O_PFV = O_PFK + (size_t)MP * WG, O_PFL = O_PFV + (size_t)MP * WG;
constexpr size_t O_PSK = O_PFL + (size_t)MP * NHG, O_PSV = O_PSK + (size_t)MP * WG;
constexpr size_t O_SFK = O_PSV + (size_t)MP * WG, O_SFV = O_SFK + (size_t)MS * WG, O_SFL = O_SFV + (size_t)MS * WG;
constexpr size_t O_SSK = O_SFL + (size_t)MS * NHG, O_SSV = O_SSK + (size_t)MS * WG, O_END = O_SSV + (size_t)MS * WG;

constexpr size_t MiB = 1u << 20;
constexpr size_t WS_CTL = 0, CTL_ZERO_BYTES = 2 * MiB;
constexpr size_t WS_WIN = 2 * MiB;
constexpr size_t WS_WOUT = 100 * MiB;
constexpr size_t WS_WGU = 132 * MiB;
constexpr size_t WS_WDN = 304 * MiB;
constexpr size_t WS_XN = 390 * MiB;
constexpr size_t WS_QO = 522 * MiB;
constexpr size_t WS_KV = 654 * MiB, KV_STRIDE = 130 * MiB;
constexpr size_t WS_ACT = 654 * MiB;
constexpr size_t WS_PART = 1174 * MiB;
constexpr size_t WS_XQ = 1238 * MiB;
constexpr size_t WS_ACTQ = 1304 * MiB;
constexpr size_t WS_END = 1482 * MiB;
static_assert((size_t)NIN * DM * 2 == 98 * MiB && (size_t)2 * DFF * DM * 2 == 172 * MiB && (size_t)DM * DFF * 2 == 86 * MiB && (size_t)MT * DM * 2 == 132 * MiB && (size_t)KVROWS * WG * 2 == KV_STRIDE, "ws map");
static_assert(WS_ACT + (size_t)MT * DFF * 2 <= WS_PART && WS_KV + 4 * KV_STRIDE == WS_PART && WS_PART + (size_t)8 * MS * DM * 4 == WS_XQ && WS_XQ + (size_t)MT * DM == WS_ACTQ && WS_ACTQ + (size_t)MT * DFF <= WS_END, "ws map");
constexpr int CW_TMO = 0, CW_CODE = 1, CW_BAR = 4096, CW_SSQ = 16384, CW_SSQ_DUMMY = 40960, CW_SSQ3 = 65536, CW_CNT7 = 163840, CW_OSQ = 180224, CW_SSQ0 = 229376, CW_CMAX = 262144, CW_AMAX = 294912, CW_AMAX2 = 311808, CW_CMAXD = 328704;
static_assert(CW_SSQ0 + MT <= CW_CMAX && CW_CMAX + 2 * DFF <= CW_AMAX && CW_AMAX + MT <= CW_AMAX2 && CW_AMAX2 + MT <= CW_CMAXD && (size_t)(CW_CMAXD + DM) * 4 <= CTL_ZERO_BYTES, "ctl");
static_assert(CW_CNT7 + 64 * 64 <= CW_OSQ && CW_OSQ + 2 * MT <= CW_SSQ0 && (CW_SSQ0 + MT) * 4 <= (int)CTL_ZERO_BYTES, "ctl");
static_assert(CW_SSQ_DUMMY + MT <= CW_SSQ3 && CW_SSQ3 + MP <= CW_CNT7 && (CW_CNT7 + 64 * 64) * 4 <= (int)CTL_ZERO_BYTES, "ctl");
static_assert((CW_SSQ + MT) * 4 <= (int)CTL_ZERO_BYTES, "ctl");

constexpr int NWAVES = 8;
constexpr int RING_OFF = 0, RING_BYTES = 131072;
static_assert(78848 + 8 * 8192 >= RING_BYTES && 78848 + 8 * 8192 + 448 <= 147456, "LDS map");
constexpr int BG_OFF = 78848, BG_BYTES = 8192;
constexpr int LDSCTL_OFF = BG_OFF + NWAVES * BG_BYTES, MISC_OFF = LDSCTL_OFF + 320;
constexpr int LDS_BYTES = 147456;

#define RLX_AGENT __ATOMIC_RELAXED, __HIP_MEMORY_SCOPE_AGENT
#define LDS_WAIT() asm volatile("s_waitcnt lgkmcnt(0)" ::: "memory")
#define VM_WAIT() asm volatile("s_waitcnt vmcnt(0)" ::: "memory")

__device__ __forceinline__ unsigned cvt_pk_bf16(float lo, float hi) { unsigned r; asm volatile("v_cvt_pk_bf16_f32 %0, %1, %2" : "=v"(r) : "v"(lo), "v"(hi)); return r; }

namespace pg8 {
#define PG8_LAS __attribute__((address_space(3)))
typedef unsigned short bf16_t;
constexpr int BM = 256, BK = 64, HALF = 128, HTB = HALF * BK * 2, STAGE_BYTES = 8 * HTB, NXCD = 8, WGM = 8;
__host__ __device__ __forceinline__ int lds_byte(int r, int c) { const int st = (r >> 4) * 2 + (c >> 5), rr = r & 15, cc = c & 31, ob = rr * 64 + cc * 2; return st * 1024 + (ob ^ (((ob >> 9) & 1) << 5)); }
__host__ __device__ __forceinline__ void stage_rc(int b, int& R, int& C) { const int st = b / 1024, sb = b % 1024, swz = sb ^ (((sb >> 9) & 1) << 5); R = (st >> 1) * 16 + swz / 64; C = (st & 1) * 32 + (swz % 64) / 2; }
__host__ __device__ __forceinline__ int perm32(int rho) { const int n = rho >> 4, i = rho & 15; return 8 * (i >> 2) + 4 * n + (i & 3); }
struct Unit { int pm, pn, kt0, nkt, ks; };
struct Gemm { const bf16_t* A; const bf16_t* Bt; int M, N, K; };
struct StaticOrder {
    int nM, nN, nwg, G, c, nkt_full;
    __host__ __device__ void init(int M, int N, int K, int G_, int c_) { nM = M / BM; nN = N / BM; nwg = nM * nN; G = G_; c = c_; nkt_full = K / BK; }
    __host__ __device__ __forceinline__ void decode(int L, int& pm, int& pn) const {
        int wgid = L; { const int q = nwg / NXCD, r = nwg % NXCD, xcd = wgid % NXCD, off = wgid / NXCD; wgid = (xcd < r ? xcd * (q + 1) : r * (q + 1) + (xcd - r) * q) + off; }
        const int nig = WGM * nN, gid = wgid / nig, fm = gid * WGM, gsz = (nM - fm) < WGM ? (nM - fm) : WGM;
        pm = fm + ((wgid % nig) % gsz); pn = (wgid % nig) / gsz;
    }
    __host__ __device__ __forceinline__ bool next(int i, Unit& u) const {
        const long L = (long)i * G + c; if (L >= nwg) return false;
        int pm, pn; decode((int)L, pm, pn);
        u.pm = pm; u.pn = pn; u.kt0 = 0; u.nkt = nkt_full; u.ks = -1; return true;
    }
    __device__ __forceinline__ void a_ready(const Unit&) const {}
    __device__ __forceinline__ void done(const Unit&) const {}
};
template <int A, int B, int C> struct TailSplitOrder : StaticOrder {
    __device__ __forceinline__ bool next(int i, Unit& u) const {
        const long L = (long)i * G + c; const bool g256 = (G == 256);
        if (g256 ? (i > 4) : (L >= nwg + 32)) return false;
        const bool stat = g256 ? (i < 4) : (L < nwg), spl = g256 && i == 4;
        const int tile = g256 ? (c >> 3) : (int)(L - nwg), ks = c & 7;
        int pm, pn; decode(stat ? (int)L : 0, pm, pn);
        u.pm = stat ? pm : MP / BM + (tile >> 4); u.pn = stat ? pn : (tile & 15);
        u.ks = spl ? ks : -1; u.kt0 = spl ? (ks < C ? A * ks : A * C + B * (ks - C)) : 0; u.nkt = spl ? (ks < C ? A : B) : nkt_full;
        return true;
    }
};
typedef TailSplitOrder<22, 20, 6> DownOrder;
typedef TailSplitOrder<8, 8, 8> OutOrder;
static_assert(6 * 22 + 2 * 20 == DFF / 64 && 8 * 8 == DM / 64, "K splits");
template <bool I8> struct AccSel { typedef f32x4 T; }; template <> struct AccSel<true> { typedef i32x4 T; };
template <class Epi, class Sched, bool ALIGN_EPI = false, bool SP2 = false, bool MIDK = false, bool I8 = false>
__device__ __forceinline__ void gemm_phase(PG8_LAS unsigned char* lds, const Gemm g, const Sched& S, const Epi& E) {
    const int tid = threadIdx.x, wid = __builtin_amdgcn_readfirstlane(tid >> 6), lane = tid & 63, wr = wid >> 2, wc = wid & 3, fr = lane & 15, fq = lane >> 4;
    const int K = g.K;
    unsigned voffA[2], voffB[2];
#pragma unroll
    for (int i = 0; i < 2; ++i) { int R, C; stage_rc(tid * 16 + i * 8192, R, C); const int Rb = Epi::PERM ? ((R & ~31) + perm32(R & 31)) : R;
        voffA[i] = (unsigned)(R * K + C) * 2u; voffB[i] = (unsigned)(Rb * K + C) * 2u; }
    const size_t kstep = (size_t)(BK * 2);
    const size_t hstep = (size_t)HALF * K * 2;
    const size_t tstep = 2 * hstep;
    const unsigned ldsw = (unsigned)wid * 1024u;
    const int aoff = lds_byte(wr * 64 + fr, fq * 8), boff = lds_byte(wc * 32 + fr, fq * 8);
#define PG8_SA(b, h) (((b) * 2 + (h)) * HTB)
#define PG8_SB(b, h) ((4 + (b) * 2 + (h)) * HTB)
#define PG8_STAGE(bufoff, gbase, voff) do { _Pragma("unroll") for (int _i = 0; _i < 2; ++_i) \
        __builtin_amdgcn_global_load_lds((const unsigned*)((const char*)(gbase) + (voff)[_i]), (PG8_LAS unsigned*)(lds + (bufoff) + ldsw + _i * 8192), 16, 0, 0); } while (0)
#define PG8_LDA(dst, b, h) do { _Pragma("unroll") for (int m = 0; m < 4; ++m) _Pragma("unroll") for (int k = 0; k < 2; ++k) dst[m][k] = *(const PG8_LAS bf16x8*)(lds + PG8_SA(b, h) + aoff + m * 2048 + k * 1024); } while (0)
#define PG8_LDB(dst, b, h) do { _Pragma("unroll") for (int n = 0; n < 2; ++n) _Pragma("unroll") for (int k = 0; k < 2; ++k) dst[n][k] = *(const PG8_LAS bf16x8*)(lds + PG8_SB(b, h) + boff + n * 2048 + k * 1024); } while (0)
#define PG8_MMA(ai, bj, At, Bt) do { __builtin_amdgcn_s_setprio(1); _Pragma("unroll") for (int m = 0; m < 4; ++m) _Pragma("unroll") for (int n = 0; n < 2; ++n) _Pragma("unroll") for (int k = 0; k < 2; ++k) \
        { if constexpr (I8) acc[ai][bj][m][n] = __builtin_amdgcn_mfma_i32_16x16x64_i8(__builtin_bit_cast(i32x4, Bt[n][k]), __builtin_bit_cast(i32x4, At[m][k]), acc[ai][bj][m][n], 0, 0, 0); \
          else acc[ai][bj][m][n] = __builtin_amdgcn_mfma_f32_16x16x32_bf16(Bt[n][k], At[m][k], acc[ai][bj][m][n], 0, 0, 0); } __builtin_amdgcn_s_setprio(0); } while (0)
#define PG8_WAIT_V(n) asm volatile("s_waitcnt vmcnt(" #n ")" ::: "memory")
#define PG8_WAIT_L(n) asm volatile("s_waitcnt lgkmcnt(" #n ")" ::: "memory")
#define PG8_BAR __builtin_amdgcn_s_barrier()
#define PG8_SCHED __builtin_amdgcn_sched_barrier(0)
    Unit cur, nxt; int ui = 0;
    if (!S.next(0, cur)) return;
    typedef typename AccSel<I8>::T acc_t; const acc_t acc_zero = {};
    acc_t acc[2][2][4][2];
#pragma unroll
    for (int a = 0; a < 2; ++a)
#pragma unroll
        for (int b = 0; b < 2; ++b)
#pragma unroll
            for (int m = 0; m < 4; ++m)
#pragma unroll
                for (int n = 0; n < 2; ++n) acc[a][b][m][n] = acc_zero;
    bf16x8 At[4][2], B0[2][2], B1[2][2];
    const char* cA = (const char*)g.A + (size_t)cur.pm * tstep + (size_t)cur.kt0 * kstep; const char* cB = (const char*)g.Bt + (size_t)cur.pn * tstep + (size_t)cur.kt0 * kstep;
    S.a_ready(cur);
    if constexpr (SP2) {
        PG8_STAGE(PG8_SB(0, 0), cB, voffB); PG8_STAGE(PG8_SB(0, 1), cB + hstep, voffB); PG8_STAGE(PG8_SA(0, 0), cA, voffA); PG8_STAGE(PG8_SA(0, 1), cA + hstep, voffA);
        if (wr == 1) PG8_BAR;
        PG8_WAIT_V(2); PG8_BAR;
        PG8_STAGE(PG8_SB(1, 0), cB + kstep, voffB); PG8_STAGE(PG8_SA(1, 0), cA + kstep, voffA); PG8_STAGE(PG8_SB(1, 1), cB + hstep + kstep, voffB);
        PG8_WAIT_V(6); PG8_BAR;
    } else {
        PG8_STAGE(PG8_SB(0, 0), cB, voffB); PG8_STAGE(PG8_SA(0, 0), cA, voffA); PG8_STAGE(PG8_SB(0, 1), cB + hstep, voffB); PG8_STAGE(PG8_SA(0, 1), cA + hstep, voffA);
        if (wr == 1) PG8_BAR;
        PG8_WAIT_V(4); PG8_BAR;
        PG8_STAGE(PG8_SB(1, 0), cB + kstep, voffB); PG8_STAGE(PG8_SA(1, 0), cA + kstep, voffA); PG8_STAGE(PG8_SB(1, 1), cB + hstep + kstep, voffB);
        PG8_WAIT_V(6); PG8_BAR;
    }
    for (;;) {
        const bool has_next = S.next(ui + 1, nxt);
        const char* nA = has_next ? (const char*)g.A + (size_t)nxt.pm * tstep + (size_t)nxt.kt0 * kstep : cA; const char* nB = has_next ? (const char*)g.Bt + (size_t)nxt.pn * tstep + (size_t)nxt.kt0 * kstep : cB;
        const int nt = cur.nkt;
        for (int t = 0; t < nt; t += 2) {
            const bool last = (t == nt - 2);
            const char* a1 = cA + (size_t)(t + 1) * kstep;
            const char* a2 = last ? nA : cA + (size_t)(t + 2) * kstep; const char* b2 = last ? nB : cB + (size_t)(t + 2) * kstep;
            const char* a3 = a2 + kstep; const char* b3 = b2 + kstep;
            if (last && has_next) S.a_ready(nxt);
            if constexpr (MIDK) { if (t == (nt >> 1) && cur.ks < 0) E.midk(acc, cur, wr, wc, fr, fq); }
            if constexpr (SP2) {
            PG8_LDB(B0, 0, 0); PG8_LDB(B1, 0, 1); PG8_SCHED; PG8_LDA(At, 0, 0); PG8_STAGE(PG8_SA(1, 1), a1 + hstep, voffA);
            PG8_WAIT_V(8); PG8_WAIT_L(0); PG8_BAR; PG8_MMA(0, 0, At, B0); PG8_MMA(0, 1, At, B1); PG8_BAR; PG8_SCHED;
            PG8_LDA(At, 0, 1); PG8_STAGE(PG8_SB(0, 0), b2, voffB); PG8_STAGE(PG8_SB(0, 1), b2 + hstep, voffB); PG8_STAGE(PG8_SA(0, 0), a2, voffA);
            PG8_WAIT_V(8); PG8_WAIT_L(0); PG8_BAR; PG8_MMA(1, 0, At, B0); PG8_MMA(1, 1, At, B1); PG8_BAR; PG8_SCHED;
            PG8_LDB(B0, 1, 0); PG8_LDB(B1, 1, 1); PG8_SCHED; PG8_LDA(At, 1, 0); PG8_STAGE(PG8_SA(0, 1), a2 + hstep, voffA);
            PG8_WAIT_V(8); PG8_WAIT_L(0); PG8_BAR; PG8_MMA(0, 0, At, B0); PG8_MMA(0, 1, At, B1); PG8_BAR; PG8_SCHED;
            PG8_LDA(At, 1, 1); PG8_STAGE(PG8_SB(1, 0), b3, voffB); PG8_STAGE(PG8_SB(1, 1), b3 + hstep, voffB); PG8_STAGE(PG8_SA(1, 0), a3, voffA);
            PG8_WAIT_V(8); PG8_WAIT_L(0); PG8_BAR; PG8_MMA(1, 0, At, B0); PG8_MMA(1, 1, At, B1); PG8_BAR; PG8_SCHED;
            } else {
            PG8_LDB(B0, 0, 0); PG8_SCHED; PG8_LDA(At, 0, 0); PG8_STAGE(PG8_SA(1, 1), a1 + hstep, voffA);
            PG8_WAIT_L(8); PG8_BAR; PG8_WAIT_L(0); PG8_MMA(0, 0, At, B0); PG8_BAR; PG8_SCHED;
            PG8_LDB(B1, 0, 1); PG8_STAGE(PG8_SB(0, 0), b2, voffB);
            PG8_BAR; PG8_WAIT_L(0); PG8_MMA(0, 1, At, B1); PG8_BAR;
            PG8_LDA(At, 0, 1); PG8_STAGE(PG8_SA(0, 0), a2, voffA);
            PG8_BAR; PG8_WAIT_L(0); PG8_MMA(1, 0, At, B0); PG8_BAR; PG8_SCHED;
            PG8_STAGE(PG8_SB(0, 1), b2 + hstep, voffB);
            PG8_WAIT_V(6); PG8_BAR; PG8_MMA(1, 1, At, B1); PG8_BAR;
            PG8_LDB(B0, 1, 0); PG8_SCHED; PG8_LDA(At, 1, 0); PG8_STAGE(PG8_SA(0, 1), a2 + hstep, voffA);
            PG8_WAIT_L(8); PG8_BAR; PG8_WAIT_L(0); PG8_MMA(0, 0, At, B0); PG8_BAR; PG8_SCHED;
            PG8_LDB(B1, 1, 1); PG8_STAGE(PG8_SB(1, 0), b3, voffB);
            PG8_BAR; PG8_WAIT_L(0); PG8_MMA(0, 1, At, B1); PG8_BAR;
            PG8_LDA(At, 1, 1); PG8_STAGE(PG8_SA(1, 0), a3, voffA);
            PG8_BAR; PG8_WAIT_L(0); PG8_MMA(1, 0, At, B0); PG8_BAR; PG8_SCHED;
            PG8_STAGE(PG8_SB(1, 1), b3 + hstep, voffB);
            PG8_WAIT_V(6); PG8_BAR; PG8_MMA(1, 1, At, B1); PG8_BAR;
            }
        }
        if constexpr (ALIGN_EPI) { if (wr == 0) PG8_BAR; }
        E(acc, cur, wr, wc, fr, fq); S.done(cur);
        if (!has_next) break;
#pragma unroll
        for (int a = 0; a < 2; ++a)
#pragma unroll
            for (int b = 0; b < 2; ++b)
#pragma unroll
                for (int m = 0; m < 4; ++m)
#pragma unroll
                    for (int n = 0; n < 2; ++n) acc[a][b][m][n] = acc_zero;
        cur = nxt; cA = nA; cB = nB; ++ui;
        if constexpr (ALIGN_EPI) { if (wr == 1) PG8_BAR; }
    }
    PG8_WAIT_V(0);
    if constexpr (!ALIGN_EPI) { if (wr == 0) PG8_BAR; }
    PG8_BAR;
#undef PG8_SA
#undef PG8_SB
#undef PG8_STAGE
#undef PG8_LDA
#undef PG8_LDB
#undef PG8_MMA
#undef PG8_WAIT_V
#undef PG8_WAIT_L
#undef PG8_BAR
#undef PG8_SCHED
}

__device__ __forceinline__ float log_sigmoid_f(float x) { return -(fmaxf(-x, 0.f) + log1pf(expf(-fabsf(x)))); }
struct EpiIn {
    static constexpr bool PERM = true;
    bf16_t* QO; bf16_t* KV; float* out; const float* bfg; const float* ssq0;
    __device__ __forceinline__ void operator()(const f32x4 (&acc)[2][2][4][2], const Unit& u, int wr, int wc, int fr, int fq) const {
        const int seg = u.pn >> 3;
        const int row0 = u.pm * BM + wr * 64 + fr;
        const int cseg = (u.pn & 7) * BM + wc * 32 + 8 * fq;
        const bool prompt = u.pm < (MP / BM);
        if (seg == 6) {
            if (wc == 0 && fq < 2) {
                const f32x4 b0 = *(const f32x4*)(bfg + 8 * fq), b1 = *(const f32x4*)(bfg + 8 * fq + 4);
#pragma unroll
                for (int ai = 0; ai < 2; ++ai)
#pragma unroll
                    for (int m = 0; m < 4; ++m) { const int row = row0 + ai * HALF + m * 16; const float rstd = rsqrtf(ssq0[row] * (1.f / DM) + EPS);
                        float* dst = prompt ? out + O_PFL + (size_t)row * NHG + 8 * fq : out + O_SFL + (size_t)(row - MP) * NHG + 8 * fq;
                        const f32x4 v0 = acc[ai][0][m][0] * rstd + b0, v1 = acc[ai][0][m][1] * rstd + b1; f32x4 r0, r1;
#pragma unroll
                        for (int j = 0; j < 4; ++j) { r0[j] = log_sigmoid_f(v0[j]); r1[j] = log_sigmoid_f(v1[j]); }
                        *(f32x4*)dst = r0; *(f32x4*)(dst + 4) = r1; }
            }
        } else if (seg == 0 || seg == 3) {
            bf16_t* base = QO + (seg == 3 ? WG : 0) + cseg;
#pragma unroll
            for (int ai = 0; ai < 2; ++ai)
#pragma unroll
                for (int m = 0; m < 4; ++m) { const int row = row0 + ai * HALF + m * 16; bf16_t* rowp = base + (size_t)row * DM; const float qs = rsqrtf(ssq0[row] * (1.f / DM) + EPS) * QSCALE;
#pragma unroll
                    for (int bj = 0; bj < 2; ++bj) { const f32x4 v0 = acc[ai][bj][m][0] * qs, v1 = acc[ai][bj][m][1] * qs;
                        v4u w; w.x = cvt_pk_bf16(v0[0], v0[1]); w.y = cvt_pk_bf16(v0[2], v0[3]); w.z = cvt_pk_bf16(v1[0], v1[1]); w.w = cvt_pk_bf16(v1[2], v1[3]);
                        *(v4u*)(rowp + bj * HALF) = w; } }
        } else {
            const int kvi = (seg == 1) ? 0 : (seg == 2) ? 1 : (seg == 4) ? 2 : 3;
            bf16_t* kvb = KV + (size_t)kvi * (KV_STRIDE / 2) + cseg;
            float* ob = out + (prompt ? O_PFK + (size_t)kvi * ((size_t)MP * WG) + (kvi >= 2 ? (size_t)MP * NHG : 0)
                                      : O_SFK + (size_t)kvi * ((size_t)MS * WG) + (kvi >= 2 ? (size_t)MS * NHG : 0)) + cseg;
#pragma unroll
            for (int ai = 0; ai < 2; ++ai)
#pragma unroll
                for (int m = 0; m < 4; ++m) { const int row = row0 + ai * HALF + m * 16; const int rs = row - MP;
                    const int kvrow = prompt ? row : MP + (rs >> 5) * TKS + PAST + (rs & 31);
                    const int orow = prompt ? row : rs;
                    bf16_t* rowp = kvb + (size_t)kvrow * WG; float* op = ob + (size_t)orow * WG; const float rstd = rsqrtf(ssq0[row] * (1.f / DM) + EPS);
#pragma unroll
                    for (int bj = 0; bj < 2; ++bj) { const f32x4 v0 = acc[ai][bj][m][0] * rstd, v1 = acc[ai][bj][m][1] * rstd;
                        v4u w; w.x = cvt_pk_bf16(v0[0], v0[1]); w.y = cvt_pk_bf16(v0[2], v0[3]); w.z = cvt_pk_bf16(v1[0], v1[1]); w.w = cvt_pk_bf16(v1[2], v1[3]);
                        if (prompt) *(v4u*)(rowp + bj * HALF) = w;
                        *(f32x4*)(op + bj * HALF) = v0; *(f32x4*)(op + bj * HALF + 4) = v1; } }
        }
    }
};
struct EpiX2 {
    static constexpr bool PERM = true;
    bf16_t* X2; float* ssq; float* part; const float* osq; unsigned* amax;
    __device__ __forceinline__ void midk(f32x4 (&acc)[2][2][4][2], const Unit& u, int wr, int wc, int fr, int fq) const {
        const int row0 = u.pm * BM + wr * 64 + fr;
#pragma unroll
        for (int ai = 0; ai < 2; ++ai)
#pragma unroll
            for (int m = 0; m < 4; ++m) { const int row = row0 + ai * HALF + m * 16;
                const float a = osq[2 * row], b = osq[2 * row + 1];
                const float ratio = rsqrtf(a * (1.f / WG) + EPS) / rsqrtf(b * (1.f / WG) + EPS);
#pragma unroll
                for (int bj = 0; bj < 2; ++bj)
#pragma unroll
                    for (int n = 0; n < 2; ++n) acc[ai][bj][m][n] = acc[ai][bj][m][n] * ratio; }
    }
    __device__ __forceinline__ void operator()(const f32x4 (&acc)[2][2][4][2], const Unit& u, int wr, int wc, int fr, int fq) const {
        const int row0 = u.pm * BM + wr * 64 + fr, col0 = u.pn * BM + wc * 32 + 8 * fq;
        if (u.ks >= 0) {
            float* pb = part + (size_t)u.ks * ((size_t)MS * DM);
#pragma unroll
            for (int ai = 0; ai < 2; ++ai)
#pragma unroll
                for (int m = 0; m < 4; ++m) { float* op = pb + (size_t)(row0 + ai * HALF + m * 16 - MP) * DM + col0;
#pragma unroll
                    for (int bj = 0; bj < 2; ++bj) { *(f32x4*)(op + bj * HALF) = acc[ai][bj][m][0]; *(f32x4*)(op + bj * HALF + 4) = acc[ai][bj][m][1]; } }
            return;
        }
#pragma unroll
        for (int ai = 0; ai < 2; ++ai)
#pragma unroll
            for (int m = 0; m < 4; ++m) { const int row = row0 + ai * HALF + m * 16;
                bf16_t* op = X2 + (size_t)row * DM + col0;
                f32x4 rv[2][2];
#pragma unroll
                for (int bj = 0; bj < 2; ++bj) { const v4u x = *(const v4u*)(op + bj * HALF);
                    rv[bj][0] = (f32x4){__uint_as_float(x.x << 16), __uint_as_float(x.x & 0xffff0000u), __uint_as_float(x.y << 16), __uint_as_float(x.y & 0xffff0000u)};
                    rv[bj][1] = (f32x4){__uint_as_float(x.z << 16), __uint_as_float(x.z & 0xffff0000u), __uint_as_float(x.w << 16), __uint_as_float(x.w & 0xffff0000u)}; }
                const float rs2 = rsqrtf(osq[2 * row + 1] * (1.f / WG) + EPS);
                float s = 0.f, mx = 0.f;
#pragma unroll
                for (int bj = 0; bj < 2; ++bj) { const f32x4 v0 = acc[ai][bj][m][0] * rs2 + rv[bj][0], v1 = acc[ai][bj][m][1] * rs2 + rv[bj][1];
                    s += (v0[0] * v0[0] + v0[1] * v0[1]) + (v0[2] * v0[2] + v0[3] * v0[3]) + (v1[0] * v1[0] + v1[1] * v1[1]) + (v1[2] * v1[2] + v1[3] * v1[3]);
                    mx = fmaxf(fmaxf(fmaxf(mx, fmaxf(fabsf(v0[0]), fabsf(v0[1]))), fmaxf(fabsf(v0[2]), fabsf(v0[3]))), fmaxf(fmaxf(fabsf(v1[0]), fabsf(v1[1])), fmaxf(fabsf(v1[2]), fabsf(v1[3]))));
                    v4u w; w.x = cvt_pk_bf16(v0[0], v0[1]); w.y = cvt_pk_bf16(v0[2], v0[3]); w.z = cvt_pk_bf16(v1[0], v1[1]); w.w = cvt_pk_bf16(v1[2], v1[3]);
                    *(v4u*)(op + bj * HALF) = w; }
                s += __shfl_xor(s, 16); s += __shfl_xor(s, 32); mx = fmaxf(mx, __shfl_xor(mx, 16)); mx = fmaxf(mx, __shfl_xor(mx, 32));
                if (fq == 0) { __hip_atomic_fetch_add(ssq + row, s, __ATOMIC_RELAXED, __HIP_MEMORY_SCOPE_AGENT);
                               __hip_atomic_fetch_max(amax + row, __float_as_uint(mx), __ATOMIC_RELAXED, __HIP_MEMORY_SCOPE_AGENT); } }
    }
};
struct EpiDown {
    static constexpr bool PERM = true;
    const bf16_t* X2; float* out; float* part;
    __device__ __forceinline__ void operator()(const f32x4 (&acc)[2][2][4][2], const Unit& u, int wr, int wc, int fr, int fq) const {
        const int row0 = u.pm * BM + wr * 64 + fr, col0 = u.pn * BM + wc * 32 + 8 * fq;
        if (u.ks >= 0) {
            float* pb = part + (size_t)u.ks * ((size_t)MS * DM);
#pragma unroll
            for (int ai = 0; ai < 2; ++ai)
#pragma unroll
                for (int m = 0; m < 4; ++m) { float* op = pb + (size_t)(row0 + ai * HALF + m * 16 - MP) * DM + col0;
#pragma unroll
                    for (int bj = 0; bj < 2; ++bj) { *(f32x4*)(op + bj * HALF) = acc[ai][bj][m][0]; *(f32x4*)(op + bj * HALF + 4) = acc[ai][bj][m][1]; } }
            return;
        }
#pragma unroll
        for (int ai = 0; ai < 2; ++ai)
#pragma unroll
            for (int m = 0; m < 4; ++m) { const size_t off = (size_t)(row0 + ai * HALF + m * 16) * DM + col0;
                v4u xv[2];
#pragma unroll
                for (int bj = 0; bj < 2; ++bj) xv[bj] = *(const v4u*)(X2 + off + bj * HALF);
#pragma unroll
                for (int bj = 0; bj < 2; ++bj) { const v4u x = xv[bj];
                    const f32x4 r0 = {__uint_as_float(x.x << 16), __uint_as_float(x.x & 0xffff0000u), __uint_as_float(x.y << 16), __uint_as_float(x.y & 0xffff0000u)};
                    const f32x4 r1 = {__uint_as_float(x.z << 16), __uint_as_float(x.z & 0xffff0000u), __uint_as_float(x.w << 16), __uint_as_float(x.w & 0xffff0000u)};
                    *(f32x4*)(out + off + bj * HALF) = acc[ai][bj][m][0] + r0; *(f32x4*)(out + off + bj * HALF + 4) = acc[ai][bj][m][1] + r1; } }
    }
};
struct FusedDownOrder {
    int c, nkt_full;
    __device__ __forceinline__ bool next(int i, Unit& u) const {
        if (i > 4) return false;
        const bool spl = (i == 4); const int x = c & 7, j = c >> 3, tile = c >> 3, ks = c & 7;
        u.pm = spl ? MP / BM + (tile >> 4) : 16 * i + 4 * (x >> 1) + (j >> 3); u.pn = spl ? (tile & 15) : 8 * (x & 1) + (j & 7);
        u.ks = spl ? ks : -1; u.kt0 = spl ? (ks < 3 ? 12 * ks : 36 + 10 * (ks - 3)) : 0; u.nkt = spl ? (ks < 3 ? 12 : 10) : nkt_full;
        return true;
    }
    __device__ __forceinline__ void a_ready(const Unit&) const {}
    __device__ __forceinline__ void done(const Unit&) const {}
};
struct EpiDownFused {
    static constexpr bool PERM = true;
    const bf16_t* X2; float* out; float* part; float* ssq3; unsigned* cnt; const float* gfin; const unsigned* amax2; const unsigned* cmaxd;
    __device__ __forceinline__ void operator()(const i32x4 (&acc)[2][2][4][2], const Unit& u, int wr, int wc, int fr, int fq) const {
        const int row0 = u.pm * BM + wr * 64 + fr, col0 = u.pn * BM + wc * 32 + 8 * fq;
#define ACCF(a) ((f32x4){(float)(a)[0], (float)(a)[1], (float)(a)[2], (float)(a)[3]})
#define LDSB(bj, n) ({ const v4u c_ = *(const v4u*)(cmaxd + col0 + (bj) * HALF + 4 * (n)); (f32x4){__uint_as_float(c_.x), __uint_as_float(c_.y), __uint_as_float(c_.z), __uint_as_float(c_.w)} * (1.f / 127.f); })
        if (u.ks >= 0) {
            float* pb = part + (size_t)u.ks * ((size_t)MS * DM);
            f32x4 sb[2][2];
#pragma unroll
            for (int bj = 0; bj < 2; ++bj)
#pragma unroll
                for (int n = 0; n < 2; ++n) sb[bj][n] = LDSB(bj, n);
#pragma unroll
            for (int ai = 0; ai < 2; ++ai)
#pragma unroll
                for (int m = 0; m < 4; ++m) { const int row = row0 + ai * HALF + m * 16; float* op = pb + (size_t)(row - MP) * DM + col0; const float sa = __uint_as_float(amax2[row]) * (1.f / (127.f * 32.f));
#pragma unroll
                    for (int bj = 0; bj < 2; ++bj) { *(f32x4*)(op + bj * HALF) = ACCF(acc[ai][bj][m][0]) * sa * sb[bj][0]; *(f32x4*)(op + bj * HALF + 4) = ACCF(acc[ai][bj][m][1]) * sa * sb[bj][1]; } }
            return;
        }
#define X2F(x, r0, r1) const f32x4 r0 = {__uint_as_float(x.x << 16), __uint_as_float(x.x & 0xffff0000u), __uint_as_float(x.y << 16), __uint_as_float(x.y & 0xffff0000u)}; \
                       const f32x4 r1 = {__uint_as_float(x.z << 16), __uint_as_float(x.z & 0xffff0000u), __uint_as_float(x.w << 16), __uint_as_float(x.w & 0xffff0000u)}
        { f32x4 sb[2][2];
#pragma unroll
          for (int bj = 0; bj < 2; ++bj)
#pragma unroll
              for (int n = 0; n < 2; ++n) sb[bj][n] = LDSB(bj, n);
#pragma unroll
          for (int ai = 0; ai < 2; ++ai)
#pragma unroll
            for (int m = 0; m < 4; ++m) { const int row = row0 + ai * HALF + m * 16; const size_t off = (size_t)row * DM + col0; float s = 0.f; const float sa = __uint_as_float(amax2[row]) * (1.f / (127.f * 32.f));
#pragma unroll
                for (int bj = 0; bj < 2; ++bj) { const v4u x = *(const v4u*)(X2 + off + bj * HALF); X2F(x, r0, r1);
                    const f32x4 v0 = ACCF(acc[ai][bj][m][0]) * sa * sb[bj][0] + r0, v1 = ACCF(acc[ai][bj][m][1]) * sa * sb[bj][1] + r1;
                    s += (v0[0] * v0[0] + v0[1] * v0[1]) + (v0[2] * v0[2] + v0[3] * v0[3]) + (v1[0] * v1[0] + v1[1] * v1[1]) + (v1[2] * v1[2] + v1[3] * v1[3]); }
                s += __shfl_xor(s, 16); s += __shfl_xor(s, 32);
                if (fq == 0) __hip_atomic_fetch_add(ssq3 + row, s, __ATOMIC_RELAXED, __HIP_MEMORY_SCOPE_AGENT);
                asm volatile("" ::: "memory"); } }
        asm volatile("s_waitcnt vmcnt(0)" ::: "memory");
        unsigned* cw = cnt + 64 * u.pm;
        if (fr == 0 && fq == 0) __hip_atomic_fetch_add(cw, 1u, __ATOMIC_RELAXED, __HIP_MEMORY_SCOPE_AGENT);
        { unsigned sp = 0;
          while ((unsigned)__builtin_amdgcn_readfirstlane(__hip_atomic_load(cw, __ATOMIC_RELAXED, __HIP_MEMORY_SCOPE_AGENT)) < 128u) { __builtin_amdgcn_s_sleep(2); if (++sp > (1u << 16)) break; } }
#pragma unroll
        for (int ai = 0; ai < 2; ++ai)
#pragma unroll
            for (int m = 0; m < 4; ++m) { const int row = row0 + ai * HALF + m * 16; const size_t off = (size_t)row * DM + col0; const float sa = __uint_as_float(amax2[row]) * (1.f / (127.f * 32.f));
                const float rstd = rsqrtf(__hip_atomic_load(ssq3 + row, __ATOMIC_RELAXED, __HIP_MEMORY_SCOPE_AGENT) * (1.f / DM) + EPS);
#pragma unroll
                for (int bj = 0; bj < 2; ++bj) { const v4u x = *(const v4u*)(X2 + off + bj * HALF); X2F(x, r0, r1);
                    i32x4 a0 = acc[ai][bj][m][0], a1 = acc[ai][bj][m][1]; asm volatile("" : "+v"(a0), "+v"(a1));
                    const f32x4 g0 = *(const f32x4*)(gfin + col0 + bj * HALF), g1 = *(const f32x4*)(gfin + col0 + bj * HALF + 4), b0 = LDSB(bj, 0), b1 = LDSB(bj, 1);
                    *(f32x4*)(out + off + bj * HALF) = (ACCF(a0) * sa * b0 + r0) * rstd * g0; *(f32x4*)(out + off + bj * HALF + 4) = (ACCF(a1) * sa * b1 + r1) * rstd * g1; }
                asm volatile("" ::: "memory"); }
#undef X2F
#undef LDSB
#undef ACCF
    }
};
struct EpiGluQ {
    static constexpr bool PERM = true;
    bf16_t* ACT; const float* ssq; const unsigned* amax; const unsigned* cmax;
    __device__ __forceinline__ void operator()(const i32x4 (&acc)[2][2][4][2], const Unit& u, int wr, int wc, int fr, int fq) const {
        const int row0 = u.pm * BM + wr * 64 + fr, col0 = u.pn * HALF + wc * 32 + 8 * fq;
        float sg[8], su[8];
#pragma unroll
        for (int j = 0; j < 8; ++j) { sg[j] = __uint_as_float(cmax[col0 + j]) * (1.f / 127.f); su[j] = __uint_as_float(cmax[DFF + col0 + j]) * (1.f / 127.f); }
#pragma unroll
        for (int ai = 0; ai < 2; ++ai)
#pragma unroll
            for (int m = 0; m < 4; ++m) { const int row = row0 + ai * HALF + m * 16; bf16_t* rowp = ACT + (size_t)row * DFF + col0; float r[8];
                const float sa = __uint_as_float(amax[row]) * (1.f / 127.f) * rsqrtf(ssq[row] * (1.f / DM) + EPS);
#pragma unroll
                for (int n = 0; n < 2; ++n)
#pragma unroll
                    for (int j = 0; j < 4; ++j) { const float g = (float)acc[ai][0][m][n][j] * (sa * sg[n * 4 + j]), up = (float)acc[ai][1][m][n][j] * (sa * su[n * 4 + j]);
                        r[n * 4 + j] = g * __builtin_amdgcn_rcpf(1.0f + __builtin_amdgcn_exp2f(-g * LOG2E)) * up; }
                v4u w; w.x = cvt_pk_bf16(r[0], r[1]); w.y = cvt_pk_bf16(r[2], r[3]); w.z = cvt_pk_bf16(r[4], r[5]); w.w = cvt_pk_bf16(r[6], r[7]);
                *(v4u*)rowp = w; }
    }
};
}


struct BgJob {
    const float *w_out, *w_gate, *w_up, *w_down, *g_ffn, *g_of, *g_os; bf16 *Wout_t, *Wgu_t, *Wdn_t; const unsigned* cmax; const unsigned* cmaxd; LAS unsigned char* scr;
    int next, have, stride, end;
};
constexpr int BG_I_OUT = (DM / 64) * (DM / 32), BG_I_G = (DM / 64) * (DFF / 32), BG_I_D = (DFF / 64) * (DM / 32), BG_N = BG_I_OUT + 2 * BG_I_G + BG_I_D;
#define BG_DECODE(it_, W_, ldw_, K_, k0_, n0_, WT_, dr_, ksc_, cm_) do { int r_ = (it_); ksc_ = nullptr; cm_ = nullptr; \
        if (r_ < BG_I_OUT) { const int kb = r_ / 128, nb = r_ % 128; W_ = B.w_out; ldw_ = DM; K_ = DM; WT_ = B.Wout_t; k0_ = 64 * kb; n0_ = 32 * nb; dr_ = 32 * nb; ksc_ = k0_ < WG ? B.g_of : B.g_os - WG; } \
        else if ((r_ -= BG_I_OUT) < BG_I_G) { const int kb = r_ / 344, nb = r_ % 344; W_ = B.w_gate; ldw_ = DFF; K_ = DM; WT_ = B.Wgu_t; ksc_ = B.g_ffn; k0_ = 64 * kb; n0_ = 32 * nb; dr_ = (n0_ >> 7) * 256 + (n0_ & 127); cm_ = B.cmax + n0_; } \
        else if ((r_ -= BG_I_G) < BG_I_G) { const int kb = r_ / 344, nb = r_ % 344; W_ = B.w_up; ldw_ = DFF; K_ = DM; WT_ = B.Wgu_t; ksc_ = B.g_ffn; k0_ = 64 * kb; n0_ = 32 * nb; dr_ = (n0_ >> 7) * 256 + 128 + (n0_ & 127); cm_ = B.cmax + DFF + n0_; } \
        else { r_ -= BG_I_G; const int kb = r_ / 128, nb = r_ % 128; W_ = B.w_down; ldw_ = DM; K_ = DFF; WT_ = B.Wdn_t; k0_ = 64 * kb; n0_ = 32 * nb; dr_ = 32 * nb; cm_ = B.cmaxd + n0_; } } while (0)
__device__ __forceinline__ void bg_step(BgJob& B, int lane) {
    const float* W; const float* ksc; const unsigned* cm; bf16* WT; int ldw, K, k0, n0, dr;
    if (B.have >= 0) {
        BG_DECODE(B.have, W, ldw, K, k0, n0, WT, dr, ksc, cm);
        const int c8 = lane & 7, nsub = lane >> 3; LAS const float* s = (LAS const float*)B.scr + (8 * c8) * 32;
        f32x4 s0 = {1.f, 1.f, 1.f, 1.f}, s1 = s0;
        if (ksc) { s0 = *(const f32x4*)(ksc + k0 + 8 * c8); s1 = *(const f32x4*)(ksc + k0 + 8 * c8 + 4); }
        if (cm) {
#pragma unroll
            for (int jn = 0; jn < 4; ++jn) { const int n = nsub + 8 * jn, o = (((n >> 2) ^ c8) << 2) + (n & 3);
                const float cmv = __uint_as_float(cm[n]), qs = cmv > 0.f ? 127.f / cmv : 0.f; int q[8];
                float v[8] = {s[o] * s0.x, s[o + 32] * s0.y, s[o + 64] * s0.z, s[o + 96] * s0.w, s[o + 128] * s1.x, s[o + 160] * s1.y, s[o + 192] * s1.z, s[o + 224] * s1.w};
                if (K == DFF) {
#define HB(a, b) { const float t_ = a; a = t_ + b; b = t_ - b; }
                    HB(v[0], v[1]) HB(v[2], v[3]) HB(v[4], v[5]) HB(v[6], v[7]) HB(v[0], v[2]) HB(v[1], v[3]) HB(v[4], v[6]) HB(v[5], v[7]) HB(v[0], v[4]) HB(v[1], v[5]) HB(v[2], v[6]) HB(v[3], v[7])
#undef HB
#pragma unroll
                    for (int i = 0; i < 8; ++i) { const float p = __shfl_xor(v[i], 1); v[i] = (c8 & 1) ? p - v[i] : v[i] + p; }
#pragma unroll
                    for (int i = 0; i < 8; ++i) { const float p = __shfl_xor(v[i], 2); v[i] = (c8 & 2) ? p - v[i] : v[i] + p; }
                }
#pragma unroll
                for (int i = 0; i < 8; ++i) q[i] = (int)__builtin_rintf(fminf(fmaxf(v[i] * qs, -127.f), 127.f)) & 0xff;
                v2u w; w.x = (unsigned)q[0] | ((unsigned)q[1] << 8) | ((unsigned)q[2] << 16) | ((unsigned)q[3] << 24); w.y = (unsigned)q[4] | ((unsigned)q[5] << 8) | ((unsigned)q[6] << 16) | ((unsigned)q[7] << 24);
                *(GAS v2u*)((unsigned char*)WT + (size_t)(dr + n) * K + k0 + 8 * c8) = w; }
        } else {
#pragma unroll
        for (int jn = 0; jn < 4; ++jn) { const int n = nsub + 8 * jn, o = (((n >> 2) ^ c8) << 2) + (n & 3);
            v4u w; w.x = cvt_pk_bf16(s[o] * s0.x, s[o + 32] * s0.y); w.y = cvt_pk_bf16(s[o + 64] * s0.z, s[o + 96] * s0.w);
            w.z = cvt_pk_bf16(s[o + 128] * s1.x, s[o + 160] * s1.y); w.w = cvt_pk_bf16(s[o + 192] * s1.z, s[o + 224] * s1.w);
            *(GAS v4u*)(WT + (size_t)(dr + n) * K + k0 + 8 * c8) = w; }
        }
        LDS_WAIT(); asm volatile("" ::: "memory");
        B.have = -1;
    }
    if (B.next < B.end) {
        BG_DECODE(B.next, W, ldw, K, k0, n0, WT, dr, ksc, cm);
        const float* p = W + (size_t)(k0 + (lane >> 3)) * ldw + n0;
#pragma unroll
        for (int j = 0; j < 8; ++j) __builtin_amdgcn_global_load_lds((const unsigned*)(p + (size_t)(8 * j) * ldw + 4 * ((lane & 7) ^ j)), (LAS unsigned*)(B.scr + j * 1024), 16, 0, 0);
        B.have = B.next; B.next += B.stride;
    }
}
#undef BG_DECODE

namespace att {
constexpr int SHM_V = 16384, SHM_K = 16384;
constexpr int OFF_V = 0, OFF_K = 2 * SHM_V, OFF_WS = 4 * 16384, OFF_U = OFF_WS + NWAVES * 256, OFF_SCAN = OFF_U + (2048 + 64) * 4, OFF_FLAG = OFF_SCAN + 64, ATT_LDS = OFF_FLAG + 64;
static_assert(ATT_LDS <= BG_OFF, "attention LDS");
#define KSWZ(row, colB) ((row) * 256 + ((colB) ^ (((row) & 7) << 4)))
#define SBAR() __builtin_amdgcn_sched_barrier(0)
__device__ __forceinline__ int slot32(int k) { return (k & 3) | (((k >> 2) & 3) << 3) | (((k >> 4) & 1) << 2); }
__device__ __forceinline__ int v_st(int k, int c) { const int kk = (k & ~0xC) | ((k & 4) << 1) | ((k & 8) >> 1); return ((kk >> 3) * 4 + (c >> 5)) * 512 + ((kk & 7) * 32 + (c & 31)) * 2; }
__device__ __forceinline__ int v_rd_base(int lane) { return ((lane & 3) << 3) | (((lane >> 2) & 3) << 6) | (((lane >> 4) & 1) << 5) | (((lane >> 5) & 1) << 8); }
constexpr int v_rd_off(int d0, int ks, int half) { return d0 * 512 + ks * 4096 + half * 2048; }
__device__ __forceinline__ int crow(int r, int hi) { return (r & 3) + 8 * (r >> 2) + 4 * hi; }
__device__ __forceinline__ float partner(float x, int hi) { auto rr = __builtin_amdgcn_permlane32_swap(__float_as_uint(x), __float_as_uint(x), false, false); return __uint_as_float(hi ? rr[0] : rr[1]); }

template <int PF = 4>
__device__ __forceinline__ void qkt(f32x16& p0, f32x16& p1, LAS const unsigned char* Kt, int r32, int hi, const bf16x8* qr) {
    LAS const unsigned char* kb[4];
#pragma unroll
    for (int dd = 0; dd < 4; ++dd) kb[dd] = Kt + KSWZ(r32, (dd * 16 + hi * 8) * 2);
    bf16x8 f0[PF], f1[PF];
#pragma unroll
    for (int d0 = 0; d0 < PF; ++d0) { LAS const unsigned char* a = kb[d0 & 3] + (d0 >> 2) * 128; f0[d0] = *(LAS const bf16x8*)a; f1[d0] = *(LAS const bf16x8*)(a + 32 * 256); }
    SBAR();
#pragma unroll
    for (int d0 = 0; d0 < 8; ++d0) {
        p0 = __builtin_amdgcn_mfma_f32_32x32x16_bf16(f0[d0 % PF], qr[d0], p0, 0, 0, 0);
        p1 = __builtin_amdgcn_mfma_f32_32x32x16_bf16(f1[d0 % PF], qr[d0], p1, 0, 0, 0);
        if (d0 + PF < 8) { LAS const unsigned char* a = kb[(d0 + PF) & 3] + ((d0 + PF) >> 2) * 128; f0[d0 % PF] = *(LAS const bf16x8*)a; f1[d0 % PF] = *(LAS const bf16x8*)(a + 32 * 256); }
        SBAR(); }
}
__device__ __forceinline__ void pv_tile(f32x16* o, int vb0, bf16x8 pa0, bf16x8 pa1, bf16x8 pa2, bf16x8 pa3) {
#define TRRD(dst, off) asm volatile("ds_read_b64_tr_b16 %0, %1 offset:%2" : "=&v"(dst) : "v"(vb0), "i"(off) : "memory")
#define PV_D0(d0) do { s16x4 l0, l1, l2, l3, h0, h1, h2, h3; constexpr int b_ = v_rd_off(d0, 0, 0); \
        TRRD(l0, b_); TRRD(h0, b_ + 2048); TRRD(l1, b_ + 4096); TRRD(h1, b_ + 6144); TRRD(l2, b_ + 8192); TRRD(h2, b_ + 10240); TRRD(l3, b_ + 12288); TRRD(h3, b_ + 14336); \
        asm volatile("s_waitcnt lgkmcnt(0)" ::: "memory"); SBAR(); \
        o[d0] = __builtin_amdgcn_mfma_f32_32x32x16_bf16(pa0, (bf16x8){l0[0], l0[1], l0[2], l0[3], h0[0], h0[1], h0[2], h0[3]}, o[d0], 0, 0, 0); \
        o[d0] = __builtin_amdgcn_mfma_f32_32x32x16_bf16(pa1, (bf16x8){l1[0], l1[1], l1[2], l1[3], h1[0], h1[1], h1[2], h1[3]}, o[d0], 0, 0, 0); \
        o[d0] = __builtin_amdgcn_mfma_f32_32x32x16_bf16(pa2, (bf16x8){l2[0], l2[1], l2[2], l2[3], h2[0], h2[1], h2[2], h2[3]}, o[d0], 0, 0, 0); \
        o[d0] = __builtin_amdgcn_mfma_f32_32x32x16_bf16(pa3, (bf16x8){l3[0], l3[1], l3[2], l3[3], h3[0], h3[1], h3[2], h3[3]}, o[d0], 0, 0, 0); } while (0)
    PV_D0(0); PV_D0(1); PV_D0(2); PV_D0(3);
#undef PV_D0
#undef TRRD
}
#define PK4(P, B_, OUT) do { unsigned a0 = cvt_pk_bf16(P[B_+0], P[B_+1]), a1 = cvt_pk_bf16(P[B_+2], P[B_+3]); \
        unsigned b0 = cvt_pk_bf16(P[B_+4], P[B_+5]), b1 = cvt_pk_bf16(P[B_+6], P[B_+7]); \
        auto r0 = __builtin_amdgcn_permlane32_swap(a0, b0, false, false); auto r1 = __builtin_amdgcn_permlane32_swap(a1, b1, false, false); \
        v4u w = {r0[0], r1[0], r0[1], r1[1]}; OUT = __builtin_bit_cast(bf16x8, w); } while (0)

template <class F> __device__ __forceinline__ void scan_u(LAS float* U, LAS float* scan, int n, F lf) {
    const int tid = threadIdx.x, lane = tid & 63, wid = tid >> 6, t0 = 4 * tid;
    float v0 = t0 < n ? lf(t0) : 0.f, v1 = t0 + 1 < n ? lf(t0 + 1) : 0.f, v2 = t0 + 2 < n ? lf(t0 + 2) : 0.f, v3 = t0 + 3 < n ? lf(t0 + 3) : 0.f;
    v1 += v0; v2 += v1; v3 += v2;
    float x = v3;
#pragma unroll
    for (int o = 1; o < 64; o <<= 1) { const float y = __shfl_up(x, o); if (lane >= o) x += y; }
    if (lane == 63) scan[wid] = x;
    __syncthreads();
    float pre = x - v3;
    for (int w = 0; w < wid; ++w) pre += scan[w];
    f32x4 r = {-(v0 + pre) * LOG2E, -(v1 + pre) * LOG2E, -(v2 + pre) * LOG2E, -(v3 + pre) * LOG2E};
    *(LAS f32x4*)(U + t0) = r;
    __syncthreads();
}

__device__ __forceinline__ int islot(int rho) { return (rho & 0x23) | (((rho >> 3) & 3) << 2) | (((rho >> 2) & 1) << 4); }
template <int MODE, bool SAMPLE>
__device__ __forceinline__ void attn_unit(LAS unsigned char* lds, const bf16* Q, const bf16* K, const bf16* V, bf16* O, int P0, const float* Kc, const float* Vc, const float* Kn, const float* Vn, BgJob& B, float* osq) {
    int tid_ = threadIdx.x; asm volatile("" : "+v"(tid_));
    const int tid = tid_, wid = __builtin_amdgcn_readfirstlane(tid >> 6), lane = tid & 63, r32 = lane & 31, hi = lane >> 5;
    constexpr int nact = SAMPLE ? 1 : NWAVES, Tk = SAMPLE ? TKS : SEQ;
    const bool active = wid < nact;
    const int NT = (P0 + 32 * nact + 63) >> 6;
    LAS unsigned char* V_lds = lds + OFF_V; LAS unsigned char* K_lds = lds + OFF_K;
    LAS float* wsf = (LAS float*)(lds + OFF_WS) + wid * 64; LAS float* li_l = wsf; LAS float* al_l = wsf + 32;
    LAS const float* U = (LAS const float*)(lds + OFF_U);
    LAS unsigned* flg = (LAS unsigned*)(lds + OFF_FLAG);
    int kkey[2], kcol[2], vkey[2], vcol[2];
#pragma unroll
    for (int i = 0; i < 2; ++i) {
        const int q = wid * 2 + i;
        { const int rho = q * 4 + (lane >> 4), cpos = lane & 15; kkey[i] = islot(rho); kcol[i] = (cpos ^ (rho & 7)) * 8; }
        { const int sub = q * 2 + (lane >> 5), kk = (sub >> 2) * 8 + ((lane & 31) >> 2), ks = (kk & ~0xC) | ((kk & 4) << 1) | ((kk & 8) >> 1); vkey[i] = islot(ks); vcol[i] = (sub & 3) * 32 + (lane & 3) * 8; }
    }
    if (MODE == 1 && lane == 0) { flg[wid] = active ? 0u : 1u; flg[8 + wid] = active ? 0u : 1u; }
#define TILE_OF(t) (NT - 1 - (t))
#define STAGE_DMA(j, bf) do { _Pragma("unroll") for (int _i = 0; _i < 2; ++_i) { \
        int kk_ = (j) * 64 + kkey[_i]; kk_ = kk_ < Tk ? kk_ : Tk - 1; int vk_ = (j) * 64 + vkey[_i]; vk_ = vk_ < Tk ? vk_ : Tk - 1; \
        __builtin_amdgcn_global_load_lds((const unsigned*)(K + (size_t)kk_ * WG + kcol[_i]), (LAS unsigned*)(K_lds + (bf) * SHM_K + (wid * 2 + _i) * 1024), 16, 0, 0); \
        __builtin_amdgcn_global_load_lds((const unsigned*)(V + (size_t)vk_ * WG + vcol[_i]), (LAS unsigned*)(V_lds + (bf) * SHM_V + (wid * 2 + _i) * 1024), 16, 0, 0); } } while (0)
#define STAGE_F32(j, bf) do { const int lt_ = tid - 64; f32x4 fa_[5], fb_[5]; int dst_[5]; \
        _Pragma("unroll") for (int jj_ = 0; jj_ < 5; ++jj_) { const int i_ = lt_ + 448 * jj_; int key_, col_; const bool isv_ = i_ >= 1024; \
            if (!isv_) { const int rho = i_ >> 4, cpos = i_ & 15; key_ = islot(rho); col_ = (cpos ^ (rho & 7)) * 8; dst_[jj_] = OFF_K + (bf) * SHM_K + i_ * 16; } \
            else { const int iv = i_ - 1024, sub = iv >> 5, kk = (sub >> 2) * 8 + ((iv & 31) >> 2), ks = (kk & ~0xC) | ((kk & 4) << 1) | ((kk & 8) >> 1); key_ = islot(ks); col_ = (sub & 3) * 32 + (iv & 3) * 8; dst_[jj_] = OFF_V + (bf) * SHM_V + iv * 16; } \
            int ka_ = (j) * 64 + key_; ka_ = ka_ < Tk ? ka_ : Tk - 1; \
            const float* src_ = (ka_ < PAST ? (isv_ ? Vc : Kc) + (size_t)ka_ * WG : (isv_ ? Vn : Kn) + (size_t)(ka_ - PAST) * WG) + col_; \
            if (i_ < 2048) { fa_[jj_] = *(const f32x4*)src_; fb_[jj_] = *(const f32x4*)(src_ + 4); } } \
        _Pragma("unroll") for (int jj_ = 0; jj_ < 5; ++jj_) { const int i_ = lt_ + 448 * jj_; \
            if (i_ < 2048) { v4u w_; w_.x = cvt_pk_bf16(fa_[jj_].x, fa_[jj_].y); w_.y = cvt_pk_bf16(fa_[jj_].z, fa_[jj_].w); w_.z = cvt_pk_bf16(fb_[jj_].x, fb_[jj_].y); w_.w = cvt_pk_bf16(fb_[jj_].z, fb_[jj_].w); \
                *(LAS v4u*)(lds + dst_[jj_]) = w_; } } } while (0)
    if (SAMPLE && wid >= 1) {
        STAGE_F32(TILE_OF(0), 0); LDS_WAIT();
        __syncthreads();
        for (int t = 0; t < NT; ++t) {
            if (t + 1 < NT) STAGE_F32(TILE_OF(t + 1), (t + 1) & 1);
            LDS_WAIT();
            __syncthreads();
            if (MODE == 1) { const v4u fa = *(LAS const v4u*)(flg + (t & 1) * 8), fb = *(LAS const v4u*)(flg + (t & 1) * 8 + 4);
                if ((fa.x & fa.y & fa.z & fa.w & fb.x & fb.y & fb.z & fb.w) != 0u) break; }
        }
        __syncthreads();
        return;
    }
    const int vb0 = (int)(size_t)V_lds + v_rd_base(lane);
    const int qlo = P0 + wid * 32, tq = qlo + r32;
    bf16x8 qr[8];
#pragma unroll
    for (int d0 = 0; d0 < 8; ++d0) qr[d0] = *(const bf16x8*)(Q + (size_t)(wid * 32 + r32) * DM + d0 * 16 + hi * 8);
    if (!SAMPLE) { STAGE_DMA(TILE_OF(0), 0); VM_WAIT(); }
    __syncthreads();
    float m_reg = -1e30f, l_reg = 0.f, carry = 1.f;
    f32x16 o[4] = {};
    for (int t = 0; t < NT; ++t) {
        const int j = TILE_OF(t), kb = j * 64, bufo = (t & 1) * SHM_K;
        if (!SAMPLE && t + 1 < NT) STAGE_DMA(TILE_OF(t + 1), (t + 1) & 1);
        if (!SAMPLE) bg_step(B, lane);
        if (kb <= qlo + 31) {
            f32x16 p0, p1;
            if (MODE == 0) {
                LAS const f32x4* up0 = (LAS const f32x4*)(U + kb + 16 * hi); LAS const f32x4* up1 = (LAS const f32x4*)(U + kb + 32 + 16 * hi);
#pragma unroll
                for (int g = 0; g < 4; ++g) { const f32x4 a = up0[g], b = up1[g];
#pragma unroll
                    for (int jj = 0; jj < 4; ++jj) { p0[4 * g + jj] = a[jj]; p1[4 * g + jj] = b[jj]; } }
            } else { p0 = f32x16{}; p1 = f32x16{}; }
            qkt(p0, p1, K_lds + bufo, r32, hi, qr);
            bf16x8 pa0, pa1, pa2, pa3;
            const int dq = tq - kb - 16 * hi;
            const bool need_mask = kb + 63 >= qlo;
            if (MODE == 0) {
                if (need_mask) { const float NEG = -__builtin_inff();
#pragma unroll
                    for (int r = 0; r < 16; ++r) { if (r > dq) p0[r] = NEG; if (r + 32 > dq) p1[r] = NEG; } }
                float pmax = p0[0];
#pragma unroll
                for (int r = 1; r < 16; ++r) pmax = fmaxf(pmax, p0[r]);
#pragma unroll
                for (int r = 0; r < 16; ++r) pmax = fmaxf(pmax, p1[r]);
                pmax = fmaxf(pmax, partner(pmax, hi));
                const float mn = fmaxf(m_reg, pmax);
                const bool grew = __any(mn > m_reg);
                float ps = 0.f;
#pragma unroll
                for (int r = 0; r < 16; ++r) { p0[r] = __builtin_amdgcn_exp2f(p0[r] - mn); p1[r] = __builtin_amdgcn_exp2f(p1[r] - mn); ps += p0[r] + p1[r]; }
                ps += partner(ps, hi);
                if (grew) {
                    const float alpha = __builtin_amdgcn_exp2f(m_reg - mn);
                    l_reg = l_reg * alpha + ps;
                    if (hi == 0) al_l[r32] = alpha;
                    LDS_WAIT();
#pragma unroll
                    for (int g = 0; g < 4; ++g) { const f32x4 a = *(LAS const f32x4*)(al_l + 8 * g + 4 * hi);
#pragma unroll
                        for (int jj = 0; jj < 4; ++jj)
#pragma unroll
                            for (int d_ = 0; d_ < 4; ++d_) o[d_][4 * g + jj] *= a[jj]; }
                } else l_reg += ps;
                m_reg = mn;
            } else {
                f32x16 w1;
#pragma unroll
                for (int r = 0; r < 16; ++r) { p1[r] = __builtin_amdgcn_exp2f(fminf(p1[r], 80.f)); w1[r] = __builtin_amdgcn_rcpf(1.0f + p1[r]); }
                if (need_mask) {
#pragma unroll
                    for (int r = 0; r < 16; ++r) if (r + 32 >= dq) { p1[r] = 0.f; w1[r] = 1.f; } }
#pragma unroll
                for (int r = 14; r >= 0; --r) w1[r] *= w1[r + 1];
                const float T1 = w1[0], oT1 = partner(T1, hi);
                const float f1 = hi ? carry : carry * oT1;
#pragma unroll
                for (int r = 0; r < 16; ++r) p1[r] = p1[r] * (w1[r] * f1);
                f32x16 w0;
#pragma unroll
                for (int r = 0; r < 16; ++r) { p0[r] = __builtin_amdgcn_exp2f(fminf(p0[r], 80.f)); w0[r] = __builtin_amdgcn_rcpf(1.0f + p0[r]); }
                if (need_mask) {
#pragma unroll
                    for (int r = 0; r < 16; ++r) if (r >= dq) { p0[r] = 0.f; w0[r] = 1.f; } }
#pragma unroll
                for (int r = 14; r >= 0; --r) w0[r] *= w0[r + 1];
                const float T0 = w0[0], oT0 = partner(T0, hi);
                const float f0 = (carry * (T1 * oT1)) * (hi ? 1.f : oT0);
#pragma unroll
                for (int r = 0; r < 16; ++r) p0[r] = p0[r] * (w0[r] * f0);
                carry = carry * ((T0 * oT0) * (T1 * oT1));
            }
            PK4(p0, 0, pa0); PK4(p0, 8, pa1); PK4(p1, 0, pa2); PK4(p1, 8, pa3);
            pv_tile(o, vb0 + bufo, pa0, pa1, pa2, pa3);
        }
        if (MODE == 1) { const bool dead = __all(carry == 0.f) != 0; if (lane == 0) flg[(t & 1) * 8 + wid] = dead ? 1u : 0u; }
        if (!SAMPLE) VM_WAIT();
        LDS_WAIT();
        __syncthreads();
        if (MODE == 1) {
            const v4u fa = *(LAS const v4u*)(flg + (t & 1) * 8), fb = *(LAS const v4u*)(flg + (t & 1) * 8 + 4);
            if ((fa.x & fa.y & fa.z & fa.w & fb.x & fb.y & fb.z & fb.w) != 0u) break;
        }
    }
    {
        if (MODE == 0) {
            if (hi == 0) li_l[r32] = 1.0f / l_reg;
            LDS_WAIT();
#pragma unroll
            for (int g = 0; g < 4; ++g) { const f32x4 a = *(LAS const f32x4*)(li_l + 8 * g + 4 * hi);
#pragma unroll
                for (int jj = 0; jj < 4; ++jj)
#pragma unroll
                    for (int d_ = 0; d_ < 4; ++d_) o[d_][4 * g + jj] *= a[jj]; }
        }
#pragma unroll
        for (int r = 0; r < 16; ++r) { float s = (o[0][r] * o[0][r] + o[1][r] * o[1][r]) + (o[2][r] * o[2][r] + o[3][r] * o[3][r]);
            s += __shfl_xor(s, 1); s += __shfl_xor(s, 2); s += __shfl_xor(s, 4); s += __shfl_xor(s, 8); s += __shfl_xor(s, 16);
            if (r32 == 0) __hip_atomic_fetch_add(osq + 2 * (wid * 32 + crow(r, hi)), s, __ATOMIC_RELAXED, __HIP_MEMORY_SCOPE_AGENT); }
        bf16* Ow = O + (size_t)(wid * 32) * DM;
#pragma unroll
        for (int r = 0; r < 16; ++r) { const int orow = crow(r, hi);
#pragma unroll
            for (int d0 = 0; d0 < 4; ++d0) { const float v = o[d0][r]; const float vn = __shfl_xor(v, 1);
                if ((r32 & 1) == 0) *(unsigned*)(Ow + (size_t)orow * DM + d0 * 32 + r32) = cvt_pk_bf16(v, vn); } }
    }
    __syncthreads();
#undef TILE_OF
#undef STAGE_DMA
#undef STAGE_F32
}
#undef PK4
}

#define XB_TMO      128
#define XB_XCNT(j)  (256  + 64 * (j))
#define XB_XSUB(j)  (1280 + 64 * (j))
#define XB_XGEN(j)  (2304 + 64 * (j))
#define XB_TOP      3328
#define XB_TOPGEN   3392
#define XCD_BAR_WORDS 3456
#define XB_SPIN_CAP (1u << 18)
__device__ __forceinline__ unsigned xb_ld(unsigned* p)              { return __hip_atomic_load(p, __ATOMIC_RELAXED, __HIP_MEMORY_SCOPE_AGENT); }
__device__ __forceinline__ unsigned xb_add(unsigned* p, unsigned v) { return __hip_atomic_fetch_add(p, v, __ATOMIC_RELAXED, __HIP_MEMORY_SCOPE_AGENT); }
__device__ __forceinline__ unsigned xb_xcc_id() { return (unsigned)__builtin_amdgcn_s_getreg((3 << 11) | 20) & 0xFu; }
#define XB_SPIN(cond, bar) do { unsigned _sp = 0; while (cond) { __builtin_amdgcn_s_sleep(1); \
    if ((++_sp & 255u) == 0u) { if (xb_ld(&(bar)[XB_TMO])) break; if (_sp > XB_SPIN_CAP) { atomicAdd(&(bar)[XB_TMO], 1u); break; } } } } while (0)
struct XcdBarrier { unsigned* bar; unsigned x; volatile LAS unsigned* st; };
__device__ __forceinline__ XcdBarrier xcd_barrier_post(unsigned* bar, volatile LAS unsigned* st) {
    XcdBarrier b; b.bar = bar; b.x = xb_xcc_id(); b.st = st;
    if (threadIdx.x == 0) (void)xb_add(&bar[XB_XCNT(b.x)], 1u);
    return b;
}
__device__ __forceinline__ void xcd_barrier_complete(unsigned* bar, unsigned x, unsigned& nloc, unsigned& nx) {
    const unsigned G = gridDim.x * gridDim.y * gridDim.z;
    unsigned sum, cnt, mine, sp = 0u;
    for (;;) {
        sum = 0u; cnt = 0u; mine = 0u;
#pragma unroll
        for (unsigned j = 0; j < 16; ++j) { const unsigned c = xb_ld(&bar[XB_XCNT(j)]); sum += c; cnt += (c > 0u) ? 1u : 0u; mine = (j == x) ? c : mine; }
        if (sum == G) break;
        __builtin_amdgcn_s_sleep(1);
        if ((++sp & 255u) == 0u) { if (xb_ld(&bar[XB_TMO])) break; if (sp > XB_SPIN_CAP) { atomicAdd(&bar[XB_TMO], 1u); break; } }
    }
    nloc = mine > 0u ? mine : 1u; nx = cnt > 0u ? cnt : 1u;
}
__device__ __forceinline__ void xcd_barrier(const XcdBarrier& b) {
    asm volatile("s_waitcnt vmcnt(0)" ::: "memory");
    __syncthreads();
    if (threadIdx.x == 0) {
        unsigned* bar = b.bar;
        __builtin_amdgcn_s_waitcnt(0);
        unsigned nloc = b.st[0], nx = b.st[1];
        if (nloc == 0u) { xcd_barrier_complete(bar, b.x, nloc, nx); b.st[0] = nloc; b.st[1] = nx; }
        const unsigned old = xb_add(&bar[XB_XSUB(b.x)], 1u);
        const unsigned gen = old / nloc;
        if (old + 1u == (gen + 1u) * nloc) {
            __builtin_amdgcn_fence(__ATOMIC_RELEASE, "agent");
            asm volatile("s_waitcnt vmcnt(0)" ::: "memory");
            const unsigned og = xb_add(&bar[XB_TOP], 1u);
            const unsigned tg = og / nx;
            if (og + 1u == (tg + 1u) * nx) xb_add(&bar[XB_TOPGEN], 1u);
            else XB_SPIN(xb_ld(&bar[XB_TOPGEN]) == tg, bar);
            __builtin_amdgcn_fence(__ATOMIC_ACQUIRE, "agent");
            xb_add(&bar[XB_XGEN(b.x)], 1u);
            asm volatile("s_waitcnt vmcnt(0)" ::: "memory");
        } else {
            XB_SPIN(xb_ld(&bar[XB_XGEN(b.x)]) == gen, bar);
            __builtin_amdgcn_fence(__ATOMIC_ACQUIRE, "agent");
            asm volatile("s_waitcnt vmcnt(0)" ::: "memory");
        }
    }
    __syncthreads();
}

struct Args { const float* in[18]; float* out; unsigned char* ws; int ph_lo, ph_hi; };

__device__ __forceinline__ float wave_sum(float v) {
#pragma unroll
    for (int o = 1; o < 64; o <<= 1) v += __shfl_xor(v, o);
    return v;
}
__device__ __forceinline__ void tr_load(f32x4 (&r)[8], const float* W, int ldw, int k0, int n0, int lane) {
    const float* p = W + (size_t)(k0 + (lane >> 3)) * ldw + n0 + 4 * (lane & 7);
#pragma unroll
    for (int j = 0; j < 8; ++j) r[j] = *(const f32x4*)(p + (size_t)(8 * j) * ldw);
}
__device__ __forceinline__ void tr_proc(const f32x4 (&r)[8], const float* ksc, int K, int k0, int ncols, bf16* WT, int drow0, LAS float* scr, int lane) {
    const int c = 4 * (lane & 7);
#pragma unroll
    for (int j = 0; j < 8; ++j) { const int kk = 8 * j + (lane >> 3); const float sc = ksc ? ksc[k0 + kk] : 1.f; LAS float* d = scr + kk * 33 + c;
        d[0] = r[j].x * sc; d[1] = r[j].y * sc; d[2] = r[j].z * sc; d[3] = r[j].w * sc; }
    LDS_WAIT(); asm volatile("" ::: "memory");
    const int c8 = lane & 7;
#pragma unroll
    for (int j = 0; j < 4; ++j) { const int n = (lane >> 3) + 8 * j; const LAS float* s = scr + (8 * c8) * 33 + n;
        v4u o; o.x = cvt_pk_bf16(s[0 * 33], s[1 * 33]); o.y = cvt_pk_bf16(s[2 * 33], s[3 * 33]); o.z = cvt_pk_bf16(s[4 * 33], s[5 * 33]); o.w = cvt_pk_bf16(s[6 * 33], s[7 * 33]);
        if (n < ncols) *(GAS v4u*)(WT + (size_t)(drow0 + n) * K + k0 + 8 * c8) = o; }
    LDS_WAIT(); asm volatile("" ::: "memory");
}
__device__ __forceinline__ void row_to_bf16_ssq(const float* xrow, bf16* orow, float* ssq, int lane) {
    const f32x4* xr = (const f32x4*)xrow + lane;
    f32x4 v[16]; float s = 0.f;
#pragma unroll
    for (int j = 0; j < 16; ++j) { v[j] = xr[64 * j]; s += (v[j].x * v[j].x + v[j].y * v[j].y) + (v[j].z * v[j].z + v[j].w * v[j].w); }
    s = wave_sum(s);
    v2u* o8 = (v2u*)orow + lane;
#pragma unroll
    for (int j = 0; j < 16; ++j) { v2u w; w.x = cvt_pk_bf16(v[j].x, v[j].y); w.y = cvt_pk_bf16(v[j].z, v[j].w); o8[64 * j] = w; }
    if (lane == 0) *ssq = s;
}
__device__ __forceinline__ float bf_lo(unsigned w) { return __uint_as_float(w << 16); }
__device__ __forceinline__ float bf_hi(unsigned w) { return __uint_as_float(w & 0xffff0000u); }

__global__ void __launch_bounds__(NWAVES * 64, 2) fwd_kernel(Args args) {
    extern __shared__ __attribute__((aligned(16))) unsigned char lds_raw[];
    LAS unsigned char* lds = (LAS unsigned char*)lds_raw;
    volatile LAS unsigned* MISC = (volatile LAS unsigned*)(lds + MISC_OFF);
    const int tid = threadIdx.x, lane = tid & 63, wave = __builtin_amdgcn_readfirstlane(tid >> 6);
    const int G = gridDim.x; const int bx = blockIdx.x; const int vcu = (G % 8 == 0) ? (bx % 8) * (G / 8) + bx / 8 : bx;
    unsigned char* ws = args.ws; float* out = args.out;
    gu32* ctl = (gu32*)(ws + WS_CTL);
    const float* x_prompt = args.in[0]; const float* x_sample = args.in[1];
    const float* cache_fk = args.in[2]; const float* cache_fv = args.in[3]; const float* cache_fl = args.in[4]; const float* cache_sk = args.in[5]; const float* cache_sv = args.in[6];
    const float* g_attn = args.in[7]; const float* w_in = args.in[8]; const float* b_forget = args.in[9]; const float* g_of = args.in[10]; const float* g_os = args.in[11];
    const float* w_out = args.in[12]; const float* g_ffn = args.in[13]; const float* w_gate = args.in[14]; const float* w_up = args.in[15]; const float* w_down = args.in[16]; const float* g_final = args.in[17];
    bf16* Win_t = (bf16*)(ws + WS_WIN); bf16* Wout_t = (bf16*)(ws + WS_WOUT); bf16* Wgu_t = (bf16*)(ws + WS_WGU); bf16* Wdn_t = (bf16*)(ws + WS_WDN);
    bf16* XN = (bf16*)(ws + WS_XN); bf16* QO = (bf16*)(ws + WS_QO); bf16* KVB = (bf16*)(ws + WS_KV); bf16* ACT = (bf16*)(ws + WS_ACT); float* PART = (float*)(ws + WS_PART);

    for (int u = tid; u < (LDS_BYTES - LDSCTL_OFF) / 4; u += NWAVES * 64) ((LAS unsigned*)(lds + LDSCTL_OFF))[u] = 0u;
    __syncthreads();
    XcdBarrier bar; bar.bar = (unsigned*)(ctl + CW_BAR); bar.x = 0; bar.st = nullptr;
    if (MK_N_LAUNCHES == 1) bar = xcd_barrier_post((unsigned*)(ctl + CW_BAR), MISC + 8);
    const int lo = args.ph_lo, hi_ph = args.ph_hi;
#ifndef PH_MASK
#define PH_MASK 0x1ff
#endif
#define IN(k) (((PH_MASK >> (k)) & 1) && lo <= (k) && (k) < hi_ph)
#define BOTH(k) (IN(k) && IN((k) + 1))
#define GRID_BAR() do { if (MK_N_LAUNCHES == 1) xcd_barrier(bar); } while (0)
#ifndef PROBE_PHASE
#define PROBE_PHASE (-1)
#endif
    unsigned long long probe_t0 = 0ull;
#define PROBE_T0(k) do { if (PROBE_PHASE == (k)) probe_t0 = __builtin_amdgcn_s_memrealtime(); } while (0)
#define PROBE_T1(k) do { if (PROBE_PHASE == (k)) { const unsigned long long t1_ = __builtin_amdgcn_s_memrealtime(); const unsigned long long d_ = t1_ - probe_t0; \
        while (__builtin_amdgcn_s_memrealtime() - t1_ < d_) __builtin_amdgcn_s_sleep(8); } } while (0)
    const int gw = vcu * NWAVES + wave, NGW = G * NWAVES;

    if (IN(0)) {
        PROBE_T0(0);
        LAS float* scr = (LAS float*)(lds + RING_OFF + wave * 16384);
        constexpr int KB4 = DM / 64;
        constexpr int I_INA = KB4 * (3 * WG / 32), I_INB = I_INA, I_FL = KB4;
        constexpr int NITEMS = I_INA + I_INB + I_FL;
#define TR_DECODE(it_, W_, ksc_, WT_, ldw_, K_, k0_, n0_, nc_, dr_) do { int r_ = (it_); ksc_ = g_attn; nc_ = 32; ldw_ = DIN; K_ = DM; W_ = w_in; WT_ = Win_t; \
            if (r_ < I_INA) { const int kb = r_ / 192, nb = r_ % 192; k0_ = 64 * kb; n0_ = 32 * nb; dr_ = 32 * nb; } \
            else if ((r_ -= I_INA) < I_INB) { const int kb = r_ / 192, nb = r_ % 192; k0_ = 64 * kb; n0_ = 3 * WG + NHG + 32 * nb; dr_ = 3 * WG + 32 * nb; } \
            else { r_ -= I_INB; k0_ = 64 * r_; n0_ = 3 * WG; nc_ = 16; dr_ = 6 * WG; } } while (0)
        if (gw < NITEMS) {
            const float* W; const float* ksc; bf16* WT; int ldw, K, k0, n0, nc, dr;
            f32x4 ra[8], rb[8];
            int it = gw;
            TR_DECODE(it, W, ksc, WT, ldw, K, k0, n0, nc, dr);
            tr_load(ra, W, ldw, k0, n0, lane);
            for (;;) {
                const int itn = it + NGW; const bool more = itn < NITEMS;
                const float* W2 = W; const float* ksc2 = ksc; bf16* WT2 = WT; int ldw2 = ldw, K2 = K, k02 = k0, n02 = n0, nc2 = nc, dr2 = dr;
                if (more) { TR_DECODE(itn, W2, ksc2, WT2, ldw2, K2, k02, n02, nc2, dr2); tr_load(rb, W2, ldw2, k02, n02, lane); }
                tr_proc(ra, ksc, K, k0, nc, WT, dr, scr, lane);
                if (!more) break;
#pragma unroll
                for (int j = 0; j < 8; ++j) ra[j] = rb[j];
                W = W2; ksc = ksc2; WT = WT2; ldw = ldw2; K = K2; k0 = k02; n0 = n02; nc = nc2; dr = dr2; it = itn;
            }
        }
#undef TR_DECODE
        for (int i = gw * 64 + lane; i < 240 * DM / 8; i += NGW * 64) *(v4u*)(Win_t + (size_t)(6 * WG + 16) * DM + (size_t)i * 8) = (v4u){0u, 0u, 0u, 0u};
        for (int m = gw; m < MT; m += NGW) row_to_bf16_ssq(m < MP ? x_prompt + (size_t)m * DM : x_sample + (size_t)(m - MP) * DM, XN + (size_t)m * DM, (float*)(ctl + CW_SSQ0) + m, lane);
        PROBE_T1(0);
        if (BOTH(0)) GRID_BAR();
    }

    if (IN(1)) {
        PROBE_T0(1);
        pg8::Gemm g{XN, Win_t, MT, NIN, DM}; pg8::StaticOrder S; S.init(MT, NIN, DM, G, bx);
        pg8::EpiIn E{QO, KVB, out, b_forget, (const float*)(ctl + CW_SSQ0)};
#ifndef PROBE_REP1
#define PROBE_REP1 1
#endif
#pragma unroll 1
        for (int rep = 0; rep < PROBE_REP1; ++rep) { if (rep) GRID_BAR();
        pg8::gemm_phase<pg8::EpiIn, pg8::StaticOrder, true, true>(lds + RING_OFF, g, S, E); }
        { const int nwg1 = (MT / 256) * (NIN / 256), rem1 = nwg1 % G;
          if (rem1 == 0 || bx >= rem1) { const int cgw = (rem1 ? bx - rem1 : bx) * NWAVES + wave, cngw = (rem1 ? G - rem1 : G) * NWAVES;
        { constexpr int CI_N = 2 * (DM / 64) * (DFF / 32);
          unsigned* CMAX = (unsigned*)(ctl + CW_CMAX);
          if (cgw < CI_N) {
            f32x4 ra[8], rb[8]; int it = cgw;
#define CM_DECODE(it_, W_, k0_, n0_, wh_) do { const int wh2_ = (it_) / ((DM / 64) * (DFF / 32)), r_ = (it_) % ((DM / 64) * (DFF / 32)); wh_ = wh2_; W_ = wh2_ ? w_up : w_gate; k0_ = 64 * (r_ / 344); n0_ = 32 * (r_ % 344); } while (0)
            const float* W; int k0, n0, wh;
            CM_DECODE(it, W, k0, n0, wh);
            tr_load(ra, W, DFF, k0, n0, lane);
            for (;;) {
                const int itn = it + cngw; const bool more = itn < CI_N;
                const float* W2 = W; int k02 = k0, n02 = n0, wh2 = wh;
                if (more) { CM_DECODE(itn, W2, k02, n02, wh2); tr_load(rb, W2, DFF, k02, n02, lane); }
                f32x4 mx = {0.f, 0.f, 0.f, 0.f};
#pragma unroll
                for (int j = 0; j < 8; ++j) { const float gk = g_ffn[k0 + 8 * j + (lane >> 3)];
                    mx.x = fmaxf(mx.x, fabsf(ra[j].x * gk)); mx.y = fmaxf(mx.y, fabsf(ra[j].y * gk)); mx.z = fmaxf(mx.z, fabsf(ra[j].z * gk)); mx.w = fmaxf(mx.w, fabsf(ra[j].w * gk)); }
#pragma unroll
                for (int o = 8; o < 64; o <<= 1) { mx.x = fmaxf(mx.x, __shfl_xor(mx.x, o)); mx.y = fmaxf(mx.y, __shfl_xor(mx.y, o)); mx.z = fmaxf(mx.z, __shfl_xor(mx.z, o)); mx.w = fmaxf(mx.w, __shfl_xor(mx.w, o)); }
                if (lane < 8) { unsigned* d = CMAX + wh * DFF + n0 + 4 * lane;
                    __hip_atomic_fetch_max(d + 0, __float_as_uint(mx.x), __ATOMIC_RELAXED, __HIP_MEMORY_SCOPE_AGENT); __hip_atomic_fetch_max(d + 1, __float_as_uint(mx.y), __ATOMIC_RELAXED, __HIP_MEMORY_SCOPE_AGENT);
                    __hip_atomic_fetch_max(d + 2, __float_as_uint(mx.z), __ATOMIC_RELAXED, __HIP_MEMORY_SCOPE_AGENT); __hip_atomic_fetch_max(d + 3, __float_as_uint(mx.w), __ATOMIC_RELAXED, __HIP_MEMORY_SCOPE_AGENT); }
                if (!more) break;
#pragma unroll
                for (int j = 0; j < 8; ++j) ra[j] = rb[j];
                W = W2; k0 = k02; n0 = n02; wh = wh2; it = itn;
            }
#undef CM_DECODE
          } }
        { unsigned* CMAXD = (unsigned*)(ctl + CW_CMAXD);
          for (int it = cgw; it < (DFF / 64) * (DM / 32); it += NGW) { const int kb = it / 128, nb = it % 128; f32x4 r[8];
            tr_load(r, w_down, DM, 64 * kb, 32 * nb, lane);
#define HB4(a, b) { const f32x4 t_ = a; a = t_ + b; b = t_ - b; }
            HB4(r[0], r[1]) HB4(r[2], r[3]) HB4(r[4], r[5]) HB4(r[6], r[7]) HB4(r[0], r[2]) HB4(r[1], r[3]) HB4(r[4], r[6]) HB4(r[5], r[7])
#undef HB4
            const int l3 = lane >> 3; f32x4 mx = {0.f, 0.f, 0.f, 0.f};
#pragma unroll
            for (int b = 0; b < 3; ++b) { const int o = 8 << b; const bool up = (l3 >> b) & 1;
#pragma unroll
                for (int j = 0; j < 8; ++j) { f32x4 p; p.x = __shfl_xor(r[j].x, o); p.y = __shfl_xor(r[j].y, o); p.z = __shfl_xor(r[j].z, o); p.w = __shfl_xor(r[j].w, o); r[j] = up ? p - r[j] : r[j] + p; } }
#pragma unroll
            for (int j = 0; j < 8; ++j) { mx.x = fmaxf(mx.x, fabsf(r[j].x)); mx.y = fmaxf(mx.y, fabsf(r[j].y)); mx.z = fmaxf(mx.z, fabsf(r[j].z)); mx.w = fmaxf(mx.w, fabsf(r[j].w)); }
#pragma unroll
            for (int o = 8; o < 64; o <<= 1) { mx.x = fmaxf(mx.x, __shfl_xor(mx.x, o)); mx.y = fmaxf(mx.y, __shfl_xor(mx.y, o)); mx.z = fmaxf(mx.z, __shfl_xor(mx.z, o)); mx.w = fmaxf(mx.w, __shfl_xor(mx.w, o)); }
            if (lane < 8) { unsigned* d = CMAXD + 32 * nb + 4 * lane;
                __hip_atomic_fetch_max(d + 0, __float_as_uint(mx.x), __ATOMIC_RELAXED, __HIP_MEMORY_SCOPE_AGENT); __hip_atomic_fetch_max(d + 1, __float_as_uint(mx.y), __ATOMIC_RELAXED, __HIP_MEMORY_SCOPE_AGENT);
                __hip_atomic_fetch_max(d + 2, __float_as_uint(mx.z), __ATOMIC_RELAXED, __HIP_MEMORY_SCOPE_AGENT); __hip_atomic_fetch_max(d + 3, __float_as_uint(mx.w), __ATOMIC_RELAXED, __HIP_MEMORY_SCOPE_AGENT); } } }
          } }
        PROBE_T1(1);
        if (BOTH(1)) GRID_BAR();
    }

    if (IN(2)) {
        PROBE_T0(2);
        LAS float* U = (LAS float*)(lds + att::OFF_U); LAS float* scn = (LAS float*)(lds + att::OFF_SCAN);
        constexpr int N_ITEMS = 512 + 512 + 256 + 256;
        float* OSQ = (float*)(ctl + CW_OSQ);
        BgJob bg{w_out, w_gate, w_up, w_down, g_ffn, g_of, g_os, Wout_t, Wgu_t, Wdn_t, (const unsigned*)(ctl + CW_CMAX), (const unsigned*)(ctl + CW_CMAXD), lds + BG_OFF + wave * BG_BYTES, gw, -1, NGW, BG_N - BG_I_D};
#ifndef PROBE_REP2
#define PROBE_REP2 1
#endif
#pragma unroll 1
        for (int prep = 0; prep < PROBE_REP2; ++prep) {
        const long odelta = (prep + 1 < PROBE_REP2) ? (long)((char*)XN - (char*)QO) / 2 : 0l;
        if (prep) GRID_BAR();
        for (int it = vcu; it < N_ITEMS; it += G) {
            if (it < 1024) {
                const int mode = it >> 9, r = it & 511, bh = r >> 2, pi = r & 3, b = bh >> 4, h = bh & 15;
                const bf16* Kp = KVB + (size_t)(mode * 2) * (KV_STRIDE / 2) + (size_t)(b * SEQ) * WG + h * HD;
                const bf16* Vp = Kp + (KV_STRIDE / 2);
                bf16* Qp = QO + (size_t)(b * SEQ) * DM + mode * WG + h * HD;
                if (mode == 0) {
                    const float* lf = out + O_PFL + (size_t)(b * SEQ) * NHG + h;
                    att::scan_u(U, scn, SEQ, [&](int t) { return lf[(size_t)t * NHG]; });
                }
#pragma unroll 1
                for (int pass = 0; pass < 2; ++pass) { const int qb = pass ? 7 - pi : pi; bf16* Qb = Qp + (size_t)(qb * 256) * DM;
                    if (mode == 0) att::attn_unit<0, false>(lds + RING_OFF, Qb, Kp, Vp, Qb + odelta, qb * 256, nullptr, nullptr, nullptr, nullptr, bg, OSQ + 2 * (size_t)(b * SEQ + qb * 256) + mode);
                    if (mode == 1) att::attn_unit<1, false>(lds + RING_OFF, Qb, Kp, Vp, Qb + odelta, qb * 256, nullptr, nullptr, nullptr, nullptr, bg, OSQ + 2 * (size_t)(b * SEQ + qb * 256) + mode);
                }
            } else {
                const int r = it - 1024, mode = r >> 8, bh = r & 255, b = bh >> 4, h = bh & 15;
                bf16* Qb = QO + (size_t)(MP + b * DS) * DM + mode * WG + h * HD;
                const float* Kc = (mode ? cache_sk : cache_fk) + (size_t)(b * PAST) * WG + h * HD; const float* Vc = (mode ? cache_sv : cache_fv) + (size_t)(b * PAST) * WG + h * HD;
                const float* Kn = out + (mode ? O_SSK : O_SFK) + (size_t)(b * DS) * WG + h * HD; const float* Vn = out + (mode ? O_SSV : O_SFV) + (size_t)(b * DS) * WG + h * HD;
                if (mode == 0) {
                    const float* lfc = cache_fl + (size_t)(b * PAST) * NHG + h; const float* lfn = out + O_SFL + (size_t)(b * DS) * NHG + h;
                    att::scan_u(U, scn, TKS, [&](int t) { return t < PAST ? lfc[(size_t)t * NHG] : lfn[(size_t)(t - PAST) * NHG]; });
                    att::attn_unit<0, true>(lds + RING_OFF, Qb, nullptr, nullptr, Qb + odelta, PAST, Kc, Vc, Kn, Vn, bg, OSQ + 2 * (size_t)(MP + b * DS) + mode);
                } else {
                    att::attn_unit<1, true>(lds + RING_OFF, Qb, nullptr, nullptr, Qb + odelta, PAST, Kc, Vc, Kn, Vn, bg, OSQ + 2 * (size_t)(MP + b * DS) + mode);
                }
            }
        }
        while (bg.have >= 0 || bg.next < bg.end) { bg_step(bg, lane); VM_WAIT(); }
        }
        PROBE_T1(2);
        if (BOTH(2)) GRID_BAR();
    }


    float* SSQ = (float*)(ctl + CW_SSQ);
    if (IN(4)) {
        PROBE_T0(4);
        pg8::Gemm g{QO, Wout_t, MT, DM, DM}; pg8::OutOrder S; S.init(MP, DM, DM, G, bx);
#ifndef PROBE_REP4
#define PROBE_REP4 1
#endif
#pragma unroll 1
        for (int rep = 0; rep < PROBE_REP4; ++rep) { if (rep) GRID_BAR();
        pg8::EpiX2 E{XN, (rep + 1 < PROBE_REP4) ? (float*)(ctl + CW_SSQ_DUMMY) : SSQ, PART, (const float*)(ctl + CW_OSQ), (unsigned*)(ctl + CW_AMAX)};
        pg8::gemm_phase<pg8::EpiX2, pg8::OutOrder, true, true, true>(lds + RING_OFF, g, S, E); }
        PROBE_T1(4);
        if (BOTH(4)) GRID_BAR();
    }

    if (IN(5)) {
        unsigned* AMAX = (unsigned*)(ctl + CW_AMAX); unsigned char* XQ = ws + WS_XQ;
        for (int m = gw; m < MT; m += NGW) {
            f32x4 v[16]; float amax;
            if (m >= MP && G == 256) {
                const int ms = m - MP; const f32x4* xr = (const f32x4*)(x_sample + (size_t)ms * DM) + lane; float s = 0.f, mx = 0.f;
#pragma unroll
                for (int j = 0; j < 16; ++j) v[j] = xr[64 * j];
                const float* oq = (const float*)(ctl + CW_OSQ) + 2 * (size_t)m;
                const float rf = rsqrtf(oq[0] * (1.f / WG) + EPS), rs2 = rsqrtf(oq[1] * (1.f / WG) + EPS);
#pragma unroll 1
                for (int ks = 0; ks < 8; ++ks) { const f32x4* pr = (const f32x4*)(PART + (size_t)ks * ((size_t)MS * DM) + (size_t)ms * DM) + lane; const float sc = ks < 4 ? rf : rs2;
#pragma unroll
                    for (int j = 0; j < 16; ++j) v[j] += pr[64 * j] * sc; }
                v2u* o8 = (v2u*)(XN + (size_t)m * DM) + lane;
#pragma unroll
                for (int j = 0; j < 16; ++j) { s += (v[j].x * v[j].x + v[j].y * v[j].y) + (v[j].z * v[j].z + v[j].w * v[j].w);
                    mx = fmaxf(fmaxf(mx, fmaxf(fabsf(v[j].x), fabsf(v[j].y))), fmaxf(fabsf(v[j].z), fabsf(v[j].w)));
                    v2u w; w.x = cvt_pk_bf16(v[j].x, v[j].y); w.y = cvt_pk_bf16(v[j].z, v[j].w); o8[64 * j] = w; }
                s = wave_sum(s);
#pragma unroll
                for (int o = 1; o < 64; o <<= 1) mx = fmaxf(mx, __shfl_xor(mx, o));
                if (lane == 0) { SSQ[m] = s; AMAX[m] = __float_as_uint(mx); }
                amax = mx;
            } else {
                const v2u* x2r = (const v2u*)(XN + (size_t)m * DM) + lane;
#pragma unroll
                for (int j = 0; j < 16; ++j) { const v2u x = x2r[64 * j]; v[j] = (f32x4){bf_lo(x.x), bf_hi(x.x), bf_lo(x.y), bf_hi(x.y)}; }
                amax = __uint_as_float(AMAX[m]);
            }
            const float qs = amax > 0.f ? 127.f / amax : 0.f;
            unsigned* q4 = (unsigned*)(XQ + (size_t)m * DM) + lane;
#pragma unroll
            for (int j = 0; j < 16; ++j) {
                const int a = (int)__builtin_rintf(fminf(fmaxf(v[j].x * qs, -127.f), 127.f)) & 0xff, b = (int)__builtin_rintf(fminf(fmaxf(v[j].y * qs, -127.f), 127.f)) & 0xff;
                const int c = (int)__builtin_rintf(fminf(fmaxf(v[j].z * qs, -127.f), 127.f)) & 0xff, d = (int)__builtin_rintf(fminf(fmaxf(v[j].w * qs, -127.f), 127.f)) & 0xff;
                q4[64 * j] = (unsigned)a | ((unsigned)b << 8) | ((unsigned)c << 16) | ((unsigned)d << 24); }
        }
        if (BOTH(5)) GRID_BAR();
    }

    if (IN(6)) {
        PROBE_T0(6);
#ifndef PROBE_REP6
#define PROBE_REP6 1
#endif
#pragma unroll 1
        for (int rep = 0; rep < PROBE_REP6; ++rep) {
        pg8::Gemm g{(const bf16*)(ws + WS_XQ), Wgu_t, MT, 2 * DFF, DM / 2}; pg8::StaticOrder S; S.init(MT, 2 * DFF, DM / 2, G, bx);
        pg8::EpiGluQ E{ACT, SSQ, (const unsigned*)(ctl + CW_AMAX), (const unsigned*)(ctl + CW_CMAX)};
        pg8::gemm_phase<pg8::EpiGluQ, pg8::StaticOrder, true, true, false, true>(lds + RING_OFF, g, S, E);
        if (rep + 1 == PROBE_REP6) { const int nwg6 = (MT / 256) * (2 * DFF / 256), rem6 = nwg6 % G;
          if (rem6 == 0 || bx >= rem6) { const int cgw = (rem6 ? bx - rem6 : bx) * NWAVES + wave, cngw = (rem6 ? G - rem6 : G) * NWAVES;
            BgJob bd{w_out, w_gate, w_up, w_down, g_ffn, g_of, g_os, Wout_t, Wgu_t, Wdn_t, (const unsigned*)(ctl + CW_CMAX), (const unsigned*)(ctl + CW_CMAXD), lds + BG_OFF + wave * BG_BYTES, BG_N - BG_I_D + cgw, -1, cngw, BG_N};
            while (bd.have >= 0 || bd.next < bd.end) { bg_step(bd, lane); VM_WAIT(); } } }
        PROBE_T1(6);
        if (BOTH(6)) GRID_BAR();
        }
    }

    if (IN(7)) {
        PROBE_T0(7);
        { unsigned* AMAX2 = (unsigned*)(ctl + CW_AMAX2); unsigned char* ACTQ = ws + WS_ACTQ;
#define HB(a, b) { const float t_ = a; a = t_ + b; b = t_ - b; }
#define ROT32(x_, f_) do { f_[0] = bf_lo(x_.x); f_[1] = bf_hi(x_.x); f_[2] = bf_lo(x_.y); f_[3] = bf_hi(x_.y); f_[4] = bf_lo(x_.z); f_[5] = bf_hi(x_.z); f_[6] = bf_lo(x_.w); f_[7] = bf_hi(x_.w); \
            HB(f_[0], f_[1]) HB(f_[2], f_[3]) HB(f_[4], f_[5]) HB(f_[6], f_[7]) HB(f_[0], f_[2]) HB(f_[1], f_[3]) HB(f_[4], f_[6]) HB(f_[5], f_[7]) HB(f_[0], f_[4]) HB(f_[1], f_[5]) HB(f_[2], f_[6]) HB(f_[3], f_[7]) \
            _Pragma("unroll") for (int i_ = 0; i_ < 8; ++i_) { const float p_ = __shfl_xor(f_[i_], 1); f_[i_] = (lane & 1) ? p_ - f_[i_] : f_[i_] + p_; } \
            _Pragma("unroll") for (int i_ = 0; i_ < 8; ++i_) { const float p_ = __shfl_xor(f_[i_], 2); f_[i_] = (lane & 2) ? p_ - f_[i_] : f_[i_] + p_; } } while (0)
          constexpr int NCH = DFF / 8, NIT = (NCH + 63) / 64;
          for (int m = gw; m < MT; m += NGW) {
              const v4u* src_ = (const v4u*)(ACT + (size_t)m * DFF); v2u* dst_ = (v2u*)(ACTQ + (size_t)m * DFF);
              v4u x[NIT];
#pragma unroll
              for (int it = 0; it < NIT; ++it) { const int c = lane + 64 * it; x[it] = src_[c < NCH ? c : NCH - 1]; }
              float mx = 0.f;
#pragma unroll
              for (int it = 0; it < NIT; ++it) { float f[8]; ROT32(x[it], f); float m8 = 0.f;
#pragma unroll
                  for (int i = 0; i < 8; ++i) m8 = fmaxf(m8, fabsf(f[i]));
                  if (lane + 64 * it < NCH) mx = fmaxf(mx, m8); }
#pragma unroll
              for (int o = 1; o < 64; o <<= 1) mx = fmaxf(mx, __shfl_xor(mx, o));
              const float qs = mx > 0.f ? 127.f / mx : 0.f;
#pragma unroll
              for (int it = 0; it < NIT; ++it) { float f[8]; ROT32(x[it], f); int q[8];
#pragma unroll
                  for (int i = 0; i < 8; ++i) q[i] = (int)__builtin_rintf(fminf(fmaxf(f[i] * qs, -127.f), 127.f)) & 0xff;
                  v2u w; w.x = (unsigned)q[0] | ((unsigned)q[1] << 8) | ((unsigned)q[2] << 16) | ((unsigned)q[3] << 24); w.y = (unsigned)q[4] | ((unsigned)q[5] << 8) | ((unsigned)q[6] << 16) | ((unsigned)q[7] << 24);
                  if (lane + 64 * it < NCH) dst_[lane + 64 * it] = w; }
              if (lane == 0) AMAX2[m] = __float_as_uint(mx); }
#undef ROT32
#undef HB
          GRID_BAR(); }
        if (G == 256) {
            pg8::Gemm g{(const bf16*)(ws + WS_ACTQ), Wdn_t, MT, DM, DFF / 2};
            pg8::FusedDownOrder S; S.c = bx; S.nkt_full = DFF / 128;
            pg8::EpiDownFused E{XN, out, PART, (float*)(ctl + CW_SSQ3), (unsigned*)(ctl + CW_CNT7), g_final, (const unsigned*)(ctl + CW_AMAX2), (const unsigned*)(ctl + CW_CMAXD)};
            pg8::gemm_phase<pg8::EpiDownFused, pg8::FusedDownOrder, true, true, false, true>(lds + RING_OFF, g, S, E);
        }
        PROBE_T1(7);
        if (BOTH(7)) GRID_BAR();
    }

    if (IN(8)) {
        PROBE_T0(8);
        for (int m = (G == 256 ? MP : 0) + gw; m < MT; m += NGW) { f32x4* xr = (f32x4*)(out + (size_t)m * DM) + lane; const f32x4* gr = (const f32x4*)g_final + lane;
            f32x4 v[16]; float s = 0.f;
            if (m >= MP && G == 256) {
                const v2u* x2r = (const v2u*)(XN + (size_t)m * DM) + lane;
#pragma unroll
                for (int j = 0; j < 16; ++j) { const v2u x = x2r[64 * j]; v[j] = (f32x4){bf_lo(x.x), bf_hi(x.x), bf_lo(x.y), bf_hi(x.y)}; }
#pragma unroll 1
                for (int ks = 0; ks < 8; ++ks) { const f32x4* pr = (const f32x4*)(PART + (size_t)ks * ((size_t)MS * DM) + (size_t)(m - MP) * DM) + lane;
#pragma unroll
                    for (int j = 0; j < 16; ++j) v[j] += pr[64 * j]; }
            } else {
#pragma unroll
                for (int j = 0; j < 16; ++j) v[j] = xr[64 * j];
            }
#pragma unroll
            for (int j = 0; j < 16; ++j) s += (v[j].x * v[j].x + v[j].y * v[j].y) + (v[j].z * v[j].z + v[j].w * v[j].w);
            const float rstd = rsqrtf(wave_sum(s) * (1.f / DM) + EPS);
#pragma unroll
            for (int j = 0; j < 16; ++j) { const f32x4 gg = gr[64 * j]; xr[64 * j] = v[j] * rstd * gg; } }
        PROBE_T1(8);
    }
#undef IN
#undef BOTH
#undef GRID_BAR
}

extern "C" void kernel_launch(void* const* d_in, const int* in_sizes, int n_in, void* d_out, int out_size, void* d_ws, size_t ws_size, hipStream_t stream) {
    static int grid = 0;
    if (grid == 0) {
        if (n_in != 18 || (size_t)out_size != O_END || ws_size < WS_END) { fprintf(stderr, "kernel_launch: unexpected shapes (n_in %d, out %d, ws %zu)\n", n_in, out_size, ws_size); grid = -1; return; }
        int dev = 0, cus = 0;
        if (hipGetDevice(&dev) != hipSuccess || hipDeviceGetAttribute(&cus, hipDeviceAttributeMultiprocessorCount, dev) != hipSuccess) { grid = -1; return; }
        if (hipFuncSetAttribute((const void*)fwd_kernel, hipFuncAttributeMaxDynamicSharedMemorySize, LDS_BYTES) != hipSuccess) { fprintf(stderr, "kernel_launch: hipFuncSetAttribute failed\n"); grid = -1; return; }
        int per_cu = 0;
        if (hipOccupancyMaxActiveBlocksPerMultiprocessor(&per_cu, (const void*)fwd_kernel, NWAVES * 64, LDS_BYTES) != hipSuccess || per_cu < 1) fprintf(stderr, "kernel_launch: occupancy query says %d\n", per_cu);
        (void)hipGetLastError();
        grid = cus;
    }
    if (grid < 0) return;
    (void)hipMemsetAsync((char*)d_ws + WS_CTL, 0, CTL_ZERO_BYTES, stream);
    Args a{};
    for (int i = 0; i < 18; ++i) a.in[i] = (const float*)d_in[i];
    a.out = (float*)d_out; a.ws = (unsigned char*)d_ws;
#if MK_N_LAUNCHES == 1
    a.ph_lo = 0; a.ph_hi = 9;
    hipLaunchKernelGGL(fwd_kernel, dim3(grid), dim3(NWAVES * 64), LDS_BYTES, stream, a);
#else
    for (int p = 0; p < 9; ++p) { a.ph_lo = p; a.ph_hi = p + 1; hipLaunchKernelGGL(fwd_kernel, dim3(grid), dim3(NWAVES * 64), LDS_BYTES, stream, a); }
#endif
}
```
